# Optimizing an MI355X kernel written in HIP

```python
import math
import jax
import jax.numpy as jnp
from jax import lax
import numpy as np

D_MODEL = 1024
BATCH = 32
SEQ = 256
DEPTH = 2
DEC_BATCH = 8
DEC_SEQ = 2048
PAST_LEN = 256

GRID_W = 64
N_MIXERS = 2
N_SSD_LAYERS = (DEPTH + 1) // 2
N_GDN_LAYERS = DEPTH // 2

SSD_D_INNER = 2 * D_MODEL
SSD_HEADDIM = 64
SSD_HEADS = SSD_D_INNER // SSD_HEADDIM
SSD_GROUPS = 8
SSD_STATE = 128
SSD_CONV = 3
SSD_CHUNK = 128
SSD_XBC = SSD_D_INNER + 2 * SSD_GROUPS * SSD_STATE
SSD_IN = SSD_D_INNER + SSD_XBC + 2 * SSD_HEADS

GDN_K_HEADS = 8
GDN_V_HEADS = 16
GDN_HEAD_K = 128
GDN_HEAD_V = 128
GDN_QK = GDN_K_HEADS * GDN_HEAD_K
GDN_V = GDN_V_HEADS * GDN_HEAD_V
GDN_QKV = 2 * GDN_QK + GDN_V
GDN_CONV = 3
GDN_CHUNK = 64
GDN_IN = GDN_QKV + GDN_V + 4 * GDN_V_HEADS

D_FF = 2816
FFN_CONV = 3

DEEPNORM_ALPHA = (2.0 * DEPTH) ** 0.25
DEEPNORM_BETA = (8.0 * DEPTH) ** -0.25
LN_EPS = 1e-5
RMS_EPS = 1e-6

kernel_name = 'bidir_ssd_gdn_prefix_dit_step'


def layer_norm(x, g, b):
    xf = x.astype(jnp.float32)
    mu = jnp.mean(xf, axis=-1, keepdims=True)
    var = jnp.mean(jnp.square(xf - mu), axis=-1, keepdims=True)
    return ((xf - mu) * lax.rsqrt(var + LN_EPS)).astype(x.dtype) * g + b


def rms_norm(x, w):
    xf = x.astype(jnp.float32)
    ms = jnp.mean(jnp.square(xf), axis=-1, keepdims=True)
    return (xf * lax.rsqrt(ms + RMS_EPS)).astype(x.dtype) * w


def l2_normalize(x):
    xf = x.astype(jnp.float32)
    return (xf * lax.rsqrt(jnp.sum(jnp.square(xf), axis=-1, keepdims=True) + RMS_EPS)).astype(x.dtype)


def adaln_params(cond, w_ada, b_ada):
    ada = (jax.nn.silu(cond) @ w_ada + b_ada)[:, None, :]
    return tuple(jnp.split(ada, 6, axis=-1))


def modulate(x, shift, scale):
    return x * (1.0 + scale) + shift


def dwconv1d_centred(x, w):
    width = w.shape[0]
    pad = width // 2
    seqlen = x.shape[1]
    xp = jnp.pad(x, ((0, 0), (pad, pad), (0, 0)))
    return sum(w[t] * xp[:, t:t + seqlen] for t in range(width))


def dwconv2d_grid(x, w, rows):
    bsz, seqlen, ch = x.shape
    img = x.reshape(bsz, rows, GRID_W, ch)
    out = lax.conv_general_dilated(img, w[:, :, None, :], window_strides=(1, 1), padding='SAME',
                                   dimension_numbers=('NHWC', 'HWIO', 'NHWC'), feature_group_count=ch)
    return out.reshape(bsz, seqlen, ch)


def flip_seq(t):
    return jnp.flip(t, axis=1)


def ssd_scan(x, dt, a_neg, b_mat, c_mat, s0):
    bsz, seqlen, nh, hp = x.shape
    ng, ns = b_mat.shape[2], b_mat.shape[3]
    nr = nh // ng
    nc = seqlen // SSD_CHUNK
    xc = x.reshape(bsz, nc, SSD_CHUNK, ng, nr, hp)
    dtc = dt.reshape(bsz, nc, SSD_CHUNK, ng, nr)
    bc = b_mat.reshape(bsz, nc, SSD_CHUNK, ng, ns)
    cc = c_mat.reshape(bsz, nc, SSD_CHUNK, ng, ns)
    acum = jnp.cumsum(dtc * a_neg.reshape(ng, nr), axis=2)
    xdt = xc * dtc[..., None]
    seg = acum[:, :, :, None] - acum[:, :, None, :]
    mask = jnp.tril(jnp.ones((SSD_CHUNK, SSD_CHUNK), dtype=bool))[:, :, None, None]
    decay = jnp.exp(jnp.where(mask, seg, -jnp.inf))
    scores = jnp.einsum('bcign,bcjgn->bcijg', cc, bc)
    y_intra = jnp.einsum('bcijgr,bcjgrp->bcigrp', scores[..., None] * decay, xdt)
    decay_end = jnp.exp(acum[:, :, -1:] - acum)
    states = jnp.einsum('bcqgn,bcqgr,bcqgrp->bcgrpn', bc, decay_end, xdt)
    chunk_decay = jnp.exp(acum[:, :, -1])

    def step(s, inp):
        st, dc = inp
        s_new = dc[..., None, None] * s + st
        return s_new.astype(s.dtype), s

    s_init = s0.reshape(bsz, ng, nr, hp, ns).astype(x.dtype)
    s_final, s_prev = lax.scan(step, s_init, (jnp.moveaxis(states, 1, 0), jnp.moveaxis(chunk_decay, 1, 0)))
    s_prev = jnp.moveaxis(s_prev, 0, 1)
    y_inter = jnp.einsum('bcign,bcgrpn,bcigr->bcigrp', cc, s_prev, jnp.exp(acum))
    y = (y_intra + y_inter).reshape(bsz, seqlen, nh, hp)
    return y, s_final.reshape(bsz, nh, hp, ns)


def gdn_scan(q, k, v, g, beta, s0):
    bsz, seqlen, nh, dk = q.shape
    dv = v.shape[-1]
    nc = seqlen // GDN_CHUNK

    def chunks(t):
        return jnp.moveaxis(t.reshape(bsz, nc, GDN_CHUNK, nh, -1), 3, 2)

    qc, kc, vc = chunks(q), chunks(k), chunks(v)
    gc = jnp.cumsum(jnp.moveaxis(g.reshape(bsz, nc, GDN_CHUNK, nh), 3, 2), axis=-1)
    bc = jnp.moveaxis(beta.reshape(bsz, nc, GDN_CHUNK, nh), 3, 2)[..., None]
    seg = gc[..., :, None] - gc[..., None, :]
    incl = jnp.tril(jnp.ones((GDN_CHUNK, GDN_CHUNK), dtype=bool))
    strict = jnp.tril(jnp.ones((GDN_CHUNK, GDN_CHUNK), dtype=bool), -1)
    kb = kc * bc
    a_mat = jnp.einsum('bchid,bchjd->bchij', kb, kc) * jnp.exp(jnp.where(strict, seg, -jnp.inf))
    sys_mat = (jnp.eye(GDN_CHUNK, dtype=jnp.float32) + a_mat.astype(jnp.float32))
    rhs = jnp.concatenate([vc * bc, kb * jnp.exp(gc)[..., None]], axis=-1).astype(jnp.float32)
    sol = lax.linalg.triangular_solve(sys_mat, rhs, left_side=True, lower=True, unit_diagonal=True).astype(q.dtype)
    u, w = sol[..., :dv], sol[..., dv:]
    qk = jnp.einsum('bchid,bchjd->bchij', qc, kc) * jnp.exp(jnp.where(incl, seg, -jnp.inf))
    q_dec = qc * jnp.exp(gc)[..., None]
    k_dec = kc * jnp.exp(gc[..., -1:] - gc)[..., None]
    g_last = jnp.exp(gc[..., -1])

    def step(s, inp):
        u_c, w_c, qk_c, qd_c, kd_c, gl_c = inp
        v_new = u_c - jnp.einsum('bhid,bhde->bhie', w_c, s)
        o_c = jnp.einsum('bhid,bhde->bhie', qd_c, s) + jnp.einsum('bhij,bhje->bhie', qk_c, v_new)
        s_new = gl_c[..., None, None] * s + jnp.einsum('bhjd,bhje->bhde', kd_c, v_new)
        return s_new.astype(s.dtype), o_c

    xs = tuple(jnp.moveaxis(t, 1, 0) for t in (u, w, qk, q_dec, k_dec, g_last))
    s_final, o = lax.scan(step, s0.astype(q.dtype), xs)
    o = jnp.moveaxis(jnp.moveaxis(o, 0, 1), 2, 3).reshape(bsz, seqlen, nh, dv)
    return o, s_final


def ssd_mixer(h, s0_f, s0_b, w_in, conv_w, conv_b, dt_bias, a_log, d_skip, norm_w, w_out):
    bsz, seqlen, _ = h.shape
    proj = h @ w_in
    z = proj[..., :SSD_D_INNER]
    xbc = jax.nn.silu(dwconv1d_centred(proj[..., SSD_D_INNER:SSD_D_INNER + SSD_XBC], conv_w) + conv_b)
    dt_raw = proj[..., SSD_D_INNER + SSD_XBC:].reshape(bsz, seqlen, 2, SSD_HEADS)
    xs = xbc[..., :SSD_D_INNER].reshape(bsz, seqlen, SSD_HEADS, SSD_HEADDIM)
    gn = SSD_GROUPS * SSD_STATE
    bm = xbc[..., SSD_D_INNER:SSD_D_INNER + gn].reshape(bsz, seqlen, SSD_GROUPS, SSD_STATE)
    cm = xbc[..., SSD_D_INNER + gn:].reshape(bsz, seqlen, SSD_GROUPS, SSD_STATE)
    dt = jax.nn.softplus(dt_raw + dt_bias)
    a_neg = -jnp.exp(a_log)
    y_f, s_f = ssd_scan(xs, dt[:, :, 0], a_neg[0], bm, cm, s0_f)
    y_b, s_b = ssd_scan(flip_seq(xs), flip_seq(dt[:, :, 1]), a_neg[1], flip_seq(bm), flip_seq(cm), s0_b)
    y = y_f + flip_seq(y_b) + xs * d_skip[:, None]
    y = rms_norm(y.reshape(bsz, seqlen, SSD_D_INNER) * jax.nn.silu(z), norm_w)
    return y @ w_out, s_f, s_b


def gdn_mixer(h, s0_f, s0_b, w_in, conv_w, dt_bias, a_log, norm_w, w_out):
    bsz, seqlen, _ = h.shape
    proj = h @ w_in
    qkv = jax.nn.silu(dwconv1d_centred(proj[..., :GDN_QKV], conv_w))
    q = qkv[..., :GDN_QK].reshape(bsz, seqlen, GDN_K_HEADS, GDN_HEAD_K)
    k = qkv[..., GDN_QK:2 * GDN_QK].reshape(bsz, seqlen, GDN_K_HEADS, GDN_HEAD_K)
    v = qkv[..., 2 * GDN_QK:].reshape(bsz, seqlen, GDN_V_HEADS, GDN_HEAD_V)
    z = proj[..., GDN_QKV:GDN_QKV + GDN_V].reshape(bsz, seqlen, GDN_V_HEADS, GDN_HEAD_V)
    a_raw = proj[..., GDN_QKV + GDN_V:GDN_QKV + GDN_V + 2 * GDN_V_HEADS].reshape(bsz, seqlen, 2, GDN_V_HEADS)
    b_raw = proj[..., GDN_QKV + GDN_V + 2 * GDN_V_HEADS:].reshape(bsz, seqlen, 2, GDN_V_HEADS)
    rep = GDN_V_HEADS // GDN_K_HEADS
    q = jnp.repeat(l2_normalize(q) * (GDN_HEAD_K ** -0.5), rep, axis=2)
    k = jnp.repeat(l2_normalize(k), rep, axis=2)
    g = -jnp.exp(a_log) * jax.nn.softplus(a_raw + dt_bias)
    beta = jax.nn.sigmoid(b_raw)
    o_f, s_f = gdn_scan(q, k, v, g[:, :, 0], beta[:, :, 0], s0_f)
    o_b, s_b = gdn_scan(flip_seq(q), flip_seq(k), flip_seq(v), flip_seq(g[:, :, 1]), flip_seq(beta[:, :, 1]), s0_b)
    o = rms_norm(o_f + flip_seq(o_b), norm_w) * jax.nn.silu(z)
    return o.reshape(bsz, seqlen, GDN_V) @ w_out, s_f, s_b


def conv_glu_ffn(h, w_up, conv_w, conv_b, w_down, rows):
    up = h @ w_up
    a, v = up[..., :D_FF], up[..., D_FF:]
    if rows is None:
        a = dwconv1d_centred(a, conv_w[FFN_CONV // 2])
    else:
        a = dwconv2d_grid(a, conv_w, rows)
    return (jax.nn.silu(a + conv_b) * v) @ w_down


def _dt_bias_init(k, shape):
    dt = jnp.exp(jax.random.uniform(k, shape, jnp.float32, math.log(1e-3), math.log(1e-1)))
    return dt + jnp.log(-jnp.expm1(-dt))


def setup_inputs(seed: int = 0) -> dict:
    key = jax.random.key(seed)
    ks = jax.random.split(key, 32)

    def nrm(k, shape, scale):
        return jax.random.normal(k, shape, jnp.float32) * scale

    return {
        'x_prompt': nrm(ks[0], (BATCH, SEQ, D_MODEL), 1.0),
        'x_sample': nrm(ks[1], (DEC_BATCH, DEC_SEQ, D_MODEL), 1.0),
        'state_ssd_fwd': nrm(ks[2], (DEC_BATCH, N_SSD_LAYERS, SSD_HEADS, SSD_HEADDIM, SSD_STATE), 0.1),
        'state_ssd_bwd': nrm(ks[3], (DEC_BATCH, N_SSD_LAYERS, SSD_HEADS, SSD_HEADDIM, SSD_STATE), 0.1),
        'state_gdn_fwd': nrm(ks[4], (DEC_BATCH, N_GDN_LAYERS, GDN_V_HEADS, GDN_HEAD_K, GDN_HEAD_V), 0.1),
        'state_gdn_bwd': nrm(ks[5], (DEC_BATCH, N_GDN_LAYERS, GDN_V_HEADS, GDN_HEAD_K, GDN_HEAD_V), 0.1),
        'c': nrm(ks[6], (DEC_BATCH, D_MODEL), 1.0),
        'c_ctx': nrm(ks[7], (D_MODEL,), 1.0),
        'w_ada': nrm(ks[8], (DEPTH, D_MODEL, 6 * D_MODEL), D_MODEL ** -0.5),
        'b_ada': nrm(ks[9], (DEPTH, 6 * D_MODEL), 0.02),
        'ln_g': 1.0 + nrm(ks[10], (DEPTH, 2, D_MODEL), 0.01),
        'ln_b': nrm(ks[11], (DEPTH, 2, D_MODEL), 0.01),
        'ssd_w_in': nrm(ks[12], (N_SSD_LAYERS, D_MODEL, SSD_IN), D_MODEL ** -0.5),
        'ssd_conv_w': nrm(ks[13], (N_SSD_LAYERS, SSD_CONV, SSD_XBC), SSD_CONV ** -0.5),
        'ssd_conv_b': nrm(ks[14], (N_SSD_LAYERS, SSD_XBC), 0.02),
        'ssd_dt_bias': _dt_bias_init(ks[15], (N_SSD_LAYERS, 2, SSD_HEADS)),
        'ssd_a_log': jnp.log(jax.random.uniform(ks[16], (N_SSD_LAYERS, 2, SSD_HEADS), jnp.float32, 1.0, 16.0)),
        'ssd_d': 1.0 + nrm(ks[17], (N_SSD_LAYERS, SSD_HEADS), 0.1),
        'ssd_norm_w': 1.0 + nrm(ks[18], (N_SSD_LAYERS, SSD_D_INNER), 0.01),
        'ssd_w_out': nrm(ks[19], (N_SSD_LAYERS, SSD_D_INNER, D_MODEL), SSD_D_INNER ** -0.5 * DEEPNORM_BETA),
        'gdn_w_in': nrm(ks[20], (N_GDN_LAYERS, D_MODEL, GDN_IN), D_MODEL ** -0.5),
        'gdn_conv_w': nrm(ks[21], (N_GDN_LAYERS, GDN_CONV, GDN_QKV), GDN_CONV ** -0.5),
        'gdn_dt_bias': _dt_bias_init(ks[22], (N_GDN_LAYERS, 2, GDN_V_HEADS)),
        'gdn_a_log': jnp.log(jax.random.uniform(ks[23], (N_GDN_LAYERS, 2, GDN_V_HEADS), jnp.float32, 1.0, 16.0)),
        'gdn_norm_w': 1.0 + nrm(ks[24], (N_GDN_LAYERS, GDN_HEAD_V), 0.01),
        'gdn_w_out': nrm(ks[25], (N_GDN_LAYERS, GDN_V, D_MODEL), GDN_V ** -0.5 * DEEPNORM_BETA),
        'ffn_w_up': nrm(ks[26], (DEPTH, D_MODEL, 2 * D_FF), D_MODEL ** -0.5),
        'ffn_conv_w': nrm(ks[27], (DEPTH, FFN_CONV, FFN_CONV, D_FF), 1.0 / FFN_CONV),
        'ffn_conv_b': nrm(ks[28], (DEPTH, D_FF), 0.02),
        'ffn_w_down': nrm(ks[29], (DEPTH, D_FF, D_MODEL), D_FF ** -0.5 * DEEPNORM_BETA),
    }


def reference(x_prompt, x_sample, state_ssd_fwd, state_ssd_bwd, state_gdn_fwd, state_gdn_bwd, c, c_ctx,
              w_ada, b_ada, ln_g, ln_b,
              ssd_w_in, ssd_conv_w, ssd_conv_b, ssd_dt_bias, ssd_a_log, ssd_d, ssd_norm_w, ssd_w_out,
              gdn_w_in, gdn_conv_w, gdn_dt_bias, gdn_a_log, gdn_norm_w, gdn_w_out,
              ffn_w_up, ffn_conv_w, ffn_conv_b, ffn_w_down):
    rows = x_sample.shape[1] // GRID_W
    n_prompt = x_prompt.shape[0]
    xp, xs = x_prompt, x_sample
    cond_ctx = c_ctx[None, :]
    new_ssd_f, new_ssd_b, new_gdn_f, new_gdn_b = [], [], [], []
    for i in range(DEPTH):
        sh_mp, sc_mp, gt_mp, sh_fp, sc_fp, gt_fp = adaln_params(cond_ctx, w_ada[i], b_ada[i])
        sh_ms, sc_ms, gt_ms, sh_fs, sc_fs, gt_fs = adaln_params(c, w_ada[i], b_ada[i])
        hp = modulate(xp, sh_mp, sc_mp)
        hs = modulate(xs, sh_ms, sc_ms)
        j = i // N_MIXERS
        if i % N_MIXERS == 0:
            prm = (ssd_w_in[j], ssd_conv_w[j], ssd_conv_b[j], ssd_dt_bias[j], ssd_a_log[j], ssd_d[j],
                   ssd_norm_w[j], ssd_w_out[j])
            zeros = jnp.zeros((n_prompt, SSD_HEADS, SSD_HEADDIM, SSD_STATE), xp.dtype)
            mp, sf, sb = ssd_mixer(hp, zeros, zeros, *prm)
            ms, _, _ = ssd_mixer(hs, state_ssd_fwd[:, j], state_ssd_bwd[:, j], *prm)
            new_ssd_f.append(sf)
            new_ssd_b.append(sb)
        else:
            prm = (gdn_w_in[j], gdn_conv_w[j], gdn_dt_bias[j], gdn_a_log[j], gdn_norm_w[j], gdn_w_out[j])
            zeros = jnp.zeros((n_prompt, GDN_V_HEADS, GDN_HEAD_K, GDN_HEAD_V), xp.dtype)
            mp, sf, sb = gdn_mixer(hp, zeros, zeros, *prm)
            ms, _, _ = gdn_mixer(hs, state_gdn_fwd[:, j], state_gdn_bwd[:, j], *prm)
            new_gdn_f.append(sf)
            new_gdn_b.append(sb)
        xp = layer_norm(DEEPNORM_ALPHA * xp + gt_mp * mp, ln_g[i, 0], ln_b[i, 0])
        xs = layer_norm(DEEPNORM_ALPHA * xs + gt_ms * ms, ln_g[i, 0], ln_b[i, 0])
        fp = conv_glu_ffn(modulate(xp, sh_fp, sc_fp), ffn_w_up[i], ffn_conv_w[i], ffn_conv_b[i], ffn_w_down[i], None)
        fs = conv_glu_ffn(modulate(xs, sh_fs, sc_fs), ffn_w_up[i], ffn_conv_w[i], ffn_conv_b[i], ffn_w_down[i], rows)
        xp = layer_norm(DEEPNORM_ALPHA * xp + gt_fp * fp, ln_g[i, 1], ln_b[i, 1])
        xs = layer_norm(DEEPNORM_ALPHA * xs + gt_fs * fs, ln_g[i, 1], ln_b[i, 1])
    y_prompt = xp
    y_sample = xs
    new_state_ssd_fwd = jnp.stack(new_ssd_f, axis=1)
    new_state_ssd_bwd = jnp.stack(new_ssd_b, axis=1)
    new_state_gdn_fwd = jnp.stack(new_gdn_f, axis=1)
    new_state_gdn_bwd = jnp.stack(new_gdn_b, axis=1)
    return (y_prompt, y_sample, new_state_ssd_fwd, new_state_ssd_bwd, new_state_gdn_fwd, new_state_gdn_bwd)
```

```cpp
#include <hip/hip_runtime.h>
#include <hip/hip_cooperative_groups.h>
#include <cstdio>
#include <cstring>
namespace cg = cooperative_groups;
namespace pg8 {
#define PG8_LAS __attribute__((address_space(3)))
typedef unsigned short bf16_t;
typedef short bf16x8 __attribute__((ext_vector_type(8)));
typedef float f32x4 __attribute__((ext_vector_type(4)));
typedef unsigned u32x4 __attribute__((ext_vector_type(4)));
constexpr int BM = 256, BK = 64, HALF = 128, HTB = HALF * BK * 2  , STAGE_BYTES = 8 * HTB, NXCD = 8, WGM = 8;

__host__ __device__ __forceinline__ int lds_byte(int r, int c) { const int st = (r >> 4) * 2 + (c >> 5), rr = r & 15, cc = c & 31, ob = rr * 64 + cc * 2; return st * 1024 + (ob ^ (((ob >> 9) & 1) << 5)); }
__host__ __device__ __forceinline__ void stage_rc(int b, int& R, int& C) { const int st = b / 1024, sb = b % 1024, swz = sb ^ (((sb >> 9) & 1) << 5); R = (st >> 1) * 16 + swz / 64; C = (st & 1) * 32 + (swz % 64) / 2; }
__host__ __device__ __forceinline__ int perm32(int rho) { const int n = rho >> 4, i = rho & 15; return 8 * (i >> 2) + 4 * n + (i & 3); }

struct Unit { int pm, pn; };
struct Gemm { const bf16_t* A; const bf16_t* Bt; int M, N, K; };

struct StaticOrder {
    int nM, nN, nwg, G, c;
    __host__ __device__ void init(int M, int N, int G_, int c_) { nM = M / BM; nN = N / BM; nwg = nM * nN; G = G_; c = c_; }
    __host__ __device__ bool next(int i, Unit& u) const {
        const long L = (long)i * G + c; if (L >= nwg) return false;
        int wgid = (int)L; { const int q = nwg / NXCD, r = nwg % NXCD, xcd = wgid % NXCD, off = wgid / NXCD; wgid = (xcd < r ? xcd * (q + 1) : r * (q + 1) + (xcd - r) * q) + off; }
        const int nig = WGM * nN, gid = wgid / nig, fm = gid * WGM, gsz = (nM - fm) < WGM ? (nM - fm) : WGM;
        u.pm = fm + ((wgid % nig) % gsz); u.pn = (wgid % nig) / gsz; return true;
    }
    __device__ __forceinline__ void a_ready(const Unit&) const {}
    __device__ __forceinline__ void done(const Unit&) const {}
};
__device__ __forceinline__ unsigned cvt_pk_bf16(float lo, float hi) { unsigned r; asm volatile("v_cvt_pk_bf16_f32 %0, %1, %2" : "=v"(r) : "v"(lo), "v"(hi)); return r; }
typedef unsigned u32x4 __attribute__((ext_vector_type(4)));
struct EpiF32 {
    static constexpr bool PERM = false, AFTER_DRAIN = false;
    float* C; int ldc;
    __device__ __forceinline__ void operator()(const f32x4 (&acc)[2][2][4][2], const Unit& u, int wr, int wc, int fr, int fq) const {
        const int row0 = u.pm * BM + wr * 64 + fr, col0 = u.pn * BM + wc * 32 + 4 * fq;
#pragma unroll
        for (int ai = 0; ai < 2; ++ai)
#pragma unroll
            for (int m = 0; m < 4; ++m) { float* rowp = C + (size_t)(row0 + ai * HALF + m * 16) * ldc + col0;
#pragma unroll
                for (int bj = 0; bj < 2; ++bj)
#pragma unroll
                    for (int n = 0; n < 2; ++n) *(f32x4*)(rowp + bj * HALF + n * 16) = acc[ai][bj][m][n]; }
    }
};
struct EpiBf16 {
    static constexpr bool PERM = true, AFTER_DRAIN = false;
    bf16_t* O; int ldc;
    __device__ __forceinline__ void operator()(const f32x4 (&acc)[2][2][4][2], const Unit& u, int wr, int wc, int fr, int fq) const {
        const int row0 = u.pm * BM + wr * 64 + fr, col0 = u.pn * BM + wc * 32 + 8 * fq;
#pragma unroll
        for (int ai = 0; ai < 2; ++ai)
#pragma unroll
            for (int m = 0; m < 4; ++m) { bf16_t* rowp = O + (size_t)(row0 + ai * HALF + m * 16) * ldc + col0;
#pragma unroll
                for (int bj = 0; bj < 2; ++bj) { const f32x4 v0 = acc[ai][bj][m][0], v1 = acc[ai][bj][m][1];
                    u32x4 w; w.x = cvt_pk_bf16(v0[0], v0[1]); w.y = cvt_pk_bf16(v0[2], v0[3]); w.z = cvt_pk_bf16(v1[0], v1[1]); w.w = cvt_pk_bf16(v1[2], v1[3]);
                    *(u32x4*)(rowp + bj * HALF) = w; } }
    }
};
template <class Epi, class Sched, bool STAMP = false>
__device__ __forceinline__ void gemm_phase(PG8_LAS unsigned char* lds, const Gemm g, const Sched& S, const Epi& E, unsigned long long* stamps) {
    int tid_ = threadIdx.x; asm volatile("" : "+v"(tid_)); const int tid = tid_, wid = __builtin_amdgcn_readfirstlane(tid >> 6), lane = tid & 63, wr = wid >> 2, wc = wid & 3, fr = lane & 15, fq = lane >> 4;
    const int K = g.K, nt = K / BK;
    int ts_lo = 0, ts_hi = 0, nts = 0; const unsigned long long rt_entry = STAMP ? (unsigned long long)wall_clock64() : 0ull;
#define PG8_STAMP() do { if (STAMP && wid == 0 && nts < 64) { const unsigned long long _c = (unsigned long long)clock64(); \
        ts_lo = (lane == nts) ? (int)(unsigned)_c : ts_lo; ts_hi = (lane == nts) ? (int)(unsigned)(_c >> 32) : ts_hi; ++nts; } } while (0)
    PG8_STAMP();
    unsigned voffA[2], voffB[2];
#pragma unroll
    for (int i = 0; i < 2; ++i) { int R, C; stage_rc(tid * 16 + i * 8192, R, C); const int Rb = Epi::PERM ? ((R & ~31) + perm32(R & 31)) : R;
        voffA[i] = (unsigned)(R * K + C) * 2u; voffB[i] = (unsigned)(Rb * K + C) * 2u; }
    const size_t kstep = (size_t)(BK * 2);
    const size_t hstep = (size_t)HALF * K * 2;
    const size_t tstep = 2 * hstep;
    const unsigned ldsw = (unsigned)wid * 1024u;
    const int aoff = lds_byte(wr * 64 + fr, fq * 8), boff = lds_byte(wc * 32 + fr, fq * 8);
#define PG8_SA(b, h) (((b) * 2 + (h)) * HTB)
#define PG8_SB(b, h) ((4 + (b) * 2 + (h)) * HTB)
#define PG8_STAGE(bufoff, gbase, voff) do { _Pragma("unroll") for (int _i = 0; _i < 2; ++_i) \
        __builtin_amdgcn_global_load_lds((const unsigned*)((const char*)(gbase) + (voff)[_i]), (PG8_LAS unsigned*)(lds + (bufoff) + ldsw + _i * 8192), 16, 0, 0); } while (0)
#define PG8_LDA(dst, b, h) do { _Pragma("unroll") for (int m = 0; m < 4; ++m) _Pragma("unroll") for (int k = 0; k < 2; ++k) dst[m][k] = *(const PG8_LAS bf16x8*)(lds + PG8_SA(b, h) + aoff + m * 2048 + k * 1024); } while (0)
#define PG8_LDB(dst, b, h) do { _Pragma("unroll") for (int n = 0; n < 2; ++n) _Pragma("unroll") for (int k = 0; k < 2; ++k) dst[n][k] = *(const PG8_LAS bf16x8*)(lds + PG8_SB(b, h) + boff + n * 2048 + k * 1024); } while (0)
#define PG8_MMA(ai, bj, At, Bt) do { __builtin_amdgcn_s_setprio(1); _Pragma("unroll") for (int m = 0; m < 4; ++m) _Pragma("unroll") for (int n = 0; n < 2; ++n) _Pragma("unroll") for (int k = 0; k < 2; ++k) \
        acc[ai][bj][m][n] = __builtin_amdgcn_mfma_f32_16x16x32_bf16(Bt[n][k], At[m][k], acc[ai][bj][m][n], 0, 0, 0); __builtin_amdgcn_s_setprio(0); } while (0)
#define PG8_WAIT_V(n) asm volatile("s_waitcnt vmcnt(" #n ")" ::: "memory")
#define PG8_WAIT_L(n) asm volatile("s_waitcnt lgkmcnt(" #n ")" ::: "memory")
#define PG8_BAR __builtin_amdgcn_s_barrier()
#define PG8_SCHED __builtin_amdgcn_sched_barrier(0)
    Unit cur, nxt; int ui = 0;
    if (!S.next(0, cur)) return;
    f32x4 acc[2][2][4][2];
#pragma unroll
    for (int a = 0; a < 2; ++a)
#pragma unroll
        for (int b = 0; b < 2; ++b)
#pragma unroll
            for (int m = 0; m < 4; ++m)
#pragma unroll
                for (int n = 0; n < 2; ++n) acc[a][b][m][n] = (f32x4){0.f, 0.f, 0.f, 0.f};
    bf16x8 At[4][2], B0[2][2], B1[2][2];
    const char* cA = (const char*)g.A + (size_t)cur.pm * tstep; const char* cB = (const char*)g.Bt + (size_t)cur.pn * tstep;
    S.a_ready(cur);
    PG8_STAGE(PG8_SB(0, 0), cB, voffB); PG8_STAGE(PG8_SA(0, 0), cA, voffA); PG8_STAGE(PG8_SB(0, 1), cB + hstep, voffB); PG8_STAGE(PG8_SA(0, 1), cA + hstep, voffA);
    if (wr == 1) PG8_BAR;
    PG8_WAIT_V(4); PG8_BAR;
    PG8_STAGE(PG8_SB(1, 0), cB + kstep, voffB); PG8_STAGE(PG8_SA(1, 0), cA + kstep, voffA); PG8_STAGE(PG8_SB(1, 1), cB + hstep + kstep, voffB);
    PG8_WAIT_V(6); PG8_BAR;
    PG8_STAMP();
    for (;;) {
        const bool has_next = S.next(ui + 1, nxt);
        const char* nA = has_next ? (const char*)g.A + (size_t)nxt.pm * tstep : cA; const char* nB = has_next ? (const char*)g.Bt + (size_t)nxt.pn * tstep : cB;
        for (int t = 0; t < nt; t += 2) {
            const bool last = (t == nt - 2);
            const char* a1 = cA + (size_t)(t + 1) * kstep;
            const char* a2 = last ? nA : cA + (size_t)(t + 2) * kstep; const char* b2 = last ? nB : cB + (size_t)(t + 2) * kstep;
            const char* a3 = a2 + kstep; const char* b3 = b2 + kstep;
            if (last && has_next) S.a_ready(nxt);
            PG8_LDB(B0, 0, 0); PG8_SCHED; PG8_LDA(At, 0, 0); PG8_STAGE(PG8_SA(1, 1), a1 + hstep, voffA);
            PG8_WAIT_L(8); PG8_BAR; PG8_WAIT_L(0); PG8_MMA(0, 0, At, B0); PG8_BAR; PG8_SCHED;
            PG8_LDB(B1, 0, 1); PG8_STAGE(PG8_SB(0, 0), b2, voffB);
            PG8_BAR; PG8_WAIT_L(0); PG8_MMA(0, 1, At, B1); PG8_BAR;
            PG8_LDA(At, 0, 1); PG8_STAGE(PG8_SA(0, 0), a2, voffA);
            PG8_BAR; PG8_WAIT_L(0); PG8_MMA(1, 0, At, B0); PG8_BAR; PG8_SCHED;
            PG8_STAGE(PG8_SB(0, 1), b2 + hstep, voffB);
            PG8_WAIT_V(6); PG8_BAR; PG8_MMA(1, 1, At, B1); PG8_BAR;
            PG8_LDB(B0, 1, 0); PG8_SCHED; PG8_LDA(At, 1, 0); PG8_STAGE(PG8_SA(0, 1), a2 + hstep, voffA);
            PG8_WAIT_L(8); PG8_BAR; PG8_WAIT_L(0); PG8_MMA(0, 0, At, B0); PG8_BAR; PG8_SCHED;
            PG8_LDB(B1, 1, 1); PG8_STAGE(PG8_SB(1, 0), b3, voffB);
            PG8_BAR; PG8_WAIT_L(0); PG8_MMA(0, 1, At, B1); PG8_BAR;
            PG8_LDA(At, 1, 1); PG8_STAGE(PG8_SA(1, 0), a3, voffA);
            PG8_BAR; PG8_WAIT_L(0); PG8_MMA(1, 0, At, B0); PG8_BAR; PG8_SCHED;
            PG8_STAGE(PG8_SB(1, 1), b3 + hstep, voffB);
            PG8_WAIT_V(6); PG8_BAR; PG8_MMA(1, 1, At, B1); PG8_BAR;
        }
        PG8_STAMP();
        if constexpr (!Epi::AFTER_DRAIN) { E(acc, cur, wr, wc, fr, fq); S.done(cur); }
        PG8_STAMP();
        if (!has_next) break;
#pragma unroll
        for (int a = 0; a < 2; ++a)
#pragma unroll
            for (int b = 0; b < 2; ++b)
#pragma unroll
                for (int m = 0; m < 4; ++m)
#pragma unroll
                    for (int n = 0; n < 2; ++n) acc[a][b][m][n] = (f32x4){0.f, 0.f, 0.f, 0.f};
        cur = nxt; cA = nA; cB = nB; ++ui;
    }
    PG8_WAIT_V(0);
    if (wr == 0) PG8_BAR;
    PG8_BAR;
    if constexpr (Epi::AFTER_DRAIN) { E.fused(acc, cur, wr, wc, fr, fq, lds, wid, lane); S.done(cur); }
    PG8_STAMP();
    if (STAMP && wid == 0) { stamps[lane] = lane < nts ? (((unsigned long long)(unsigned)ts_hi << 32) | (unsigned)ts_lo) : 0ull;
        if (lane == 62) stamps[62] = rt_entry; if (lane == 63) stamps[63] = (unsigned long long)wall_clock64(); }
#undef PG8_STAMP
#undef PG8_SA
#undef PG8_SB
#undef PG8_STAGE
#undef PG8_LDA
#undef PG8_LDB
#undef PG8_MMA
#undef PG8_WAIT_V
#undef PG8_WAIT_L
#undef PG8_BAR
#undef PG8_SCHED
}
}

typedef unsigned short u16;
constexpr int D = 1024, T_ALL = 24576, TG = 8192, NGRP = 3;
constexpr int NINP = 6400, DI = 2048, FF = 2816, FF2 = 5632;
constexpr int NTHREADS = 512, LDS_BYTES = 131072;
constexpr float ALPHA = 1.4142135623730951f;
constexpr size_t WS_ADA = 0;
constexpr size_t WS_W = 524288;
constexpr size_t W_IN = 0, W_OUT = W_IN + (size_t)NINP * D * 2, W_UP = W_OUT + (size_t)D * DI * 2, W_DN = W_UP + (size_t)FF2 * D * 2, W_LAYER = W_DN + (size_t)D * FF * 2;
constexpr size_t WS_H = WS_W + 2 * W_LAYER;
constexpr size_t WS_P = WS_H + (size_t)T_ALL * D * 2;
constexpr size_t WS_G = WS_P + (size_t)TG * NINP * 2;
constexpr size_t WS_YB = WS_G + (size_t)TG * FF * 2;
constexpr size_t WS_END = WS_YB + (size_t)TG * DI * 2;
constexpr size_t OUT_SSD_F = (size_t)T_ALL * D, OUT_SSD_B = OUT_SSD_F + 8388608, OUT_GDN_F = OUT_SSD_B + 8388608, OUT_GDN_B = OUT_GDN_F + 8388608;
constexpr int NPHASES = 2 + 2 * NGRP * 9;

struct Params {
    const float *x_prompt, *x_sample, *st_ssd_f, *st_ssd_b, *st_gdn_f, *st_gdn_b, *c, *c_ctx, *w_ada, *b_ada, *ln_g, *ln_b,
        *ssd_w_in, *ssd_conv_w, *ssd_conv_b, *ssd_dt_bias, *ssd_a_log, *ssd_d, *ssd_norm_w, *ssd_w_out,
        *gdn_w_in, *gdn_conv_w, *gdn_dt_bias, *gdn_a_log, *gdn_norm_w, *gdn_w_out,
        *ffn_w_up, *ffn_conv_w, *ffn_conv_b, *ffn_w_down;
    float* out; unsigned char* ws; int ph_lo, ph_hi;
};

__device__ __forceinline__ int otid() { int t = threadIdx.x; asm volatile("" : "+v"(t)); return t; }
__device__ __forceinline__ float bf2f(u16 b) { return __uint_as_float(((unsigned)b) << 16); }
__device__ __forceinline__ unsigned pk2(float lo, float hi) { return pg8::cvt_pk_bf16(lo, hi); }
__device__ __forceinline__ float siluf(float x) { return x / (1.f + __expf(-x)); }
__device__ __forceinline__ float softplusf(float x) { return x > 20.f ? x : log1pf(__expf(x)); }
__device__ __forceinline__ void unpack8(const uint4 v, float* f) {
    f[0] = __uint_as_float(v.x << 16); f[1] = __uint_as_float(v.x & 0xffff0000u); f[2] = __uint_as_float(v.y << 16); f[3] = __uint_as_float(v.y & 0xffff0000u);
    f[4] = __uint_as_float(v.z << 16); f[5] = __uint_as_float(v.z & 0xffff0000u); f[6] = __uint_as_float(v.w << 16); f[7] = __uint_as_float(v.w & 0xffff0000u);
}
__device__ __forceinline__ void unpack4(const uint2 v, float* f) {
    f[0] = __uint_as_float(v.x << 16); f[1] = __uint_as_float(v.x & 0xffff0000u); f[2] = __uint_as_float(v.y << 16); f[3] = __uint_as_float(v.y & 0xffff0000u);
}
__device__ __forceinline__ uint4 pack8(const float* f) { uint4 r; r.x = pk2(f[0], f[1]); r.y = pk2(f[2], f[3]); r.z = pk2(f[4], f[5]); r.w = pk2(f[6], f[7]); return r; }
__device__ __forceinline__ int cond_of(int t) { return t < 8192 ? 0 : 1 + ((t - 8192) >> 11); }
__device__ __forceinline__ const float* xin_row(const Params& p, int t) { return t < 8192 ? p.x_prompt + (size_t)t * D : p.x_sample + (size_t)(t - 8192) * D; }
__device__ __forceinline__ float wave_sum(float v) {
    v += __shfl_xor(v, 1); v += __shfl_xor(v, 2); v += __shfl_xor(v, 4); v += __shfl_xor(v, 8); v += __shfl_xor(v, 16); v += __shfl_xor(v, 32); return v;
}

__device__ __forceinline__ void wprep(const float* __restrict__ src, u16* __restrict__ dst, int K, int N, int Npad, float* tile) {
    const int tid = otid(); const int nkt = K >> 6, nnt = Npad >> 6;
    for (int t = blockIdx.x; t < nkt * nnt; t += gridDim.x) {
        const int kt = t % nkt, nt = t / nkt; const int k0 = kt * 64, n0 = nt * 64;
#pragma unroll
        for (int e = 0; e < 8; ++e) { const int idx = e * 512 + tid; const int kk = idx >> 6, nn = idx & 63; float v = 0.f;
            if (n0 + nn < N) v = src[(size_t)(k0 + kk) * N + n0 + nn];
            tile[kk * 65 + nn] = v; }
        __syncthreads();
#pragma unroll
        for (int e = 0; e < 4; ++e) { const int idx = e * 512 + tid; const int nn = idx >> 5, kp = idx & 31;
            const unsigned w = pk2(tile[(2 * kp) * 65 + nn], tile[(2 * kp + 1) * 65 + nn]);
            *(unsigned*)(dst + (size_t)(n0 + nn) * K + k0 + 2 * kp) = w; }
        __syncthreads();
    }
}
__device__ __forceinline__ void adaln_phase(const Params& p, float* lds) {
    float* s = lds; float* red = lds + 9 * 1024;
    const int tid = otid(), wave = tid >> 6, lane = tid & 63;
    if ((int)blockIdx.x >= 192) return;
    for (int i = tid; i < 9 * 1024; i += NTHREADS) { const int c = i >> 10, k = i & 1023; const float v = c == 0 ? p.c_ctx[k] : p.c[(c - 1) * 1024 + k]; s[i] = siluf(v); }
    __syncthreads();
    float* ada = (float*)(p.ws + WS_ADA);
    for (int ch = blockIdx.x; ch < 192; ch += gridDim.x) {
        const int l = ch / 96, col0 = (ch % 96) * 64;
        const float* w = p.w_ada + (size_t)l * 1024 * 6144 + col0 + lane;
        float acc[9];
#pragma unroll
        for (int c = 0; c < 9; ++c) acc[c] = 0.f;
#pragma unroll 8
        for (int k = wave * 128; k < wave * 128 + 128; ++k) { const float wv = w[(size_t)k * 6144];
#pragma unroll
            for (int c = 0; c < 9; ++c) acc[c] += s[c * 1024 + k] * wv; }
#pragma unroll
        for (int c = 0; c < 9; ++c) red[(wave * 9 + c) * 64 + lane] = acc[c];
        __syncthreads();
        for (int i = tid; i < 576; i += NTHREADS) { const int c = i >> 6, col = i & 63; float v = p.b_ada[l * 6144 + col0 + col];
#pragma unroll
            for (int w8 = 0; w8 < 8; ++w8) v += red[(w8 * 9 + c) * 64 + col];
            ada[(size_t)(l * 9 + c) * 6144 + col0 + col] = v; }
        __syncthreads();
    }
}
__device__ __forceinline__ void prep_phase(const Params& p, float* lds) {
    adaln_phase(p, lds);
    __syncthreads();
    for (int l = 0; l < 2; ++l) {
        u16* wb = (u16*)(p.ws + WS_W + (size_t)l * W_LAYER);
        wprep(l == 0 ? p.ssd_w_in : p.gdn_w_in, wb + W_IN / 2, 1024, 6208, NINP, lds);
        wprep(l == 0 ? p.ssd_w_out : p.gdn_w_out, wb + W_OUT / 2, 2048, 1024, 1024, lds);
        wprep(p.ffn_w_up + (size_t)l * 1024 * FF2, wb + W_UP / 2, 1024, FF2, FF2, lds);
        wprep(p.ffn_w_down + (size_t)l * FF * 1024, wb + W_DN / 2, FF, 1024, 1024, lds);
    }
}
__device__ __forceinline__ void mod0_phase(const Params& p) {
    const float* ada = (const float*)(p.ws + WS_ADA); u16* H = (u16*)(p.ws + WS_H);
    for (size_t i = (size_t)blockIdx.x * NTHREADS + otid(); i < (size_t)T_ALL * 256; i += (size_t)gridDim.x * NTHREADS) {
        const int t = (int)(i >> 8), c = (int)(i & 255) * 4;
        const float4 x = *(const float4*)(xin_row(p, t) + c);
        const float* a = ada + (size_t)cond_of(t) * 6144;
        const float4 sh = *(const float4*)(a + c), sc = *(const float4*)(a + 1024 + c);
        uint2 w; w.x = pk2(x.x * (1.f + sc.x) + sh.x, x.y * (1.f + sc.y) + sh.y); w.y = pk2(x.z * (1.f + sc.z) + sh.z, x.w * (1.f + sc.w) + sh.w);
        *(uint2*)(H + (size_t)t * D + c) = w;
    }
}
__device__ __forceinline__ void conv8(const u16* r1, int rs, bool hm, bool hp, const float* w, int wstride, float* o) {
    const uint4 z = {0u, 0u, 0u, 0u};
    const uint4 v0 = hm ? *(const uint4*)(r1 - rs) : z, v1 = *(const uint4*)r1, v2 = hp ? *(const uint4*)(r1 + rs) : z;
    float a0[8], a1[8], a2[8]; unpack8(v0, a0); unpack8(v1, a1); unpack8(v2, a2);
    float w0[8], w1[8], w2[8];
    *(float4*)w0 = *(const float4*)w; *(float4*)(w0 + 4) = *(const float4*)(w + 4);
    *(float4*)w1 = *(const float4*)(w + wstride); *(float4*)(w1 + 4) = *(const float4*)(w + wstride + 4);
    *(float4*)w2 = *(const float4*)(w + 2 * wstride); *(float4*)(w2 + 4) = *(const float4*)(w + 2 * wstride + 4);
#pragma unroll
    for (int j = 0; j < 8; ++j) o[j] = w0[j] * a0[j] + w1[j] * a1[j] + w2[j] * a2[j];
}
__device__ __forceinline__ void conv4(const u16* r1, int rs, bool hm, bool hp, const float* w, int wstride, float* o) {
    const uint2 z = {0u, 0u};
    const uint2 v0 = hm ? *(const uint2*)(r1 - rs) : z, v1 = *(const uint2*)r1, v2 = hp ? *(const uint2*)(r1 + rs) : z;
    float a0[4], a1[4], a2[4]; unpack4(v0, a0); unpack4(v1, a1); unpack4(v2, a2);
    const float4 w0 = *(const float4*)w, w1 = *(const float4*)(w + wstride), w2 = *(const float4*)(w + 2 * wstride);
    o[0] = w0.x * a0[0] + w1.x * a1[0] + w2.x * a2[0]; o[1] = w0.y * a0[1] + w1.y * a1[1] + w2.y * a2[1];
    o[2] = w0.z * a0[2] + w1.z * a1[2] + w2.z * a2[2]; o[3] = w0.w * a0[3] + w1.w * a1[3] + w2.w * a2[3];
}
__device__ __forceinline__ void ssd_scan_phase(const Params& p, int g, float* lds) {
    const int tid = otid(), wave = tid >> 6, lane = tid & 63;
    const int L = g == 0 ? 256 : 2048, nseq = g == 0 ? 32 : 4, nitems = nseq * 64;
    float* Bs = lds; float* Cs = lds + 4096; float* xs = lds + 8192; float* ybuf = lds + 10240; float* dts = lds + 12288; float* dAs = lds + 12320;
    const u16* P = (const u16*)(p.ws + WS_P);
    const int tok = tid >> 4, cgi = tid & 15;
    const int pl = lane >> 3, ng = lane & 7, pp = wave * 8 + pl;
    for (int item = blockIdx.x; item < nitems; item += gridDim.x) {
        const int d = item & 1, h = (item >> 1) & 31, seq = item >> 6, grp = h >> 2;
        const int row0 = seq * L;
        const float a_neg = -__expf(p.ssd_a_log[d * 32 + h]), dtb = p.ssd_dt_bias[d * 32 + h], dskip = d == 0 ? p.ssd_d[h] : 0.f;
        float S[16];
        if (g == 0) {
#pragma unroll
            for (int i = 0; i < 16; ++i) S[i] = 0.f;
        } else {
            const float* s0 = (d ? p.st_ssd_b : p.st_ssd_f) + ((size_t)(((g - 1) * 4 + seq) * 32 + h) * 64 + pp) * 128;
#pragma unroll
            for (int i = 0; i < 4; ++i) { const float4 v = *(const float4*)(s0 + 32 * i + 4 * ng); S[4 * i] = v.x; S[4 * i + 1] = v.y; S[4 * i + 2] = v.z; S[4 * i + 3] = v.w; }
        }
        const int chx = h * 64 + cgi * 4, chb = 2048 + grp * 128 + cgi * 8, chc = 3072 + grp * 128 + cgi * 8;
        u16* ydst = (u16*)(p.ws + (d ? WS_YB : WS_G));
        for (int tile = 0; tile < L / 32; ++tile) {
            const int sidx = tile * 32 + tok; const int tp = d ? L - 1 - sidx : sidx;
            {
                const u16* r1 = P + (size_t)(row0 + tp) * NINP + 2048;
                const bool hm = tp > 0, hp = tp < L - 1;
                float o4[4]; conv4(r1 + chx, NINP, hm, hp, p.ssd_conv_w + chx, 4096, o4);
                const float4 bx = *(const float4*)(p.ssd_conv_b + chx);
                float4 xo; xo.x = siluf(o4[0] + bx.x); xo.y = siluf(o4[1] + bx.y); xo.z = siluf(o4[2] + bx.z); xo.w = siluf(o4[3] + bx.w);
                *(float4*)(xs + tok * 64 + cgi * 4) = xo;
                float o8[8], bb[8];
                conv8(r1 + chb, NINP, hm, hp, p.ssd_conv_w + chb, 4096, o8);
                *(float4*)bb = *(const float4*)(p.ssd_conv_b + chb); *(float4*)(bb + 4) = *(const float4*)(p.ssd_conv_b + chb + 4);
#pragma unroll
                for (int j = 0; j < 8; ++j) o8[j] = siluf(o8[j] + bb[j]);
                *(float4*)(Bs + tok * 128 + cgi * 8) = *(float4*)o8; *(float4*)(Bs + tok * 128 + cgi * 8 + 4) = *(float4*)(o8 + 4);
                conv8(r1 + chc, NINP, hm, hp, p.ssd_conv_w + chc, 4096, o8);
                *(float4*)bb = *(const float4*)(p.ssd_conv_b + chc); *(float4*)(bb + 4) = *(const float4*)(p.ssd_conv_b + chc + 4);
#pragma unroll
                for (int j = 0; j < 8; ++j) o8[j] = siluf(o8[j] + bb[j]);
                *(float4*)(Cs + tok * 128 + cgi * 8) = *(float4*)o8; *(float4*)(Cs + tok * 128 + cgi * 8 + 4) = *(float4*)(o8 + 4);
                if (cgi == 0) { const float raw = bf2f(P[(size_t)(row0 + tp) * NINP + 6144 + d * 32 + h]); const float dt = softplusf(raw + dtb); dts[tok] = dt; dAs[tok] = __expf(dt * a_neg); }
            }
            __syncthreads();
            for (int tt = 0; tt < 32; ++tt) {
                const float dA = dAs[tt], x = xs[tt * 64 + pp]; const float xdt = x * dts[tt];
                float acc = 0.f;
#pragma unroll
                for (int i = 0; i < 4; ++i) {
                    const float4 b = *(const float4*)(Bs + tt * 128 + 32 * i + 4 * ng), c = *(const float4*)(Cs + tt * 128 + 32 * i + 4 * ng);
                    S[4 * i] = S[4 * i] * dA + xdt * b.x; S[4 * i + 1] = S[4 * i + 1] * dA + xdt * b.y; S[4 * i + 2] = S[4 * i + 2] * dA + xdt * b.z; S[4 * i + 3] = S[4 * i + 3] * dA + xdt * b.w;
                    acc += S[4 * i] * c.x + S[4 * i + 1] * c.y + S[4 * i + 2] * c.z + S[4 * i + 3] * c.w;
                }
                acc += __shfl_xor(acc, 1); acc += __shfl_xor(acc, 2); acc += __shfl_xor(acc, 4);
                if (ng == 0) ybuf[tt * 64 + pp] = acc + dskip * x;
            }
            __syncthreads();
            {   const float4 y = *(const float4*)(ybuf + tok * 64 + cgi * 4); uint2 w; w.x = pk2(y.x, y.y); w.y = pk2(y.z, y.w);
                *(uint2*)(ydst + (size_t)(row0 + tp) * DI + h * 64 + cgi * 4) = w; }
        }
        if (g == 0) {
            float* so = p.out + (d ? OUT_SSD_B : OUT_SSD_F) + ((size_t)(seq * 32 + h) * 64 + pp) * 128;
#pragma unroll
            for (int i = 0; i < 4; ++i) { float4 v; v.x = S[4 * i]; v.y = S[4 * i + 1]; v.z = S[4 * i + 2]; v.w = S[4 * i + 3]; *(float4*)(so + 32 * i + 4 * ng) = v; }
        }
        __syncthreads();
    }
}
__device__ __forceinline__ void ssd_combine_phase(const Params& p) {
    const int tid = otid(), wave = tid >> 6, lane = tid & 63;
    u16* YF = (u16*)(p.ws + WS_G); const u16* YB = (const u16*)(p.ws + WS_YB); const u16* P = (const u16*)(p.ws + WS_P);
    for (int row = blockIdx.x * 8 + wave; row < TG; row += gridDim.x * 8) {
        float gv[32]; float ss = 0.f;
#pragma unroll
        for (int i = 0; i < 4; ++i) { const int c = i * 512 + lane * 8;
            float a[8], b[8], z[8]; unpack8(*(const uint4*)(YF + (size_t)row * DI + c), a); unpack8(*(const uint4*)(YB + (size_t)row * DI + c), b); unpack8(*(const uint4*)(P + (size_t)row * NINP + c), z);
#pragma unroll
            for (int j = 0; j < 8; ++j) { const float v = (a[j] + b[j]) * siluf(z[j]); gv[i * 8 + j] = v; ss += v * v; } }
        ss = wave_sum(ss);
        const float r = rsqrtf(ss * (1.f / 2048.f) + 1e-6f);
#pragma unroll
        for (int i = 0; i < 4; ++i) { const int c = i * 512 + lane * 8; float nw[8], o[8];
            *(float4*)nw = *(const float4*)(p.ssd_norm_w + c); *(float4*)(nw + 4) = *(const float4*)(p.ssd_norm_w + c + 4);
#pragma unroll
            for (int j = 0; j < 8; ++j) o[j] = gv[i * 8 + j] * r * nw[j];
            *(uint4*)(YF + (size_t)row * DI + c) = pack8(o); }
    }
}
__device__ __forceinline__ void gdn_scan_phase(const Params& p, int g, float* lds) {
    const int tid = otid(), wave = tid >> 6, lane = tid & 63;
    const int L = g == 0 ? 256 : 2048, nseq = g == 0 ? 32 : 4, nitems = nseq * 64;
    float* qs = lds; float* ks = lds + 4096; float* vs = lds + 8192; float* obuf = lds + 10240; float* egs = lds + 12288; float* betas = lds + 12320; float* kqs = lds + 12352;
    const u16* P = (const u16*)(p.ws + WS_P);
    const int tok = tid >> 4, cgi = tid & 15;
    const int dvl = lane >> 3, dkg = lane & 7, dv = wave * 8 + dvl;
    for (int item = blockIdx.x; item < nitems; item += gridDim.x) {
        const int e = item & 1, d = (item >> 1) & 1, hv = (item >> 2) & 15, seq = item >> 6, kh = hv >> 1;
        const int row0 = seq * L;
        const float a_neg = -__expf(p.gdn_a_log[d * 16 + hv]), dtb = p.gdn_dt_bias[d * 16 + hv];
        float S[16];
        if (g == 0) {
#pragma unroll
            for (int i = 0; i < 16; ++i) S[i] = 0.f;
        } else {
            const float* s0 = (d ? p.st_gdn_b : p.st_gdn_f) + (size_t)(((g - 1) * 4 + seq) * 16 + hv) * 16384 + e * 64 + dv;
#pragma unroll
            for (int i = 0; i < 4; ++i)
#pragma unroll
                for (int j = 0; j < 4; ++j) S[4 * i + j] = s0[(size_t)(32 * i + 4 * dkg + j) * 128];
        }
        const int chq = kh * 128 + cgi * 8, chk = 1024 + kh * 128 + cgi * 8, chv = 2048 + hv * 128 + e * 64 + cgi * 4;
        u16* odst = (u16*)(p.ws + (d ? WS_YB : WS_G));
        for (int tile = 0; tile < L / 32; ++tile) {
            const int sidx = tile * 32 + tok; const int tp = d ? L - 1 - sidx : sidx;
            {
                const u16* r1 = P + (size_t)(row0 + tp) * NINP;
                const bool hm = tp > 0, hp = tp < L - 1;
                float q8[8], k8[8], v4[4];
                conv8(r1 + chq, NINP, hm, hp, p.gdn_conv_w + chq, 4096, q8);
                conv8(r1 + chk, NINP, hm, hp, p.gdn_conv_w + chk, 4096, k8);
                conv4(r1 + chv, NINP, hm, hp, p.gdn_conv_w + chv, 4096, v4);
                float sq = 0.f, sk = 0.f;
#pragma unroll
                for (int j = 0; j < 8; ++j) { q8[j] = siluf(q8[j]); k8[j] = siluf(k8[j]); sq += q8[j] * q8[j]; sk += k8[j] * k8[j]; }
                sq += __shfl_xor(sq, 1); sq += __shfl_xor(sq, 2); sq += __shfl_xor(sq, 4); sq += __shfl_xor(sq, 8);
                sk += __shfl_xor(sk, 1); sk += __shfl_xor(sk, 2); sk += __shfl_xor(sk, 4); sk += __shfl_xor(sk, 8);
                const float rq = rsqrtf(sq + 1e-6f) * 0.08838834764831845f, rk = rsqrtf(sk + 1e-6f);
                float kq = 0.f;
#pragma unroll
                for (int j = 0; j < 8; ++j) { q8[j] *= rq; k8[j] *= rk; kq += q8[j] * k8[j]; }
                kq += __shfl_xor(kq, 1); kq += __shfl_xor(kq, 2); kq += __shfl_xor(kq, 4); kq += __shfl_xor(kq, 8);
                *(float4*)(qs + tok * 128 + cgi * 8) = *(float4*)q8; *(float4*)(qs + tok * 128 + cgi * 8 + 4) = *(float4*)(q8 + 4);
                *(float4*)(ks + tok * 128 + cgi * 8) = *(float4*)k8; *(float4*)(ks + tok * 128 + cgi * 8 + 4) = *(float4*)(k8 + 4);
                float4 vo; vo.x = siluf(v4[0]); vo.y = siluf(v4[1]); vo.z = siluf(v4[2]); vo.w = siluf(v4[3]);
                *(float4*)(vs + tok * 64 + cgi * 4) = vo;
                if (cgi == 0) {
                    const float a_raw = bf2f(r1[6144 + d * 16 + hv]), b_raw = bf2f(r1[6176 + d * 16 + hv]);
                    egs[tok] = __expf(a_neg * softplusf(a_raw + dtb)); betas[tok] = 1.f / (1.f + __expf(-b_raw)); kqs[tok] = kq;
                }
            }
            __syncthreads();
            for (int tt = 0; tt < 32; ++tt) {
                const float eg = egs[tt], be = betas[tt], kq = kqs[tt], v = vs[tt * 64 + dv];
                float kk[16]; float u = 0.f, w = 0.f;
#pragma unroll
                for (int i = 0; i < 4; ++i) {
                    const float4 k4 = *(const float4*)(ks + tt * 128 + 32 * i + 4 * dkg), q4 = *(const float4*)(qs + tt * 128 + 32 * i + 4 * dkg);
                    kk[4 * i] = k4.x; kk[4 * i + 1] = k4.y; kk[4 * i + 2] = k4.z; kk[4 * i + 3] = k4.w;
                    u += S[4 * i] * k4.x + S[4 * i + 1] * k4.y + S[4 * i + 2] * k4.z + S[4 * i + 3] * k4.w;
                    w += S[4 * i] * q4.x + S[4 * i + 1] * q4.y + S[4 * i + 2] * q4.z + S[4 * i + 3] * q4.w;
                }
                u += __shfl_xor(u, 1); w += __shfl_xor(w, 1); u += __shfl_xor(u, 2); w += __shfl_xor(w, 2); u += __shfl_xor(u, 4); w += __shfl_xor(w, 4);
                const float delta = be * (v - eg * u);
#pragma unroll
                for (int i = 0; i < 16; ++i) S[i] = S[i] * eg + kk[i] * delta;
                if (dkg == 0) obuf[tt * 64 + dv] = eg * w + delta * kq;
            }
            __syncthreads();
            {   const float4 y = *(const float4*)(obuf + tok * 64 + cgi * 4); uint2 w; w.x = pk2(y.x, y.y); w.y = pk2(y.z, y.w);
                *(uint2*)(odst + (size_t)(row0 + tp) * DI + hv * 128 + e * 64 + cgi * 4) = w; }
        }
        if (g == 0) {
            float* so = p.out + (d ? OUT_GDN_B : OUT_GDN_F) + (size_t)(seq * 16 + hv) * 16384 + e * 64 + dv;
#pragma unroll
            for (int i = 0; i < 4; ++i)
#pragma unroll
                for (int j = 0; j < 4; ++j) so[(size_t)(32 * i + 4 * dkg + j) * 128] = S[4 * i + j];
        }
        __syncthreads();
    }
}
__device__ __forceinline__ void gdn_combine_phase(const Params& p) {
    const int tid = otid(), wave = tid >> 6, lane = tid & 63;
    u16* YF = (u16*)(p.ws + WS_G); const u16* YB = (const u16*)(p.ws + WS_YB); const u16* P = (const u16*)(p.ws + WS_P);
    float nw[8];
    *(float4*)nw = *(const float4*)(p.gdn_norm_w + (lane & 15) * 8); *(float4*)(nw + 4) = *(const float4*)(p.gdn_norm_w + (lane & 15) * 8 + 4);
    for (int row = blockIdx.x * 8 + wave; row < TG; row += gridDim.x * 8) {
#pragma unroll
        for (int i = 0; i < 4; ++i) { const int c = i * 512 + lane * 8;
            float a[8], b[8], z[8], o[8]; unpack8(*(const uint4*)(YF + (size_t)row * DI + c), a); unpack8(*(const uint4*)(YB + (size_t)row * DI + c), b); unpack8(*(const uint4*)(P + (size_t)row * NINP + 4096 + c), z);
            float ss = 0.f;
#pragma unroll
            for (int j = 0; j < 8; ++j) { a[j] += b[j]; ss += a[j] * a[j]; }
            ss += __shfl_xor(ss, 1); ss += __shfl_xor(ss, 2); ss += __shfl_xor(ss, 4); ss += __shfl_xor(ss, 8);
            const float r = rsqrtf(ss * (1.f / 128.f) + 1e-6f);
#pragma unroll
            for (int j = 0; j < 8; ++j) o[j] = a[j] * r * nw[j] * siluf(z[j]);
            *(uint4*)(YF + (size_t)row * DI + c) = pack8(o); }
    }
}
__device__ __forceinline__ void ln_phase(const Params& p, int l, int which, int g) {
    const int tid = otid(), wave = tid >> 6, lane = tid & 63;
    const float* O = (const float*)(p.ws + WS_P); const float* adab = (const float*)(p.ws + WS_ADA); u16* H = (u16*)(p.ws + WS_H);
    const float* lg = p.ln_g + (l * 2 + which) * 1024; const float* lb = p.ln_b + (l * 2 + which) * 1024;
    const bool has_next = !(l == 1 && which == 1);
    for (int row = blockIdx.x * 8 + wave; row < TG; row += gridDim.x * 8) {
        const int t = g * TG + row, cond = cond_of(t);
        const float* xr = (l == 0 && which == 0) ? xin_row(p, t) : p.out + (size_t)t * D;
        const float* ada = adab + (size_t)(l * 9 + cond) * 6144;
        const float* gate = ada + (which ? 5120 : 2048);
        float v[16]; float s = 0.f;
#pragma unroll
        for (int i = 0; i < 4; ++i) { const int c = i * 256 + lane * 4;
            const float4 x = *(const float4*)(xr + c), o = *(const float4*)(O + (size_t)row * D + c), gt = *(const float4*)(gate + c);
            v[4 * i] = ALPHA * x.x + gt.x * o.x; v[4 * i + 1] = ALPHA * x.y + gt.y * o.y; v[4 * i + 2] = ALPHA * x.z + gt.z * o.z; v[4 * i + 3] = ALPHA * x.w + gt.w * o.w;
            s += v[4 * i] + v[4 * i + 1] + v[4 * i + 2] + v[4 * i + 3]; }
        const float mean = wave_sum(s) * (1.f / 1024.f);
        float q = 0.f;
#pragma unroll
        for (int i = 0; i < 16; ++i) { v[i] -= mean; q += v[i] * v[i]; }
        const float rstd = rsqrtf(wave_sum(q) * (1.f / 1024.f) + 1e-5f);
        const float* nsh = which == 0 ? ada + 3072 : adab + (size_t)((l + 1) * 9 + cond) * 6144;
        const float* nsc = nsh + 1024;
#pragma unroll
        for (int i = 0; i < 4; ++i) { const int c = i * 256 + lane * 4;
            const float4 gg = *(const float4*)(lg + c), bb = *(const float4*)(lb + c);
            float4 y; y.x = v[4 * i] * rstd * gg.x + bb.x; y.y = v[4 * i + 1] * rstd * gg.y + bb.y; y.z = v[4 * i + 2] * rstd * gg.z + bb.z; y.w = v[4 * i + 3] * rstd * gg.w + bb.w;
            *(float4*)(p.out + (size_t)t * D + c) = y;
            if (has_next) { const float4 sh = *(const float4*)(nsh + c), sc = *(const float4*)(nsc + c);
                uint2 w; w.x = pk2(y.x * (1.f + sc.x) + sh.x, y.y * (1.f + sc.y) + sh.y); w.y = pk2(y.z * (1.f + sc.z) + sh.z, y.w * (1.f + sc.w) + sh.w);
                *(uint2*)(H + (size_t)t * D + c) = w; } }
    }
}
__device__ __forceinline__ void convgate_phase(const Params& p, int l, int g) {
    const int tid = otid();
    const u16* U = (const u16*)(p.ws + WS_P); u16* G = (u16*)(p.ws + WS_G);
    const int rpb = (TG + gridDim.x - 1) / gridDim.x;
    const int r_lo = blockIdx.x * rpb, r_hi = min(TG, r_lo + rpb);
    if (tid >= 352) return;
    const int c = tid * 8;
    const float* cw = p.ffn_conv_w + (size_t)l * 9 * FF + c;
    float bias[8]; *(float4*)bias = *(const float4*)(p.ffn_conv_b + l * FF + c); *(float4*)(bias + 4) = *(const float4*)(p.ffn_conv_b + l * FF + c + 4);
    for (int row = r_lo; row < r_hi; ++row) {
        float acc[8];
#pragma unroll
        for (int j = 0; j < 8; ++j) acc[j] = bias[j];
        if (g == 0) {
            const int tp = row & 255;
#pragma unroll
            for (int j = 0; j < 3; ++j) { const int tq = tp + j - 1;
                if (tq >= 0 && tq < 256) { float a[8], w[8]; unpack8(*(const uint4*)(U + (size_t)(row + j - 1) * FF2 + c), a);
                    *(float4*)w = *(const float4*)(cw + (3 + j) * FF); *(float4*)(w + 4) = *(const float4*)(cw + (3 + j) * FF + 4);
#pragma unroll
                    for (int k = 0; k < 8; ++k) acc[k] += w[k] * a[k]; } }
        } else {
            const int tp = row & 2047, gr = tp >> 6, gc = tp & 63;
#pragma unroll
            for (int i = 0; i < 3; ++i)
#pragma unroll
                for (int j = 0; j < 3; ++j) { const int r2 = gr + i - 1, c2 = gc + j - 1;
                    if (r2 >= 0 && r2 < 32 && c2 >= 0 && c2 < 64) { float a[8], w[8]; unpack8(*(const uint4*)(U + (size_t)(row + (i - 1) * 64 + (j - 1)) * FF2 + c), a);
                        *(float4*)w = *(const float4*)(cw + (i * 3 + j) * FF); *(float4*)(w + 4) = *(const float4*)(cw + (i * 3 + j) * FF + 4);
#pragma unroll
                        for (int k = 0; k < 8; ++k) acc[k] += w[k] * a[k]; } }
        }
        float vv[8], o[8]; unpack8(*(const uint4*)(U + (size_t)row * FF2 + FF + c), vv);
#pragma unroll
        for (int k = 0; k < 8; ++k) o[k] = siluf(acc[k]) * vv[k];
        *(uint4*)(G + (size_t)row * FF + c) = pack8(o);
    }
}
__device__ __forceinline__ void gemm_bf16out(PG8_LAS unsigned char* lds, const u16* A, const u16* Bt, u16* O, int M, int N, int K) {
    pg8::Gemm gg{A, Bt, M, N, K}; pg8::StaticOrder S; S.init(M, N, (int)gridDim.x, (int)blockIdx.x);
    pg8::EpiBf16 E{O, N};
    pg8::gemm_phase<pg8::EpiBf16, pg8::StaticOrder>(lds, gg, S, E, nullptr);
}
__device__ __forceinline__ void gemm_f32out(PG8_LAS unsigned char* lds, const u16* A, const u16* Bt, float* C, int M, int N, int K) {
    pg8::Gemm gg{A, Bt, M, N, K}; pg8::StaticOrder S; S.init(M, N, (int)gridDim.x, (int)blockIdx.x);
    pg8::EpiF32 E{C, N};
    pg8::gemm_phase<pg8::EpiF32, pg8::StaticOrder>(lds, gg, S, E, nullptr);
}

__global__ void __launch_bounds__(NTHREADS, 2) mega_fwd(Params p) {
    extern __shared__ __attribute__((aligned(16))) unsigned char lds_raw[];
    cg::grid_group grid = cg::this_grid();
    PG8_LAS unsigned char* ldsp = (PG8_LAS unsigned char*)lds_raw;
    float* ldsf = (float*)lds_raw;
    unsigned char* ws = p.ws;
    for (int ph = p.ph_lo; ph < p.ph_hi; ++ph) {
        if (ph == 0) prep_phase(p, ldsf);
        else if (ph == 1) mod0_phase(p);
        else {
            const int q = ph - 2, l = q / 27, r = q % 27, g = r / 9, s = r % 9;
            const u16* wb = (const u16*)(ws + WS_W + (size_t)l * W_LAYER);
            const u16* Hg = (const u16*)(ws + WS_H) + (size_t)g * TG * D;
            if (s == 0) gemm_bf16out(ldsp, Hg, wb + W_IN / 2, (u16*)(ws + WS_P), TG, NINP, D);
            else if (s == 1) { if (l == 0) ssd_scan_phase(p, g, ldsf); else gdn_scan_phase(p, g, ldsf); }
            else if (s == 2) { if (l == 0) ssd_combine_phase(p); else gdn_combine_phase(p); }
            else if (s == 3) gemm_f32out(ldsp, (const u16*)(ws + WS_G), wb + W_OUT / 2, (float*)(ws + WS_P), TG, D, DI);
            else if (s == 4) ln_phase(p, l, 0, g);
            else if (s == 5) gemm_bf16out(ldsp, Hg, wb + W_UP / 2, (u16*)(ws + WS_P), TG, FF2, D);
            else if (s == 6) convgate_phase(p, l, g);
            else if (s == 7) gemm_f32out(ldsp, (const u16*)(ws + WS_G), wb + W_DN / 2, (float*)(ws + WS_P), TG, D, FF);
            else ln_phase(p, l, 1, g);
        }
        if (ph + 1 < p.ph_hi) grid.sync();
    }
}

extern "C" void kernel_launch(void* const* d_in, const int* in_sizes, int n_in, void* d_out, int out_size, void* d_ws, size_t ws_size, hipStream_t stream) {
    static int grid = 0;
    if (grid == 0) {
        if (n_in != 30 || ws_size < WS_END) { fprintf(stderr, "kernel_launch: unexpected n_in %d or ws_size %zu (need %zu)\n", n_in, ws_size, (size_t)WS_END); grid = -1; return; }
        int dev = 0, cus = 0, per_cu = 0;
        hipGetDevice(&dev); hipDeviceGetAttribute(&cus, hipDeviceAttributeMultiprocessorCount, dev);
        if (hipFuncSetAttribute((const void*)mega_fwd, hipFuncAttributeMaxDynamicSharedMemorySize, LDS_BYTES) != hipSuccess) { fprintf(stderr, "kernel_launch: hipFuncSetAttribute failed\n"); grid = -1; return; }
        if (hipOccupancyMaxActiveBlocksPerMultiprocessor(&per_cu, (const void*)mega_fwd, NTHREADS, LDS_BYTES) != hipSuccess || per_cu < 1) per_cu = 1;
        (void)hipGetLastError();
        grid = cus * 1;
        if (grid <= 0) grid = 256;
    }
    if (grid < 0) return;
    Params p; memset(&p, 0, sizeof(p));
    const float** pp = (const float**)&p;
    for (int i = 0; i < 30; ++i) pp[i] = (const float*)d_in[i];
    p.out = (float*)d_out; p.ws = (unsigned char*)d_ws; p.ph_lo = 0; p.ph_hi = NPHASES;
    void* args[] = {&p};
    hipError_t e = hipLaunchCooperativeKernel((const void*)mega_fwd, dim3(grid), dim3(NTHREADS), args, LDS_BYTES, stream);
    if (e != hipSuccess) fprintf(stderr, "cooperative launch failed: %s (grid %d)\n", hipGetErrorString(e), grid);
}
```

```cpp
#include <hip/hip_runtime.h>
#include <hip/hip_cooperative_groups.h>
#include <cstdio>
#include <cstring>
namespace cg = cooperative_groups;
namespace pg8 {
#define PG8_LAS __attribute__((address_space(3)))
typedef unsigned short bf16_t;
typedef short bf16x8 __attribute__((ext_vector_type(8)));
typedef float f32x4 __attribute__((ext_vector_type(4)));
typedef unsigned u32x4 __attribute__((ext_vector_type(4)));
constexpr int BM = 256, BK = 64, HALF = 128, HTB = HALF * BK * 2  , STAGE_BYTES = 8 * HTB, NXCD = 8, WGM = 4;

__host__ __device__ __forceinline__ int lds_byte(int r, int c) { const int st = (r >> 4) * 2 + (c >> 5), rr = r & 15, cc = c & 31, ob = rr * 64 + cc * 2; return st * 1024 + (ob ^ (((ob >> 9) & 1) << 5)); }
__host__ __device__ __forceinline__ void stage_rc(int b, int& R, int& C) { const int st = b / 1024, sb = b % 1024, swz = sb ^ (((sb >> 9) & 1) << 5); R = (st >> 1) * 16 + swz / 64; C = (st & 1) * 32 + (swz % 64) / 2; }
__host__ __device__ __forceinline__ int perm32(int rho) { const int n = rho >> 4, i = rho & 15; return 8 * (i >> 2) + 4 * n + (i & 3); }

struct Unit { int pm, pn; };
struct Gemm { const bf16_t* A; const bf16_t* Bt; int M, N, K, ld, npn; };

struct StaticOrder {
    int nM, nN, nwg, G, c;
    __host__ __device__ void init(int M, int N, int G_, int c_) { nM = M / BM; nN = N / BM; nwg = nM * nN; G = G_; c = c_; }
    __host__ __device__ bool next(int i, Unit& u) const {
        const long L = (long)i * G + c; if (L >= nwg) return false;
        int wgid = (int)L; { const int q = nwg / NXCD, r = nwg % NXCD, xcd = wgid % NXCD, off = wgid / NXCD; wgid = (xcd < r ? xcd * (q + 1) : r * (q + 1) + (xcd - r) * q) + off; }
        const int nig = WGM * nN, gid = wgid / nig, fm = gid * WGM, gsz = (nM - fm) < WGM ? (nM - fm) : WGM;
        u.pm = fm + ((wgid % nig) % gsz); u.pn = (wgid % nig) / gsz; return true;
    }
    __device__ __forceinline__ void a_ready(const Unit&) const {}
    __device__ __forceinline__ void done(const Unit&) const {}
};
typedef __bf16 bf16x2_t __attribute__((ext_vector_type(2)));
typedef float f32x2_t __attribute__((ext_vector_type(2)));
__device__ __forceinline__ unsigned cvt_pk_bf16(float lo, float hi) { const f32x2_t f = {lo, hi}; const bf16x2_t v = __builtin_convertvector(f, bf16x2_t); return __builtin_bit_cast(unsigned, v); }
typedef unsigned u32x4 __attribute__((ext_vector_type(4)));
struct EpiF32 {
    static constexpr bool PERM = false, AFTER_DRAIN = false;
    float* C; int ldc; int npn; size_t split_stride;
    __device__ __forceinline__ void operator()(const f32x4 (&acc)[2][2][4][2], const Unit& u, int wr, int wc, int fr, int fq) const {
        const int row0 = u.pm * BM + wr * 64 + fr, col0 = (u.pn % npn) * BM + wc * 32 + 4 * fq;
        float* Cs = C + (size_t)(u.pn / npn) * split_stride;
#pragma unroll
        for (int ai = 0; ai < 2; ++ai)
#pragma unroll
            for (int m = 0; m < 4; ++m) { float* rowp = Cs + (size_t)(row0 + ai * HALF + m * 16) * ldc + col0;
#pragma unroll
                for (int bj = 0; bj < 2; ++bj)
#pragma unroll
                    for (int n = 0; n < 2; ++n) *(f32x4*)(rowp + bj * HALF + n * 16) = acc[ai][bj][m][n]; }
    }
};
struct EpiBf16 {
    static constexpr bool PERM = true, AFTER_DRAIN = false;
    bf16_t* O; int ldc; int npn; size_t split_stride;
    __device__ __forceinline__ void operator()(const f32x4 (&acc)[2][2][4][2], const Unit& u, int wr, int wc, int fr, int fq) const {
        const int row0 = u.pm * BM + wr * 64 + fr, col0 = (u.pn % npn) * BM + wc * 32 + 8 * fq;
        bf16_t* Os = O + (size_t)(u.pn / npn) * split_stride;
#pragma unroll
        for (int ai = 0; ai < 2; ++ai)
#pragma unroll
            for (int m = 0; m < 4; ++m) { bf16_t* rowp = Os + (size_t)(row0 + ai * HALF + m * 16) * ldc + col0;
#pragma unroll
                for (int bj = 0; bj < 2; ++bj) { const f32x4 v0 = acc[ai][bj][m][0], v1 = acc[ai][bj][m][1];
                    u32x4 w; w.x = cvt_pk_bf16(v0[0], v0[1]); w.y = cvt_pk_bf16(v0[2], v0[3]); w.z = cvt_pk_bf16(v1[0], v1[1]); w.w = cvt_pk_bf16(v1[2], v1[3]);
                    *(u32x4*)(rowp + bj * HALF) = w; } }
    }
};
template <class Epi, class Sched, bool STAMP = false>
__device__ __forceinline__ void gemm_phase(PG8_LAS unsigned char* lds, const Gemm g, const Sched& S, const Epi& E, unsigned long long* stamps) {
    int tid_ = threadIdx.x; asm volatile("" : "+v"(tid_)); const int tid = tid_, wid = __builtin_amdgcn_readfirstlane(tid >> 6), lane = tid & 63, wr = wid >> 2, wc = wid & 3, fr = lane & 15, fq = lane >> 4;
    const int K = g.K, nt = K / BK;
    int ts_lo = 0, ts_hi = 0, nts = 0; const unsigned long long rt_entry = STAMP ? (unsigned long long)wall_clock64() : 0ull;
#define PG8_STAMP() do { if (STAMP && wid == 0 && nts < 64) { const unsigned long long _c = (unsigned long long)clock64(); \
        ts_lo = (lane == nts) ? (int)(unsigned)_c : ts_lo; ts_hi = (lane == nts) ? (int)(unsigned)(_c >> 32) : ts_hi; ++nts; } } while (0)
    PG8_STAMP();
    unsigned voffA[2], voffB[2];
#pragma unroll
    for (int i = 0; i < 2; ++i) { int R, C; stage_rc(tid * 16 + i * 8192, R, C); const int Rb = Epi::PERM ? ((R & ~31) + perm32(R & 31)) : R;
        voffA[i] = (unsigned)(R * g.ld + C) * 2u; voffB[i] = (unsigned)(Rb * g.ld + C) * 2u; }
    const size_t kstep = (size_t)(BK * 2);
    const size_t hstep = (size_t)HALF * g.ld * 2;
    const size_t tstep = 2 * hstep;
    const unsigned ldsw = (unsigned)wid * 1024u;
    const int aoff = lds_byte(wr * 64 + fr, fq * 8), boff = lds_byte(wc * 32 + fr, fq * 8);
#define PG8_SA(b, h) (((b) * 2 + (h)) * HTB)
#define PG8_SB(b, h) ((4 + (b) * 2 + (h)) * HTB)
#define PG8_STAGE(bufoff, gbase, voff) do { _Pragma("unroll") for (int _i = 0; _i < 2; ++_i) \
        __builtin_amdgcn_global_load_lds((const unsigned*)((const char*)(gbase) + (voff)[_i]), (PG8_LAS unsigned*)(lds + (bufoff) + ldsw + _i * 8192), 16, 0, 0); } while (0)
#define PG8_LDA(dst, b, h) do { _Pragma("unroll") for (int m = 0; m < 4; ++m) _Pragma("unroll") for (int k = 0; k < 2; ++k) dst[m][k] = *(const PG8_LAS bf16x8*)(lds + PG8_SA(b, h) + aoff + m * 2048 + k * 1024); } while (0)
#define PG8_LDB(dst, b, h) do { _Pragma("unroll") for (int n = 0; n < 2; ++n) _Pragma("unroll") for (int k = 0; k < 2; ++k) dst[n][k] = *(const PG8_LAS bf16x8*)(lds + PG8_SB(b, h) + boff + n * 2048 + k * 1024); } while (0)
#define PG8_MMA(ai, bj, At, Bt) do { __builtin_amdgcn_s_setprio(1); _Pragma("unroll") for (int m = 0; m < 4; ++m) _Pragma("unroll") for (int n = 0; n < 2; ++n) _Pragma("unroll") for (int k = 0; k < 2; ++k) \
        acc[ai][bj][m][n] = __builtin_amdgcn_mfma_f32_16x16x32_bf16(Bt[n][k], At[m][k], acc[ai][bj][m][n], 0, 0, 0); __builtin_amdgcn_s_setprio(0); } while (0)
#define PG8_WAIT_V(n) asm volatile("s_waitcnt vmcnt(" #n ")" ::: "memory")
#define PG8_WAIT_L(n) asm volatile("s_waitcnt lgkmcnt(" #n ")" ::: "memory")
#define PG8_BAR __builtin_amdgcn_s_barrier()
#define PG8_SCHED __builtin_amdgcn_sched_barrier(0)
    Unit cur, nxt; int ui = 0;
    if (!S.next(0, cur)) return;
    f32x4 acc[2][2][4][2];
#pragma unroll
    for (int a = 0; a < 2; ++a)
#pragma unroll
        for (int b = 0; b < 2; ++b)
#pragma unroll
            for (int m = 0; m < 4; ++m)
#pragma unroll
                for (int n = 0; n < 2; ++n) acc[a][b][m][n] = (f32x4){0.f, 0.f, 0.f, 0.f};
    bf16x8 At[4][2], B0[2][2], B1[2][2];
    const size_t ksb = (size_t)K * 2;
    const char* cA = (const char*)g.A + (size_t)cur.pm * tstep + (size_t)(cur.pn / g.npn) * ksb; const char* cB = (const char*)g.Bt + (size_t)(cur.pn % g.npn) * tstep + (size_t)(cur.pn / g.npn) * ksb;
    S.a_ready(cur);
    PG8_STAGE(PG8_SB(0, 0), cB, voffB); PG8_STAGE(PG8_SA(0, 0), cA, voffA); PG8_STAGE(PG8_SB(0, 1), cB + hstep, voffB); PG8_STAGE(PG8_SA(0, 1), cA + hstep, voffA);
    if (wr == 1) PG8_BAR;
    PG8_WAIT_V(4); PG8_BAR;
    PG8_STAGE(PG8_SB(1, 0), cB + kstep, voffB); PG8_STAGE(PG8_SA(1, 0), cA + kstep, voffA); PG8_STAGE(PG8_SB(1, 1), cB + hstep + kstep, voffB);
    PG8_WAIT_V(6); PG8_BAR;
    PG8_STAMP();
    for (;;) {
        const bool has_next = S.next(ui + 1, nxt);
        const char* nA = has_next ? (const char*)g.A + (size_t)nxt.pm * tstep + (size_t)(nxt.pn / g.npn) * ksb : cA; const char* nB = has_next ? (const char*)g.Bt + (size_t)(nxt.pn % g.npn) * tstep + (size_t)(nxt.pn / g.npn) * ksb : cB;
        for (int t = 0; t < nt; t += 2) {
            const bool last = (t == nt - 2);
            const char* a1 = cA + (size_t)(t + 1) * kstep;
            const char* a2 = last ? nA : cA + (size_t)(t + 2) * kstep; const char* b2 = last ? nB : cB + (size_t)(t + 2) * kstep;
            const char* a3 = a2 + kstep; const char* b3 = b2 + kstep;
            if (last && has_next) S.a_ready(nxt);
            PG8_LDB(B0, 0, 0); PG8_SCHED; PG8_LDA(At, 0, 0); PG8_STAGE(PG8_SA(1, 1), a1 + hstep, voffA);
            PG8_WAIT_L(8); PG8_BAR; PG8_WAIT_L(0); PG8_MMA(0, 0, At, B0); PG8_BAR; PG8_SCHED;
            PG8_LDB(B1, 0, 1); PG8_STAGE(PG8_SB(0, 0), b2, voffB);
            PG8_BAR; PG8_WAIT_L(0); PG8_MMA(0, 1, At, B1); PG8_BAR;
            PG8_LDA(At, 0, 1); PG8_STAGE(PG8_SA(0, 0), a2, voffA);
            PG8_BAR; PG8_WAIT_L(0); PG8_MMA(1, 0, At, B0); PG8_BAR; PG8_SCHED;
            PG8_STAGE(PG8_SB(0, 1), b2 + hstep, voffB);
            PG8_WAIT_V(6); PG8_BAR; PG8_MMA(1, 1, At, B1); PG8_BAR;
            PG8_LDB(B0, 1, 0); PG8_SCHED; PG8_LDA(At, 1, 0); PG8_STAGE(PG8_SA(0, 1), a2 + hstep, voffA);
            PG8_WAIT_L(8); PG8_BAR; PG8_WAIT_L(0); PG8_MMA(0, 0, At, B0); PG8_BAR; PG8_SCHED;
            PG8_LDB(B1, 1, 1); PG8_STAGE(PG8_SB(1, 0), b3, voffB);
            PG8_BAR; PG8_WAIT_L(0); PG8_MMA(0, 1, At, B1); PG8_BAR;
            PG8_LDA(At, 1, 1); PG8_STAGE(PG8_SA(1, 0), a3, voffA);
            PG8_BAR; PG8_WAIT_L(0); PG8_MMA(1, 0, At, B0); PG8_BAR; PG8_SCHED;
            PG8_STAGE(PG8_SB(1, 1), b3 + hstep, voffB);
            PG8_WAIT_V(6); PG8_BAR; PG8_MMA(1, 1, At, B1); PG8_BAR;
        }
        PG8_STAMP();
        if constexpr (!Epi::AFTER_DRAIN) { E(acc, cur, wr, wc, fr, fq); S.done(cur); }
        PG8_STAMP();
        if (!has_next) break;
#pragma unroll
        for (int a = 0; a < 2; ++a)
#pragma unroll
            for (int b = 0; b < 2; ++b)
#pragma unroll
                for (int m = 0; m < 4; ++m)
#pragma unroll
                    for (int n = 0; n < 2; ++n) acc[a][b][m][n] = (f32x4){0.f, 0.f, 0.f, 0.f};
        cur = nxt; cA = nA; cB = nB; ++ui;
    }
    PG8_WAIT_V(0);
    if (wr == 0) PG8_BAR;
    PG8_BAR;
    if constexpr (Epi::AFTER_DRAIN) { E.fused(acc, cur, wr, wc, fr, fq, lds, wid, lane); S.done(cur); }
    PG8_STAMP();
    if (STAMP && wid == 0) { stamps[lane] = lane < nts ? (((unsigned long long)(unsigned)ts_hi << 32) | (unsigned)ts_lo) : 0ull;
        if (lane == 62) stamps[62] = rt_entry; if (lane == 63) stamps[63] = (unsigned long long)wall_clock64(); }
#undef PG8_STAMP
#undef PG8_SA
#undef PG8_SB
#undef PG8_STAGE
#undef PG8_LDA
#undef PG8_LDB
#undef PG8_MMA
#undef PG8_WAIT_V
#undef PG8_WAIT_L
#undef PG8_BAR
#undef PG8_SCHED
}
}

typedef unsigned short u16;
constexpr int D = 1024, T_ALL = 24576, TG = 8192, NGRP = 3;
constexpr int NINP = 6400, DI = 2048, FF = 2816, FF2 = 5632;
constexpr int NTHREADS = 512, LDS_BYTES = 143360;
constexpr float ALPHA = 1.4142135623730951f;
constexpr size_t WS_ADA = 0;
constexpr size_t WS_BAR = 499712;
constexpr size_t WS_W = 524288;
constexpr size_t W_IN = 0, W_OUT = W_IN + (size_t)NINP * D * 2, W_UP = W_OUT + (size_t)D * DI * 2, W_DN = W_UP + (size_t)FF2 * D * 2, W_LAYER = W_DN + (size_t)D * FF * 2;
constexpr size_t WS_H = WS_W + 2 * W_LAYER;
constexpr size_t WS_P = WS_H + (size_t)T_ALL * D * 2;
constexpr size_t WS_G = WS_P + (size_t)TG * NINP * 2;
constexpr size_t WS_YB = WS_G + (size_t)TG * FF * 2;
constexpr size_t WS_END = WS_YB + (size_t)TG * DI * 2;
constexpr size_t OUT_SSD_F = (size_t)T_ALL * D, OUT_SSD_B = OUT_SSD_F + 8388608, OUT_GDN_F = OUT_SSD_B + 8388608, OUT_GDN_B = OUT_GDN_F + 8388608;
#ifndef REP_SCAN
#define REP_SCAN 1
#endif
#ifndef REP_EW
#define REP_EW 1
#endif
#ifndef REP_SYNC
#define REP_SYNC 1
#endif
#ifndef REP_GEMM
#define REP_GEMM 1
#endif
constexpr int NPHASES = 2 + 2 * NGRP * 8 + 1;

struct Params {
    const float *x_prompt, *x_sample, *st_ssd_f, *st_ssd_b, *st_gdn_f, *st_gdn_b, *c, *c_ctx, *w_ada, *b_ada, *ln_g, *ln_b,
        *ssd_w_in, *ssd_conv_w, *ssd_conv_b, *ssd_dt_bias, *ssd_a_log, *ssd_d, *ssd_norm_w, *ssd_w_out,
        *gdn_w_in, *gdn_conv_w, *gdn_dt_bias, *gdn_a_log, *gdn_norm_w, *gdn_w_out,
        *ffn_w_up, *ffn_conv_w, *ffn_conv_b, *ffn_w_down;
    float* out; unsigned char* ws; int ph_lo, ph_hi;
};

__device__ __forceinline__ int otid() { int t = threadIdx.x; asm volatile("" : "+v"(t)); return t; }
__device__ __forceinline__ float bf2f(u16 b) { return __uint_as_float(((unsigned)b) << 16); }
__device__ __forceinline__ unsigned pk2(float lo, float hi) { return pg8::cvt_pk_bf16(lo, hi); }
__device__ __forceinline__ float siluf(float x) { return x * __builtin_amdgcn_rcpf(1.f + __expf(-x)); }
__device__ __forceinline__ float softplusf(float x) { return x > 15.f ? x : __logf(1.f + __expf(x)); }
__device__ __forceinline__ void unpack8(const uint4 v, float* f) {
    f[0] = __uint_as_float(v.x << 16); f[1] = __uint_as_float(v.x & 0xffff0000u); f[2] = __uint_as_float(v.y << 16); f[3] = __uint_as_float(v.y & 0xffff0000u);
    f[4] = __uint_as_float(v.z << 16); f[5] = __uint_as_float(v.z & 0xffff0000u); f[6] = __uint_as_float(v.w << 16); f[7] = __uint_as_float(v.w & 0xffff0000u);
}
__device__ __forceinline__ void unpack4(const uint2 v, float* f) {
    f[0] = __uint_as_float(v.x << 16); f[1] = __uint_as_float(v.x & 0xffff0000u); f[2] = __uint_as_float(v.y << 16); f[3] = __uint_as_float(v.y & 0xffff0000u);
}
__device__ __forceinline__ uint4 pack8(const float* f) { uint4 r; r.x = pk2(f[0], f[1]); r.y = pk2(f[2], f[3]); r.z = pk2(f[4], f[5]); r.w = pk2(f[6], f[7]); return r; }
typedef unsigned ntl_u32x4 __attribute__((ext_vector_type(4)));
typedef unsigned ntl_u32x2 __attribute__((ext_vector_type(2)));
typedef float ntl_f32x4 __attribute__((ext_vector_type(4)));
__device__ __forceinline__ uint4 ldnt16(const void* p) { const ntl_u32x4 v = __builtin_nontemporal_load((const ntl_u32x4*)p); return make_uint4(v.x, v.y, v.z, v.w); }
__device__ __forceinline__ uint2 ldnt8(const void* p) { const ntl_u32x2 v = __builtin_nontemporal_load((const ntl_u32x2*)p); return make_uint2(v.x, v.y); }
__device__ __forceinline__ float4 ldnt16f(const float* p) { const ntl_f32x4 v = __builtin_nontemporal_load((const ntl_f32x4*)p); return make_float4(v.x, v.y, v.z, v.w); }
__device__ __forceinline__ int cond_of(int t) { return t < 8192 ? 0 : 1 + ((t - 8192) >> 11); }
__device__ __forceinline__ const float* xin_row(const Params& p, int t) { return t < 8192 ? p.x_prompt + (size_t)t * D : p.x_sample + (size_t)(t - 8192) * D; }
__device__ __forceinline__ float wave_sum(float v) {
    v += __shfl_xor(v, 1); v += __shfl_xor(v, 2); v += __shfl_xor(v, 4); v += __shfl_xor(v, 8); v += __shfl_xor(v, 16); v += __shfl_xor(v, 32); return v;
}


#define DPP_STEP(v, ctrl, rmask, bctl) (v) += __int_as_float(__builtin_amdgcn_update_dpp(0, __float_as_int(v), (ctrl), (rmask), 0xF, (bctl)))
__device__ __forceinline__ float wave_prefix_sum(float v) {
    DPP_STEP(v, 0x111, 0xF, true); DPP_STEP(v, 0x112, 0xF, true); DPP_STEP(v, 0x114, 0xF, true); DPP_STEP(v, 0x118, 0xF, true);
    DPP_STEP(v, 0x142, 0xA, false);
    DPP_STEP(v, 0x143, 0xC, false);
    return v;
}
__device__ __forceinline__ float wave_last(float v) { return __int_as_float(__builtin_amdgcn_readlane(__float_as_int(v), 63)); }
__device__ __forceinline__ void wprep(const float* __restrict__ src, u16* __restrict__ dst, int K, int N, int Npad, float* tile) {
    const int tid = otid(); const int nkt = K >> 6, nnt = Npad >> 6;
    for (int t = blockIdx.x; t < nkt * nnt; t += gridDim.x) {
        const int kt = t % nkt, nt = t / nkt; const int k0 = kt * 64, n0 = nt * 64;
#pragma unroll
        for (int e = 0; e < 8; ++e) { const int idx = e * 512 + tid; const int kk = idx >> 6, nn = idx & 63; float v = 0.f;
            if (n0 + nn < N) v = src[(size_t)(k0 + kk) * N + n0 + nn];
            tile[kk * 65 + nn] = v; }
        __syncthreads();
#pragma unroll
        for (int e = 0; e < 4; ++e) { const int idx = e * 512 + tid; const int nn = idx >> 5, kp = idx & 31;
            const unsigned w = pk2(tile[(2 * kp) * 65 + nn], tile[(2 * kp + 1) * 65 + nn]);
            *(unsigned*)(dst + (size_t)(n0 + nn) * K + k0 + 2 * kp) = w; }
        __syncthreads();
    }
}
__device__ __forceinline__ void adaln_phase(const Params& p, float* lds) {
    float* s = lds; float* red = lds + 9 * 1024;
    const int tid = otid(), wave = tid >> 6, lane = tid & 63;
    if ((int)blockIdx.x >= 192) return;
    for (int i = tid; i < 9 * 1024; i += NTHREADS) { const int c = i >> 10, k = i & 1023; const float v = c == 0 ? p.c_ctx[k] : p.c[(c - 1) * 1024 + k]; s[i] = siluf(v); }
    __syncthreads();
    float* ada = (float*)(p.ws + WS_ADA);
    for (int ch = blockIdx.x; ch < 192; ch += gridDim.x) {
        const int l = ch / 96, col0 = (ch % 96) * 64;
        const float* w = p.w_ada + (size_t)l * 1024 * 6144 + col0 + lane;
        float acc[9];
#pragma unroll
        for (int c = 0; c < 9; ++c) acc[c] = 0.f;
#pragma unroll 8
        for (int k = wave * 128; k < wave * 128 + 128; ++k) { const float wv = w[(size_t)k * 6144];
#pragma unroll
            for (int c = 0; c < 9; ++c) acc[c] += s[c * 1024 + k] * wv; }
#pragma unroll
        for (int c = 0; c < 9; ++c) red[(wave * 9 + c) * 64 + lane] = acc[c];
        __syncthreads();
        for (int i = tid; i < 576; i += NTHREADS) { const int c = i >> 6, col = i & 63; float v = p.b_ada[l * 6144 + col0 + col];
#pragma unroll
            for (int w8 = 0; w8 < 8; ++w8) v += red[(w8 * 9 + c) * 64 + col];
            ada[(size_t)(l * 9 + c) * 6144 + col0 + col] = v; }
        __syncthreads();
    }
}
__device__ __forceinline__ void prep_phase(const Params& p, float* lds) {
    adaln_phase(p, lds);
    __syncthreads();
    for (int l = 0; l < 2; ++l) {
        u16* wb = (u16*)(p.ws + WS_W + (size_t)l * W_LAYER);
        wprep(l == 0 ? p.ssd_w_in : p.gdn_w_in, wb + W_IN / 2, 1024, 6208, NINP, lds);
        wprep(l == 0 ? p.ssd_w_out : p.gdn_w_out, wb + W_OUT / 2, 2048, 1024, 1024, lds);
        wprep(p.ffn_w_up + (size_t)l * 1024 * FF2, wb + W_UP / 2, 1024, FF2, FF2, lds);
        wprep(p.ffn_w_down + (size_t)l * FF * 1024, wb + W_DN / 2, FF, 1024, 1024, lds);
    }
}
__device__ __forceinline__ void mod0_phase(const Params& p) {
    const float* ada = (const float*)(p.ws + WS_ADA); u16* H = (u16*)(p.ws + WS_H);
    for (size_t i = (size_t)blockIdx.x * NTHREADS + otid(); i < (size_t)T_ALL * 256; i += (size_t)gridDim.x * NTHREADS) {
        const int t = (int)(i >> 8), c = (int)(i & 255) * 4;
        const float4 x = *(const float4*)(xin_row(p, t) + c);
        const float* a = ada + (size_t)cond_of(t) * 6144;
        const float4 sh = *(const float4*)(a + c), sc = *(const float4*)(a + 1024 + c);
        uint2 w; w.x = pk2(x.x * (1.f + sc.x) + sh.x, x.y * (1.f + sc.y) + sh.y); w.y = pk2(x.z * (1.f + sc.z) + sh.z, x.w * (1.f + sc.w) + sh.w);
        *(uint2*)(H + (size_t)t * D + c) = w;
    }
}
__device__ __forceinline__ void conv8(const u16* r1, int rs, bool hm, bool hp, const float* w, int wstride, float* o) {
    const uint4 z = {0u, 0u, 0u, 0u};
    const uint4 v0 = hm ? *(const uint4*)(r1 - rs) : z, v1 = *(const uint4*)r1, v2 = hp ? *(const uint4*)(r1 + rs) : z;
    float a0[8], a1[8], a2[8]; unpack8(v0, a0); unpack8(v1, a1); unpack8(v2, a2);
    float w0[8], w1[8], w2[8];
    *(float4*)w0 = *(const float4*)w; *(float4*)(w0 + 4) = *(const float4*)(w + 4);
    *(float4*)w1 = *(const float4*)(w + wstride); *(float4*)(w1 + 4) = *(const float4*)(w + wstride + 4);
    *(float4*)w2 = *(const float4*)(w + 2 * wstride); *(float4*)(w2 + 4) = *(const float4*)(w + 2 * wstride + 4);
#pragma unroll
    for (int j = 0; j < 8; ++j) o[j] = w0[j] * a0[j] + w1[j] * a1[j] + w2[j] * a2[j];
}
__device__ __forceinline__ void conv4(const u16* r1, int rs, bool hm, bool hp, const float* w, int wstride, float* o) {
    const uint2 z = {0u, 0u};
    const uint2 v0 = hm ? *(const uint2*)(r1 - rs) : z, v1 = *(const uint2*)r1, v2 = hp ? *(const uint2*)(r1 + rs) : z;
    float a0[4], a1[4], a2[4]; unpack4(v0, a0); unpack4(v1, a1); unpack4(v2, a2);
    const float4 w0 = *(const float4*)w, w1 = *(const float4*)(w + wstride), w2 = *(const float4*)(w + 2 * wstride);
    o[0] = w0.x * a0[0] + w1.x * a1[0] + w2.x * a2[0]; o[1] = w0.y * a0[1] + w1.y * a1[1] + w2.y * a2[1];
    o[2] = w0.z * a0[2] + w1.z * a1[2] + w2.z * a2[2]; o[3] = w0.w * a0[3] + w1.w * a1[3] + w2.w * a2[3];
}
__device__ __forceinline__ void ssd_scan_phase(const Params& p, int g, float* lds) {
    const int tid = otid(), wave = tid >> 6, lane = tid & 63;
    const int L = g == 0 ? 256 : 2048, nseq = g == 0 ? 32 : 4, nitems = nseq * 64;
    float* Bs = lds; float* Cs = lds + 4096; float* xs = lds + 8192; float* ybuf = lds + 10240; float* dts = lds + 12288; float* dAs = lds + 12320;
    const u16* P = (const u16*)(p.ws + WS_P);
    const int tok = tid >> 4, cgi = tid & 15;
    const int pl = lane >> 3, ng = lane & 7, pp = wave * 8 + pl;
    for (int item = blockIdx.x; item < nitems; item += gridDim.x) {
        const int d = item & 1, h = (item >> 1) & 31, seq = item >> 6, grp = h >> 2;
        const int row0 = seq * L;
        const float a_neg = -__expf(p.ssd_a_log[d * 32 + h]), dtb = p.ssd_dt_bias[d * 32 + h], dskip = d == 0 ? p.ssd_d[h] : 0.f;
        float S[16];
        if (g == 0) {
#pragma unroll
            for (int i = 0; i < 16; ++i) S[i] = 0.f;
        } else {
            const float* s0 = (d ? p.st_ssd_b : p.st_ssd_f) + ((size_t)(((g - 1) * 4 + seq) * 32 + h) * 64 + pp) * 128;
#pragma unroll
            for (int i = 0; i < 4; ++i) { const float4 v = *(const float4*)(s0 + 32 * i + 4 * ng); S[4 * i] = v.x; S[4 * i + 1] = v.y; S[4 * i + 2] = v.z; S[4 * i + 3] = v.w; }
        }
        const int chx = h * 64 + cgi * 4, chb = 2048 + grp * 128 + cgi * 8, chc = 3072 + grp * 128 + cgi * 8;
        u16* ydst = (u16*)(p.ws + (d ? WS_YB : WS_G));
        for (int tile = 0; tile < L / 32; ++tile) {
            const int sidx = tile * 32 + tok; const int tp = d ? L - 1 - sidx : sidx;
            {
                const u16* r1 = P + (size_t)(row0 + tp) * NINP + 2048;
                const bool hm = tp > 0, hp = tp < L - 1;
                float o4[4]; conv4(r1 + chx, NINP, hm, hp, p.ssd_conv_w + chx, 4096, o4);
                const float4 bx = *(const float4*)(p.ssd_conv_b + chx);
                float4 xo; xo.x = siluf(o4[0] + bx.x); xo.y = siluf(o4[1] + bx.y); xo.z = siluf(o4[2] + bx.z); xo.w = siluf(o4[3] + bx.w);
                *(float4*)(xs + tok * 64 + cgi * 4) = xo;
                float o8[8], bb[8];
                conv8(r1 + chb, NINP, hm, hp, p.ssd_conv_w + chb, 4096, o8);
                *(float4*)bb = *(const float4*)(p.ssd_conv_b + chb); *(float4*)(bb + 4) = *(const float4*)(p.ssd_conv_b + chb + 4);
#pragma unroll
                for (int j = 0; j < 8; ++j) o8[j] = siluf(o8[j] + bb[j]);
                *(float4*)(Bs + tok * 128 + cgi * 8) = *(float4*)o8; *(float4*)(Bs + tok * 128 + cgi * 8 + 4) = *(float4*)(o8 + 4);
                conv8(r1 + chc, NINP, hm, hp, p.ssd_conv_w + chc, 4096, o8);
                *(float4*)bb = *(const float4*)(p.ssd_conv_b + chc); *(float4*)(bb + 4) = *(const float4*)(p.ssd_conv_b + chc + 4);
#pragma unroll
                for (int j = 0; j < 8; ++j) o8[j] = siluf(o8[j] + bb[j]);
                *(float4*)(Cs + tok * 128 + cgi * 8) = *(float4*)o8; *(float4*)(Cs + tok * 128 + cgi * 8 + 4) = *(float4*)(o8 + 4);
                if (cgi == 0) { const float raw = bf2f(P[(size_t)(row0 + tp) * NINP + 6144 + d * 32 + h]); const float dt = softplusf(raw + dtb); dts[tok] = dt; dAs[tok] = __expf(dt * a_neg); }
            }
            __syncthreads();
            for (int tt = 0; tt < 32; ++tt) {
                const float dA = dAs[tt], x = xs[tt * 64 + pp]; const float xdt = x * dts[tt];
                float acc = 0.f;
#pragma unroll
                for (int i = 0; i < 4; ++i) {
                    const float4 b = *(const float4*)(Bs + tt * 128 + 32 * i + 4 * ng), c = *(const float4*)(Cs + tt * 128 + 32 * i + 4 * ng);
                    S[4 * i] = S[4 * i] * dA + xdt * b.x; S[4 * i + 1] = S[4 * i + 1] * dA + xdt * b.y; S[4 * i + 2] = S[4 * i + 2] * dA + xdt * b.z; S[4 * i + 3] = S[4 * i + 3] * dA + xdt * b.w;
                    acc += S[4 * i] * c.x + S[4 * i + 1] * c.y + S[4 * i + 2] * c.z + S[4 * i + 3] * c.w;
                }
                acc += __shfl_xor(acc, 1); acc += __shfl_xor(acc, 2); acc += __shfl_xor(acc, 4);
                if (ng == 0) ybuf[tt * 64 + pp] = acc + dskip * x;
            }
            __syncthreads();
            {   const float4 y = *(const float4*)(ybuf + tok * 64 + cgi * 4); uint2 w; w.x = pk2(y.x, y.y); w.y = pk2(y.z, y.w);
                *(uint2*)(ydst + (size_t)(row0 + tp) * DI + h * 64 + cgi * 4) = w; }
        }
        if (g == 0) {
            float* so = p.out + (d ? OUT_SSD_B : OUT_SSD_F) + ((size_t)(seq * 32 + h) * 64 + pp) * 128;
#pragma unroll
            for (int i = 0; i < 4; ++i) { float4 v; v.x = S[4 * i]; v.y = S[4 * i + 1]; v.z = S[4 * i + 2]; v.w = S[4 * i + 3]; *(float4*)(so + 32 * i + 4 * ng) = v; }
        }
        __syncthreads();
    }
}

typedef pg8::bf16x8 bfx8; typedef pg8::f32x4 fx4;
__device__ __forceinline__ fx4 mma16(bfx8 a, bfx8 b, fx4 c) { return __builtin_amdgcn_mfma_f32_16x16x32_bf16(a, b, c, 0, 0, 0); }
__device__ __forceinline__ uint2 pack4v(fx4 v) { uint2 r; r.x = pk2(v[0], v[1]); r.y = pk2(v[2], v[3]); return r; }
__device__ __forceinline__ void ssd_scan_mfma(const Params& p, int g, unsigned char* lds) {
    const int tid = otid(), wave = tid >> 6, lane = tid & 63, fr = lane & 15, fq = lane >> 4;
    const int L = g == 0 ? 256 : 2048, nseq = g == 0 ? 32 : 4, nitems = nseq * 64, nchunk = L / 64;
    u16* Cs = (u16*)lds; u16* Bs = Cs + 64 * 144; u16* BT = Bs + 64 * 144; u16* XT = BT + 128 * 80; u16* XwT = XT + 64 * 80; u16* Ms = XwT + 64 * 80; u16* Sb = Ms + 64 * 80;
    float* cum = (float*)(Sb + 64 * 144); float* dtv = cum + 64; float* wgt = cum + 128; float* ecum = cum + 192; float* misc = cum + 256;
    const u16* P = (const u16*)(p.ws + WS_P);
    for (int item0 = ((gridDim.x & 7) == 0 ? (int)((blockIdx.x & 7) * (gridDim.x >> 3) + (blockIdx.x >> 3)) : (int)blockIdx.x); item0 < nitems; item0 += gridDim.x) {
        const int item = item0;
        const int d = item & 1, h = (item >> 1) & 31, seq = item >> 6, grp = h >> 2;
        const int row0 = seq * L;
        const float a_neg = -__expf(p.ssd_a_log[d * 32 + h]), dtb = p.ssd_dt_bias[d * 32 + h], dskip = p.ssd_d[h];
        fx4 st[4];
        const int n0 = wave * 16 + 4 * fq;
#pragma unroll
        for (int pt = 0; pt < 4; ++pt) {
            if (g == 0) st[pt] = (fx4){0.f, 0.f, 0.f, 0.f};
            else st[pt] = *(const fx4*)((d ? p.st_ssd_b : p.st_ssd_f) + ((size_t)(((g - 1) * 4 + seq) * 32 + h) * 64 + pt * 16 + fr) * 128 + n0);
            *(uint2*)(Sb + (pt * 16 + fr) * 144 + n0) = pack4v(st[pt]);
        }
        const int oc = tid & 31, tq = tid >> 5; const int cha = (oc < 16 ? 2048 + grp * 128 + oc * 8 : 3072 + grp * 128 + (oc - 16) * 8);
        float wa0[8], wa1[8], wa2[8], ba[8];
        *(float4*)wa0 = *(const float4*)(p.ssd_conv_w + cha); *(float4*)(wa0 + 4) = *(const float4*)(p.ssd_conv_w + cha + 4);
        *(float4*)wa1 = *(const float4*)(p.ssd_conv_w + 4096 + cha); *(float4*)(wa1 + 4) = *(const float4*)(p.ssd_conv_w + 4096 + cha + 4);
        *(float4*)wa2 = *(const float4*)(p.ssd_conv_w + 8192 + cha); *(float4*)(wa2 + 4) = *(const float4*)(p.ssd_conv_w + 8192 + cha + 4);
        *(float4*)ba = *(const float4*)(p.ssd_conv_b + cha); *(float4*)(ba + 4) = *(const float4*)(p.ssd_conv_b + cha + 4);
        const int cx = h * 64 + (tid & 63);
        const float wx0 = p.ssd_conv_w[cx], wx1 = p.ssd_conv_w[4096 + cx], wx2 = p.ssd_conv_w[8192 + cx], bx = p.ssd_conv_b[cx];
        u16* ydst = (u16*)(p.ws + (d ? WS_YB : WS_G));
        uint4 pa[6]; unsigned px[10]; unsigned pdt = 0;
#define SSD_PREFETCH(T0) do { const int _t0 = (T0); \
            _Pragma("unroll") for (int k = 0; k < 6; ++k) { const int tp = _t0 + tq * 4 - 1 + k; \
                pa[k] = (tp >= 0 && tp < L) ? *(const uint4*)(P + (size_t)(row0 + tp) * NINP + 2048 + cha) : make_uint4(0u, 0u, 0u, 0u); } \
            _Pragma("unroll") for (int k = 0; k < 10; ++k) { const int tp = _t0 + (tid >> 6) * 8 - 1 + k; \
                px[k] = (tp >= 0 && tp < L) ? (unsigned)P[(size_t)(row0 + tp) * NINP + 2048 + cx] : 0u; } \
            if (wave == 0) pdt = (unsigned)P[(size_t)(row0 + _t0 + lane) * NINP + 6144 + d * 32 + h]; } while (0)
        SSD_PREFETCH((d ? nchunk - 1 : 0) * 64);
        for (int ci = 0; ci < nchunk; ++ci) {
            const int t0 = (d ? nchunk - 1 - ci : ci) * 64;
            if (wave == 0) {
                const float raw = bf2f((u16)pdt);
                const float dt = softplusf(raw + dtb), la = dt * a_neg;
                const float c = wave_prefix_sum(la);
                const float tot = wave_last(c);
                const float cm = d ? (tot - c + la) : c;
                cum[lane] = cm; dtv[lane] = dt; ecum[lane] = __expf(cm); wgt[lane] = dt * __expf(tot - cm);
                if (lane == 0) misc[0] = __expf(tot);
            }
            __syncthreads();
            {
                float rw[6][8];
#pragma unroll
                for (int k = 0; k < 6; ++k) unpack8(pa[k], rw[k]);
#pragma unroll
                for (int m = 0; m < 4; ++m) { float o[8];
#pragma unroll
                    for (int k = 0; k < 8; ++k) o[k] = siluf(wa0[k] * rw[m][k] + wa1[k] * rw[m + 1][k] + wa2[k] * rw[m + 2][k] + ba[k]);
                    *(uint4*)((oc < 16 ? Bs : Cs) + (tq * 4 + m) * 144 + (oc & 15) * 8) = pack8(o); }
            }
            {
                const int c = tid & 63, j0 = (tid >> 6) * 8;
                float o[8], ow[8];
#pragma unroll
                for (int k = 0; k < 8; ++k) { o[k] = siluf(wx0 * bf2f((u16)px[k]) + wx1 * bf2f((u16)px[k + 1]) + wx2 * bf2f((u16)px[k + 2]) + bx); ow[k] = o[k] * wgt[j0 + k]; }
                *(uint4*)(XT + c * 80 + j0) = pack8(o); *(uint4*)(XwT + c * 80 + j0) = pack8(ow);
            }
            __syncthreads();
            if (ci + 1 < nchunk) SSD_PREFETCH((d ? nchunk - 2 - ci : ci + 1) * 64);
#pragma unroll
            for (int it = 0; it < 2; ++it) {
                const int n = tid & 127, j0 = ((tid >> 7) + 4 * it) * 8;
                uint4 w; unsigned e[8];
#pragma unroll
                for (int k = 0; k < 8; ++k) e[k] = Bs[(j0 + k) * 144 + n];
                w.x = e[0] | (e[1] << 16); w.y = e[2] | (e[3] << 16); w.z = e[4] | (e[5] << 16); w.w = e[6] | (e[7] << 16);
                *(uint4*)(BT + n * 80 + j0) = w;
            }
#pragma unroll
            for (int tt = 0; tt < 2; ++tt) {
                const int id = wave * 2 + tt, jt = id >> 2, it = id & 3;
                fx4 acc = {0.f, 0.f, 0.f, 0.f};
#pragma unroll
                for (int ks = 0; ks < 4; ++ks) acc = mma16(*(const bfx8*)(Bs + (jt * 16 + fr) * 144 + ks * 32 + fq * 8), *(const bfx8*)(Cs + (it * 16 + fr) * 144 + ks * 32 + fq * 8), acc);
                asm volatile("s_nop 15" : "+v"(acc));
                const int i = it * 16 + fr; const float cmi = cum[i];
                fx4 m;
#pragma unroll
                for (int r = 0; r < 4; ++r) { const int j = jt * 16 + 4 * fq + r; const bool valid = d ? (j >= i) : (j <= i);
                    const float e = __expf(valid ? cmi - cum[j] : 0.f) * dtv[j]; m[r] = valid ? acc[r] * e : 0.f; }
                *(uint2*)(Ms + i * 80 + jt * 16 + 4 * fq) = pack4v(m);
            }
            __syncthreads();
#pragma unroll
            for (int tt = 0; tt < 2; ++tt) {
                const int id = wave * 2 + tt, pt = id >> 2, it = id & 3;
                fx4 acc = {0.f, 0.f, 0.f, 0.f};
#pragma unroll
                for (int ks = 0; ks < 4; ++ks) acc = mma16(*(const bfx8*)(Sb + (pt * 16 + fr) * 144 + ks * 32 + fq * 8), *(const bfx8*)(Cs + (it * 16 + fr) * 144 + ks * 32 + fq * 8), acc);
                asm volatile("s_nop 15" : "+v"(acc));
                const int i = it * 16 + fr; const float e = ecum[i];
                acc *= e;
#pragma unroll
                for (int ks = 0; ks < 2; ++ks) acc = mma16(*(const bfx8*)(XT + (pt * 16 + fr) * 80 + ks * 32 + fq * 8), *(const bfx8*)(Ms + (it * 16 + fr) * 80 + ks * 32 + fq * 8), acc);
                asm volatile("s_nop 15" : "+v"(acc));
                if (d == 0) {
#pragma unroll
                    for (int r = 0; r < 4; ++r) acc[r] += dskip * bf2f(XT[(pt * 16 + 4 * fq + r) * 80 + i]);
                }
                *(uint2*)(ydst + (size_t)(row0 + t0 + i) * DI + h * 64 + pt * 16 + 4 * fq) = pack4v(acc);
            }
            {
                const float cd = misc[0];
#pragma unroll
                for (int pt = 0; pt < 4; ++pt) {
                    st[pt] *= cd;
#pragma unroll
                    for (int ks = 0; ks < 2; ++ks) st[pt] = mma16(*(const bfx8*)(BT + (wave * 16 + fr) * 80 + ks * 32 + fq * 8), *(const bfx8*)(XwT + (pt * 16 + fr) * 80 + ks * 32 + fq * 8), st[pt]);
                    asm volatile("s_nop 15" : "+v"(st[pt]));
                }
            }
            __syncthreads();
#pragma unroll
            for (int pt = 0; pt < 4; ++pt) *(uint2*)(Sb + (pt * 16 + fr) * 144 + n0) = pack4v(st[pt]);
        }
        if (g == 0) {
#pragma unroll
            for (int pt = 0; pt < 4; ++pt) *(fx4*)(p.out + (d ? OUT_SSD_B : OUT_SSD_F) + ((size_t)(seq * 32 + h) * 64 + pt * 16 + fr) * 128 + n0) = st[pt];
        }
        __syncthreads();
    }
}
__device__ __forceinline__ void ssd_combine_phase(const Params& p) {
    const int tid = otid(), wave = tid >> 6, lane = tid & 63;
    u16* YF = (u16*)(p.ws + WS_G); const u16* YB = (const u16*)(p.ws + WS_YB); const u16* P = (const u16*)(p.ws + WS_P);
    for (int row = blockIdx.x * 8 + wave; row < TG; row += gridDim.x * 8) {
        float gv[32]; float ss = 0.f;
#pragma unroll
        for (int i = 0; i < 4; ++i) { const int c = i * 512 + lane * 8;
            float a[8], b[8], z[8]; unpack8(ldnt16(YF + (size_t)row * DI + c), a); unpack8(ldnt16(YB + (size_t)row * DI + c), b); unpack8(ldnt16(P + (size_t)row * NINP + c), z);
#pragma unroll
            for (int j = 0; j < 8; ++j) { const float v = (a[j] + b[j]) * siluf(z[j]); gv[i * 8 + j] = v; ss += v * v; } }
        ss = wave_sum(ss);
        const float r = rsqrtf(ss * (1.f / 2048.f) + 1e-6f);
#pragma unroll
        for (int i = 0; i < 4; ++i) { const int c = i * 512 + lane * 8; float nw[8], o[8];
            *(float4*)nw = *(const float4*)(p.ssd_norm_w + c); *(float4*)(nw + 4) = *(const float4*)(p.ssd_norm_w + c + 4);
#pragma unroll
            for (int j = 0; j < 8; ++j) o[j] = gv[i * 8 + j] * r * nw[j];
            *(uint4*)(YF + (size_t)row * DI + c) = pack8(o); }
    }
}
__device__ __forceinline__ void gdn_scan_phase(const Params& p, int g, float* lds) {
    const int tid = otid(), wave = tid >> 6, lane = tid & 63;
    const int L = g == 0 ? 256 : 2048, nseq = g == 0 ? 32 : 4, nitems = nseq * 64;
    float* qs = lds; float* ks = lds + 4096; float* vs = lds + 8192; float* obuf = lds + 10240; float* egs = lds + 12288; float* betas = lds + 12320; float* kqs = lds + 12352;
    const u16* P = (const u16*)(p.ws + WS_P);
    const int tok = tid >> 4, cgi = tid & 15;
    const int dvl = lane >> 3, dkg = lane & 7, dv = wave * 8 + dvl;
    for (int item = blockIdx.x; item < nitems; item += gridDim.x) {
        const int e = item & 1, d = (item >> 1) & 1, hv = (item >> 2) & 15, seq = item >> 6, kh = hv >> 1;
        const int row0 = seq * L;
        const float a_neg = -__expf(p.gdn_a_log[d * 16 + hv]), dtb = p.gdn_dt_bias[d * 16 + hv];
        float S[16];
        if (g == 0) {
#pragma unroll
            for (int i = 0; i < 16; ++i) S[i] = 0.f;
        } else {
            const float* s0 = (d ? p.st_gdn_b : p.st_gdn_f) + (size_t)(((g - 1) * 4 + seq) * 16 + hv) * 16384 + e * 64 + dv;
#pragma unroll
            for (int i = 0; i < 4; ++i)
#pragma unroll
                for (int j = 0; j < 4; ++j) S[4 * i + j] = s0[(size_t)(32 * i + 4 * dkg + j) * 128];
        }
        const int chq = kh * 128 + cgi * 8, chk = 1024 + kh * 128 + cgi * 8, chv = 2048 + hv * 128 + e * 64 + cgi * 4;
        u16* odst = (u16*)(p.ws + (d ? WS_YB : WS_G));
        for (int tile = 0; tile < L / 32; ++tile) {
            const int sidx = tile * 32 + tok; const int tp = d ? L - 1 - sidx : sidx;
            {
                const u16* r1 = P + (size_t)(row0 + tp) * NINP;
                const bool hm = tp > 0, hp = tp < L - 1;
                float q8[8], k8[8], v4[4];
                conv8(r1 + chq, NINP, hm, hp, p.gdn_conv_w + chq, 4096, q8);
                conv8(r1 + chk, NINP, hm, hp, p.gdn_conv_w + chk, 4096, k8);
                conv4(r1 + chv, NINP, hm, hp, p.gdn_conv_w + chv, 4096, v4);
                float sq = 0.f, sk = 0.f;
#pragma unroll
                for (int j = 0; j < 8; ++j) { q8[j] = siluf(q8[j]); k8[j] = siluf(k8[j]); sq += q8[j] * q8[j]; sk += k8[j] * k8[j]; }
                sq += __shfl_xor(sq, 1); sq += __shfl_xor(sq, 2); sq += __shfl_xor(sq, 4); sq += __shfl_xor(sq, 8);
                sk += __shfl_xor(sk, 1); sk += __shfl_xor(sk, 2); sk += __shfl_xor(sk, 4); sk += __shfl_xor(sk, 8);
                const float rq = rsqrtf(sq + 1e-6f) * 0.08838834764831845f, rk = rsqrtf(sk + 1e-6f);
                float kq = 0.f;
#pragma unroll
                for (int j = 0; j < 8; ++j) { q8[j] *= rq; k8[j] *= rk; kq += q8[j] * k8[j]; }
                kq += __shfl_xor(kq, 1); kq += __shfl_xor(kq, 2); kq += __shfl_xor(kq, 4); kq += __shfl_xor(kq, 8);
                *(float4*)(qs + tok * 128 + cgi * 8) = *(float4*)q8; *(float4*)(qs + tok * 128 + cgi * 8 + 4) = *(float4*)(q8 + 4);
                *(float4*)(ks + tok * 128 + cgi * 8) = *(float4*)k8; *(float4*)(ks + tok * 128 + cgi * 8 + 4) = *(float4*)(k8 + 4);
                float4 vo; vo.x = siluf(v4[0]); vo.y = siluf(v4[1]); vo.z = siluf(v4[2]); vo.w = siluf(v4[3]);
                *(float4*)(vs + tok * 64 + cgi * 4) = vo;
                if (cgi == 0) {
                    const float a_raw = bf2f(r1[6144 + d * 16 + hv]), b_raw = bf2f(r1[6176 + d * 16 + hv]);
                    egs[tok] = __expf(a_neg * softplusf(a_raw + dtb)); betas[tok] = 1.f / (1.f + __expf(-b_raw)); kqs[tok] = kq;
                }
            }
            __syncthreads();
            for (int tt = 0; tt < 32; ++tt) {
                const float eg = egs[tt], be = betas[tt], kq = kqs[tt], v = vs[tt * 64 + dv];
                float kk[16]; float u = 0.f, w = 0.f;
#pragma unroll
                for (int i = 0; i < 4; ++i) {
                    const float4 k4 = *(const float4*)(ks + tt * 128 + 32 * i + 4 * dkg), q4 = *(const float4*)(qs + tt * 128 + 32 * i + 4 * dkg);
                    kk[4 * i] = k4.x; kk[4 * i + 1] = k4.y; kk[4 * i + 2] = k4.z; kk[4 * i + 3] = k4.w;
                    u += S[4 * i] * k4.x + S[4 * i + 1] * k4.y + S[4 * i + 2] * k4.z + S[4 * i + 3] * k4.w;
                    w += S[4 * i] * q4.x + S[4 * i + 1] * q4.y + S[4 * i + 2] * q4.z + S[4 * i + 3] * q4.w;
                }
                u += __shfl_xor(u, 1); w += __shfl_xor(w, 1); u += __shfl_xor(u, 2); w += __shfl_xor(w, 2); u += __shfl_xor(u, 4); w += __shfl_xor(w, 4);
                const float delta = be * (v - eg * u);
#pragma unroll
                for (int i = 0; i < 16; ++i) S[i] = S[i] * eg + kk[i] * delta;
                if (dkg == 0) obuf[tt * 64 + dv] = eg * w + delta * kq;
            }
            __syncthreads();
            {   const float4 y = *(const float4*)(obuf + tok * 64 + cgi * 4); uint2 w; w.x = pk2(y.x, y.y); w.y = pk2(y.z, y.w);
                *(uint2*)(odst + (size_t)(row0 + tp) * DI + hv * 128 + e * 64 + cgi * 4) = w; }
        }
        if (g == 0) {
            float* so = p.out + (d ? OUT_GDN_B : OUT_GDN_F) + (size_t)(seq * 16 + hv) * 16384 + e * 64 + dv;
#pragma unroll
            for (int i = 0; i < 4; ++i)
#pragma unroll
                for (int j = 0; j < 4; ++j) so[(size_t)(32 * i + 4 * dkg + j) * 128] = S[4 * i + j];
        }
        __syncthreads();
    }
}

__device__ __forceinline__ void gdn_scan_mfma(const Params& p, int g, unsigned char* lds) {
    const int tid = otid(), wave = tid >> 6, lane = tid & 63, fr = lane & 15, fq = lane >> 4;
    const int L = g == 0 ? 256 : 2048, nseq = g == 0 ? 32 : 4, nitems = nseq * 64, nchunk = L / 64;
    float* R32 = (float*)lds; float* Adg = R32 + 64 * 64; u16* VnT = (u16*)(Adg + 64 * 20); u16* QKm = VnT + 64 * 80; u16* Abf = QKm + 64 * 80; u16* TB = Abf + 64 * 80; u16* RT = TB + 64 * 40;
    float* cum = (float*)(RT + 64 * 40); float* ecum = cum + 64; float* beta = cum + 128; float* edec = cum + 192; float* misc = cum + 256;
    u16* Kn = (u16*)(cum + 320); u16* Qn = Kn + 64 * 144; u16* KdT = Qn + 64 * 144; u16* ST = KdT + 128 * 80;
    const u16* P = (const u16*)(p.ws + WS_P);
    const int tok = tid >> 4, cgi = tid & 15;
    for (int item0 = ((gridDim.x & 7) == 0 ? (int)((blockIdx.x & 7) * (gridDim.x >> 3) + (blockIdx.x >> 3)) : (int)blockIdx.x); item0 < nitems; item0 += gridDim.x) {
        const int item = item0;
        const int e = item & 1, d = (item >> 1) & 1, hv = (item >> 2) & 15, seq = item >> 6, kh = hv >> 1;
        const int row0 = seq * L;
        const float a_neg = -__expf(p.gdn_a_log[d * 16 + hv]), dtb = p.gdn_dt_bias[d * 16 + hv];
        fx4 st[4];
        const int dk0 = wave * 16 + 4 * fq;
#pragma unroll
        for (int pt = 0; pt < 4; ++pt) {
            if (g == 0) st[pt] = (fx4){0.f, 0.f, 0.f, 0.f};
            else { const float* s0 = (d ? p.st_gdn_b : p.st_gdn_f) + (size_t)(((g - 1) * 4 + seq) * 16 + hv) * 16384 + e * 64 + pt * 16 + fr;
#pragma unroll
                for (int r = 0; r < 4; ++r) st[pt][r] = s0[(size_t)(dk0 + r) * 128]; }
            *(uint2*)(ST + (pt * 16 + fr) * 144 + dk0) = pack4v(st[pt]);
        }
        for (int z = tid; z < 640; z += NTHREADS) ((uint4*)TB)[z] = make_uint4(0u, 0u, 0u, 0u);
        u16* odst = (u16*)(p.ws + (d ? WS_YB : WS_G));
        uint4 pq[4], pk[4]; uint2 pv[4]; unsigned pa_raw = 0, pb_raw = 0;
#define GDN_PREFETCH(T0) do { const int _t0 = (T0); const int _tok = tid >> 4, _cg = tid & 15; \
            const int _tpl = d ? _t0 + 62 - 2 * _tok : _t0 + 2 * _tok; \
            _Pragma("unroll") for (int k = 0; k < 4; ++k) { const int tp = _tpl - 1 + k; const bool ok = tp >= 0 && tp < L; const u16* r1 = P + (size_t)(row0 + tp) * NINP; \
                pq[k] = ok ? *(const uint4*)(r1 + kh * 128 + _cg * 8) : make_uint4(0u, 0u, 0u, 0u); \
                pk[k] = ok ? *(const uint4*)(r1 + 1024 + kh * 128 + _cg * 8) : make_uint4(0u, 0u, 0u, 0u); \
                pv[k] = ok ? *(const uint2*)(r1 + 2048 + hv * 128 + e * 64 + _cg * 4) : make_uint2(0u, 0u); } \
            if ((tid >> 6) == 0) { const int tp = d ? _t0 + 63 - (tid & 63) : _t0 + (tid & 63); const u16* r1 = P + (size_t)(row0 + tp) * NINP; \
                pa_raw = (unsigned)r1[6144 + d * 16 + hv]; pb_raw = (unsigned)r1[6176 + d * 16 + hv]; } } while (0)
        GDN_PREFETCH((d ? nchunk - 1 : 0) * 64);
        float wq[3][8], wk[3][8], wv[3][4];
        { const int _cg = tid & 15; const int chq = kh * 128 + _cg * 8, chk = 1024 + kh * 128 + _cg * 8, chv = 2048 + hv * 128 + e * 64 + _cg * 4;
#pragma unroll
          for (int t = 0; t < 3; ++t) {
            *(float4*)wq[t] = *(const float4*)(p.gdn_conv_w + t * 4096 + chq); *(float4*)(wq[t] + 4) = *(const float4*)(p.gdn_conv_w + t * 4096 + chq + 4);
            *(float4*)wk[t] = *(const float4*)(p.gdn_conv_w + t * 4096 + chk); *(float4*)(wk[t] + 4) = *(const float4*)(p.gdn_conv_w + t * 4096 + chk + 4);
            *(float4*)wv[t] = *(const float4*)(p.gdn_conv_w + t * 4096 + chv); } }
        for (int ci = 0; ci < nchunk; ++ci) {
            const int t0 = (d ? nchunk - 1 - ci : ci) * 64;
            const int tid = otid(), wave = tid >> 6, lane = tid & 63, fr = lane & 15, fq = lane >> 4, tok = tid >> 4, cgi = tid & 15, dk0 = wave * 16 + 4 * fq;
            int lz = 0; asm volatile("" : "+v"(lz));
            unsigned char* lb = lds + lz;
            float* R32 = (float*)lb; float* Adg = R32 + 64 * 64; u16* VnT = (u16*)(Adg + 64 * 20); u16* QKm = VnT + 64 * 80; u16* Abf = QKm + 64 * 80; u16* TB = Abf + 64 * 80; u16* RT = TB + 64 * 40;
            float* cum = (float*)(RT + 64 * 40); float* ecum = cum + 64; float* beta = cum + 128; float* edec = cum + 192; float* misc = cum + 256;
            u16* Kn = (u16*)(cum + 320); u16* Qn = Kn + 64 * 144; u16* KdT = Qn + 64 * 144; u16* ST = KdT + 128 * 80;
            const int chq = kh * 128 + cgi * 8, chk = 1024 + kh * 128 + cgi * 8, chv = 2048 + hv * 128 + e * 64 + cgi * 4;
            if (wave == 0) {
                const float a_raw = bf2f((u16)pa_raw), b_raw = bf2f((u16)pb_raw);
                const float c = wave_prefix_sum(a_neg * softplusf(a_raw + dtb));
                const float tot = wave_last(c);
                cum[lane] = c; ecum[lane] = __expf(c); beta[lane] = __builtin_amdgcn_rcpf(1.f + __expf(-b_raw)); edec[lane] = __expf(tot - c);
                if (lane == 0) misc[0] = __expf(tot);
            }
            __syncthreads();
            for (int z = tid; z < 640; z += NTHREADS) ((uint4*)VnT)[z] = make_uint4(0u, 0u, 0u, 0u);
            {
                float rq[4][8], rk[4][8], rv[4][4];
#pragma unroll
                for (int k = 0; k < 4; ++k) { unpack8(pq[k], rq[k]); unpack8(pk[k], rk[k]); unpack4(pv[k], rv[k]); }
#pragma unroll
                for (int m = 0; m < 2; ++m) {
                    const int i = (m == 0) ? (d ? 2 * tok + 1 : 2 * tok) : (d ? 2 * tok : 2 * tok + 1);
                    float q8[8], k8[8], v4[4]; float sq = 0.f, sk = 0.f;
#pragma unroll
                    for (int k = 0; k < 8; ++k) { q8[k] = siluf(wq[0][k] * rq[m][k] + wq[1][k] * rq[m + 1][k] + wq[2][k] * rq[m + 2][k]); sq += q8[k] * q8[k];
                        k8[k] = siluf(wk[0][k] * rk[m][k] + wk[1][k] * rk[m + 1][k] + wk[2][k] * rk[m + 2][k]); sk += k8[k] * k8[k]; }
#pragma unroll
                    for (int k = 0; k < 4; ++k) v4[k] = siluf(wv[0][k] * rv[m][k] + wv[1][k] * rv[m + 1][k] + wv[2][k] * rv[m + 2][k]);
                    sq += __shfl_xor(sq, 1); sq += __shfl_xor(sq, 2); sq += __shfl_xor(sq, 4); sq += __shfl_xor(sq, 8);
                    sk += __shfl_xor(sk, 1); sk += __shfl_xor(sk, 2); sk += __shfl_xor(sk, 4); sk += __shfl_xor(sk, 8);
                    const float rqn = rsqrtf(sq + 1e-6f) * 0.08838834764831845f, rkn = rsqrtf(sk + 1e-6f);
#pragma unroll
                    for (int k = 0; k < 8; ++k) { q8[k] *= rqn; k8[k] *= rkn; }
                    *(uint4*)(Qn + i * 144 + cgi * 8) = pack8(q8); *(uint4*)(Kn + i * 144 + cgi * 8) = pack8(k8);
                    const float bi = beta[i];
                    float4 rvv; rvv.x = bi * v4[0]; rvv.y = bi * v4[1]; rvv.z = bi * v4[2]; rvv.w = bi * v4[3];
                    *(float4*)(R32 + i * 64 + cgi * 4) = rvv;
                }
            }
            __syncthreads();
            if (ci + 1 < nchunk) GDN_PREFETCH((d ? nchunk - 2 - ci : ci + 1) * 64);
#pragma unroll
            for (int tt = 0; tt < 2; ++tt) {
                const int id = wave * 2 + tt, jt = id >> 2, it = id & 3;
                fx4 accA = {0.f, 0.f, 0.f, 0.f}, accQ = {0.f, 0.f, 0.f, 0.f};
#pragma unroll
                for (int ks = 0; ks < 4; ++ks) { const bfx8 a = *(const bfx8*)(Kn + (jt * 16 + fr) * 144 + ks * 32 + fq * 8);
                    accA = mma16(a, *(const bfx8*)(Kn + (it * 16 + fr) * 144 + ks * 32 + fq * 8), accA);
                    accQ = mma16(a, *(const bfx8*)(Qn + (it * 16 + fr) * 144 + ks * 32 + fq * 8), accQ); }
                asm volatile("s_nop 15" : "+v"(accA), "+v"(accQ));
                const int i = it * 16 + fr; const float cmi = cum[i], bi = beta[i];
                fx4 mA, mQ;
#pragma unroll
                for (int r = 0; r < 4; ++r) { const int j = jt * 16 + 4 * fq + r;
                    const float dec = __expf(j <= i ? cmi - cum[j] : 0.f);
                    mA[r] = j < i ? bi * accA[r] * dec : 0.f; mQ[r] = j <= i ? accQ[r] * dec : 0.f; }
                *(uint2*)(Abf + i * 80 + jt * 16 + 4 * fq) = pack4v(mA);
                if (jt == it) *(fx4*)(Adg + i * 20 + 4 * fq) = mA;
                *(uint2*)(QKm + i * 80 + jt * 16 + 4 * fq) = pack4v(mQ);
            }
            __syncthreads();
            if (wave == 4) {
                const int tb = lane >> 4, tc = lane & 15;
                float t[16]; float4 nx[4];
#pragma unroll
                for (int j4 = 0; j4 < 1; ++j4) nx[j4] = *(const float4*)(Adg + (tb * 16 + 1) * 20 + j4 * 4);
#pragma unroll
                for (int i = 0; i < 16; ++i) {
                    float4 cu[4];
#pragma unroll
                    for (int j4 = 0; j4 < 4; ++j4) cu[j4] = nx[j4];
                    if (i >= 1 && i < 15) {
#pragma unroll
                        for (int j4 = 0; j4 < (i + 4) / 4; ++j4) nx[j4] = *(const float4*)(Adg + (tb * 16 + i + 1) * 20 + j4 * 4);
                    }
                    float acc = (i == tc) ? 1.f : 0.f;
#pragma unroll
                    for (int j4 = 0; j4 < (i + 3) / 4; ++j4) {
                        const float4 a = cu[j4];
                        if (j4 * 4 + 0 < i) acc -= a.x * t[j4 * 4 + 0];
                        if (j4 * 4 + 1 < i) acc -= a.y * t[j4 * 4 + 1];
                        if (j4 * 4 + 2 < i) acc -= a.z * t[j4 * 4 + 2];
                        if (j4 * 4 + 3 < i) acc -= a.w * t[j4 * 4 + 3];
                    }
                    t[i] = acc;
                    __builtin_amdgcn_sched_barrier(0);
                }
#pragma unroll
                for (int i = 0; i < 16; ++i) TB[(tb * 16 + i) * 40 + tc] = (u16)(pk2(t[i], 0.f) & 0xffffu);
            }
            fx4 oacc[2];
#pragma unroll
            for (int tt = 0; tt < 2; ++tt) {
                const int id = wave * 2 + tt, pt = id >> 2, it = id & 3;
                fx4 accK = {0.f, 0.f, 0.f, 0.f}, accQ = {0.f, 0.f, 0.f, 0.f};
#pragma unroll
                for (int ks = 0; ks < 4; ++ks) { const bfx8 a = *(const bfx8*)(ST + (pt * 16 + fr) * 144 + ks * 32 + fq * 8);
                    accK = mma16(a, *(const bfx8*)(Kn + (it * 16 + fr) * 144 + ks * 32 + fq * 8), accK);
                    accQ = mma16(a, *(const bfx8*)(Qn + (it * 16 + fr) * 144 + ks * 32 + fq * 8), accQ); }
                asm volatile("s_nop 15" : "+v"(accK), "+v"(accQ));
                const int i = it * 16 + fr; const float ei = ecum[i], bei = beta[i] * ei;
                fx4 rr = *(const fx4*)(R32 + i * 64 + pt * 16 + 4 * fq);
                rr -= accK * bei;
                *(fx4*)(R32 + i * 64 + pt * 16 + 4 * fq) = rr;
                oacc[tt] = accQ * ei;
            }
            __syncthreads();
            if (wave >= 4) {
                const int t4 = tid - 256;
#pragma unroll
                for (int it2 = 0; it2 < 4; ++it2) {
                    const int dk = t4 & 127, j0 = ((t4 >> 7) + 2 * it2) * 8;
                    float o[8];
#pragma unroll
                    for (int k = 0; k < 8; ++k) o[k] = bf2f(Kn[(j0 + k) * 144 + dk]) * edec[j0 + k];
                    *(uint4*)(KdT + dk * 80 + j0) = pack8(o);
                }
            }
            if (wave < 4) {
#pragma unroll
                for (int b = 0; b < 4; ++b) {
                    fx4 u = {0.f, 0.f, 0.f, 0.f};
                    if (b > 0) {
#pragma unroll
                        for (int ks = 0; ks < 2; ++ks) u = mma16(*(const bfx8*)(VnT + (wave * 16 + fr) * 80 + ks * 32 + fq * 8), *(const bfx8*)(Abf + (b * 16 + fr) * 80 + ks * 32 + fq * 8), u);
                        asm volatile("s_nop 15" : "+v"(u));
                    }
                    fx4 rr = *(const fx4*)(R32 + (b * 16 + fr) * 64 + wave * 16 + 4 * fq);
                    rr -= u;
#pragma unroll
                    for (int r = 0; r < 4; ++r) RT[(wave * 16 + 4 * fq + r) * 40 + fr] = (u16)(pk2(rr[r], 0.f) & 0xffffu);
                    asm volatile("s_waitcnt lgkmcnt(0)" ::: "memory");
                    fx4 xb = {0.f, 0.f, 0.f, 0.f};
                    xb = mma16(*(const bfx8*)(RT + (wave * 16 + fr) * 40 + fq * 8), *(const bfx8*)(TB + (b * 16 + fr) * 40 + fq * 8), xb);
                    asm volatile("s_nop 15" : "+v"(xb));
#pragma unroll
                    for (int r = 0; r < 4; ++r) VnT[(wave * 16 + 4 * fq + r) * 80 + b * 16 + fr] = (u16)(pk2(xb[r], 0.f) & 0xffffu);
                    asm volatile("s_waitcnt lgkmcnt(0)" ::: "memory");
                }
            }
            __syncthreads();
#pragma unroll
            for (int tt = 0; tt < 2; ++tt) {
                const int id = wave * 2 + tt, pt = id >> 2, it = id & 3;
#pragma unroll
                for (int ks = 0; ks < 2; ++ks) oacc[tt] = mma16(*(const bfx8*)(VnT + (pt * 16 + fr) * 80 + ks * 32 + fq * 8), *(const bfx8*)(QKm + (it * 16 + fr) * 80 + ks * 32 + fq * 8), oacc[tt]);
                asm volatile("s_nop 15" : "+v"(oacc[tt]));
                const int i = it * 16 + fr, tp = d ? t0 + 63 - i : t0 + i;
                *(uint2*)(odst + (size_t)(row0 + tp) * DI + hv * 128 + e * 64 + pt * 16 + 4 * fq) = pack4v(oacc[tt]);
            }
            __syncthreads();
            {
                const float cd = misc[0];
#pragma unroll
                for (int pt = 0; pt < 4; ++pt) {
                    st[pt] *= cd;
#pragma unroll
                    for (int ks = 0; ks < 2; ++ks) st[pt] = mma16(*(const bfx8*)(KdT + (wave * 16 + fr) * 80 + ks * 32 + fq * 8), *(const bfx8*)(VnT + (pt * 16 + fr) * 80 + ks * 32 + fq * 8), st[pt]);
                    asm volatile("s_nop 15" : "+v"(st[pt]));
                }
            }
            __syncthreads();
#pragma unroll
            for (int pt = 0; pt < 4; ++pt) *(uint2*)(ST + (pt * 16 + fr) * 144 + dk0) = pack4v(st[pt]);
        }
        if (g == 0) {
            float* so = p.out + (d ? OUT_GDN_B : OUT_GDN_F) + (size_t)(seq * 16 + hv) * 16384 + e * 64;
#pragma unroll
            for (int pt = 0; pt < 4; ++pt)
#pragma unroll
                for (int r = 0; r < 4; ++r) so[(size_t)(dk0 + r) * 128 + pt * 16 + fr] = st[pt][r];
        }
        __syncthreads();
    }
}
__device__ __forceinline__ void gdn_combine_phase(const Params& p) {
    const int tid = otid(), wave = tid >> 6, lane = tid & 63;
    u16* YF = (u16*)(p.ws + WS_G); const u16* YB = (const u16*)(p.ws + WS_YB); const u16* P = (const u16*)(p.ws + WS_P);
    float nw[8];
    *(float4*)nw = *(const float4*)(p.gdn_norm_w + (lane & 15) * 8); *(float4*)(nw + 4) = *(const float4*)(p.gdn_norm_w + (lane & 15) * 8 + 4);
    for (int row = blockIdx.x * 8 + wave; row < TG; row += gridDim.x * 8) {
#pragma unroll
        for (int i = 0; i < 4; ++i) { const int c = i * 512 + lane * 8;
            float a[8], b[8], z[8], o[8]; unpack8(ldnt16(YF + (size_t)row * DI + c), a); unpack8(ldnt16(YB + (size_t)row * DI + c), b); unpack8(ldnt16(P + (size_t)row * NINP + 4096 + c), z);
            float ss = 0.f;
#pragma unroll
            for (int j = 0; j < 8; ++j) { a[j] += b[j]; ss += a[j] * a[j]; }
            ss += __shfl_xor(ss, 1); ss += __shfl_xor(ss, 2); ss += __shfl_xor(ss, 4); ss += __shfl_xor(ss, 8);
            const float r = rsqrtf(ss * (1.f / 128.f) + 1e-6f);
#pragma unroll
            for (int j = 0; j < 8; ++j) o[j] = a[j] * r * nw[j] * siluf(z[j]);
            *(uint4*)(YF + (size_t)row * DI + c) = pack8(o); }
    }
}
__device__ __forceinline__ void ln_phase(const Params& p, int l, int which, int g, int wg0, int nwg) {
    const int tid = otid(), wave = tid >> 6, lane = tid & 63;
    if ((int)blockIdx.x < wg0) return;
    const u16* O = (const u16*)(p.ws + (which ? WS_YB : WS_P));
    const float* adab = (const float*)(p.ws + WS_ADA); u16* H = (u16*)(p.ws + WS_H);
    const float* lg = p.ln_g + (l * 2 + which) * 1024; const float* lb = p.ln_b + (l * 2 + which) * 1024;
    const bool has_next = !(l == 1 && which == 1);
    for (int row = ((int)blockIdx.x - wg0) * 8 + wave; row < TG; row += nwg * 8) {
        const int t = g * TG + row, cond = cond_of(t);
        const float* xr = (l == 0 && which == 0) ? xin_row(p, t) : p.out + (size_t)t * D;
        const float* ada = adab + (size_t)(l * 9 + cond) * 6144;
        const float* gate = ada + (which ? 5120 : 2048);
        float v[16]; float s = 0.f;
#pragma unroll
        for (int i = 0; i < 4; ++i) { const int c = i * 256 + lane * 4;
            const float4 x = ldnt16f(xr + c), gt = *(const float4*)(gate + c);
            float o0[4], o1[4]; unpack4(ldnt8(O + (size_t)row * D + c), o0); unpack4(ldnt8(O + (size_t)TG * D + (size_t)row * D + c), o1);
            float4 o; o.x = o0[0] + o1[0]; o.y = o0[1] + o1[1]; o.z = o0[2] + o1[2]; o.w = o0[3] + o1[3];
            v[4 * i] = ALPHA * x.x + gt.x * o.x; v[4 * i + 1] = ALPHA * x.y + gt.y * o.y; v[4 * i + 2] = ALPHA * x.z + gt.z * o.z; v[4 * i + 3] = ALPHA * x.w + gt.w * o.w;
            s += v[4 * i] + v[4 * i + 1] + v[4 * i + 2] + v[4 * i + 3]; }
        const float mean = wave_sum(s) * (1.f / 1024.f);
        float q = 0.f;
#pragma unroll
        for (int i = 0; i < 16; ++i) { v[i] -= mean; q += v[i] * v[i]; }
        const float rstd = rsqrtf(wave_sum(q) * (1.f / 1024.f) + 1e-5f);
        const float* nsh = which == 0 ? ada + 3072 : adab + (size_t)((l + 1) * 9 + cond) * 6144;
        const float* nsc = nsh + 1024;
#pragma unroll
        for (int i = 0; i < 4; ++i) { const int c = i * 256 + lane * 4;
            const float4 gg = *(const float4*)(lg + c), bb = *(const float4*)(lb + c);
            float4 y; y.x = v[4 * i] * rstd * gg.x + bb.x; y.y = v[4 * i + 1] * rstd * gg.y + bb.y; y.z = v[4 * i + 2] * rstd * gg.z + bb.z; y.w = v[4 * i + 3] * rstd * gg.w + bb.w;
            *(float4*)(p.out + (size_t)t * D + c) = y;
            if (has_next) { const float4 sh = *(const float4*)(nsh + c), sc = *(const float4*)(nsc + c);
                uint2 w; w.x = pk2(y.x * (1.f + sc.x) + sh.x, y.y * (1.f + sc.y) + sh.y); w.y = pk2(y.z * (1.f + sc.z) + sh.z, y.w * (1.f + sc.w) + sh.w);
                *(uint2*)(H + (size_t)t * D + c) = w; } }
    }
}
__device__ __forceinline__ void convgate_phase(const Params& p, int l, int g) {
    const int tid = otid();
    const u16* U = (const u16*)(p.ws + WS_P); u16* G = (u16*)(p.ws + WS_G);
    const int rpb = (TG + gridDim.x - 1) / gridDim.x;
    const int r_lo = blockIdx.x * rpb, r_hi = min(TG, r_lo + rpb);
    if (tid >= 352) return;
    const int c = tid * 8;
    const float* cw = p.ffn_conv_w + (size_t)l * 9 * FF + c;
    float bias[8]; *(float4*)bias = *(const float4*)(p.ffn_conv_b + l * FF + c); *(float4*)(bias + 4) = *(const float4*)(p.ffn_conv_b + l * FF + c + 4);
    if (g == 0) {
        float w[3][8];
#pragma unroll
        for (int j = 0; j < 3; ++j) { *(float4*)w[j] = *(const float4*)(cw + (3 + j) * FF); *(float4*)(w[j] + 4) = *(const float4*)(cw + (3 + j) * FF + 4); }
        for (int row = r_lo; row < r_hi; ++row) {
            const int tp = row & 255;
            uint4 dv[3];
#pragma unroll
            for (int j = 0; j < 3; ++j) { const bool ok = (unsigned)(tp + j - 1) < 256u; dv[j] = *(const uint4*)(U + (size_t)(row + (ok ? j - 1 : 0)) * FF2 + c); }
            const uint4 vraw = *(const uint4*)(U + (size_t)row * FF2 + FF + c);
            float acc[8];
#pragma unroll
            for (int k = 0; k < 8; ++k) acc[k] = bias[k];
#pragma unroll
            for (int j = 0; j < 3; ++j) { const float m = (unsigned)(tp + j - 1) < 256u ? 1.f : 0.f; float a[8]; unpack8(dv[j], a);
#pragma unroll
                for (int k = 0; k < 8; ++k) acc[k] += (m * w[j][k]) * a[k]; }
            float vv[8], o[8]; unpack8(vraw, vv);
#pragma unroll
            for (int k = 0; k < 8; ++k) o[k] = siluf(acc[k]) * vv[k];
            *(uint4*)(G + (size_t)row * FF + c) = pack8(o);
        }
    } else {
        float w[9][8];
#pragma unroll
        for (int t = 0; t < 9; ++t) { *(float4*)w[t] = *(const float4*)(cw + t * FF); *(float4*)(w[t] + 4) = *(const float4*)(cw + t * FF + 4); }
        for (int row = r_lo; row < r_hi; ++row) {
            const int tp = row & 2047, gr = tp >> 6, gc = tp & 63;
            uint4 dv[9];
#pragma unroll
            for (int i = 0; i < 3; ++i)
#pragma unroll
                for (int j = 0; j < 3; ++j) { const bool ok = (unsigned)(gr + i - 1) < 32u && (unsigned)(gc + j - 1) < 64u;
                    dv[i * 3 + j] = *(const uint4*)(U + (size_t)(row + (ok ? (i - 1) * 64 + (j - 1) : 0)) * FF2 + c); }
            const uint4 vraw = *(const uint4*)(U + (size_t)row * FF2 + FF + c);
            float acc[8];
#pragma unroll
            for (int k = 0; k < 8; ++k) acc[k] = bias[k];
#pragma unroll
            for (int i = 0; i < 3; ++i)
#pragma unroll
                for (int j = 0; j < 3; ++j) { const float m = ((unsigned)(gr + i - 1) < 32u && (unsigned)(gc + j - 1) < 64u) ? 1.f : 0.f; float a[8]; unpack8(dv[i * 3 + j], a);
#pragma unroll
                    for (int k = 0; k < 8; ++k) acc[k] += (m * w[i * 3 + j][k]) * a[k]; }
            float vv[8], o[8]; unpack8(vraw, vv);
#pragma unroll
            for (int k = 0; k < 8; ++k) o[k] = siluf(acc[k]) * vv[k];
            *(uint4*)(G + (size_t)row * FF + c) = pack8(o);
        }
    }
}
__device__ __forceinline__ void gemm_bf16out(PG8_LAS unsigned char* lds, const u16* A, const u16* Bt, u16* O, int M, int N, int K) {
    pg8::Gemm gg{A, Bt, M, N, K, K, N / 256}; pg8::StaticOrder S; S.init(M, N, (int)gridDim.x, (int)blockIdx.x);
    pg8::EpiBf16 E{O, N, N / 256, 0};
    pg8::gemm_phase<pg8::EpiBf16, pg8::StaticOrder>(lds, gg, S, E, nullptr);
}
__device__ __forceinline__ void gemm_f32out(PG8_LAS unsigned char* lds, const u16* A, const u16* Bt, float* C, int M, int N, int K) {
    pg8::Gemm gg{A, Bt, M, 2 * N, K / 2, K, N / 256}; pg8::StaticOrder S; S.init(M, 2 * N, (int)gridDim.x, (int)blockIdx.x);
    pg8::EpiBf16 E{(u16*)C, N, N / 256, (size_t)M * N};
    pg8::gemm_phase<pg8::EpiBf16, pg8::StaticOrder>(lds, gg, S, E, nullptr);
}


__device__ __forceinline__ void grid_bar(unsigned* ctr, unsigned target) {
    asm volatile("s_waitcnt vmcnt(0)" ::: "memory");
    __syncthreads();
    if (threadIdx.x < 64) {
        if (threadIdx.x == 0) {
            __builtin_amdgcn_fence(__ATOMIC_RELEASE, "agent");
            asm volatile("s_waitcnt vmcnt(0)" ::: "memory");
            __hip_atomic_fetch_add(ctr, 1u, __ATOMIC_RELAXED, __HIP_MEMORY_SCOPE_AGENT);
            while (__hip_atomic_load(ctr, __ATOMIC_RELAXED, __HIP_MEMORY_SCOPE_AGENT) < target) __builtin_amdgcn_s_sleep(1);
        }
        __builtin_amdgcn_fence(__ATOMIC_ACQUIRE, "agent");
        asm volatile("s_waitcnt vmcnt(0)" ::: "memory");
    }
    __syncthreads();
}

#define XB_TMO      128
#define XB_XCNT(j)  (256  + 64 * (j))
#define XB_XSUB(j)  (1280 + 64 * (j))
#define XB_XGEN(j)  (2304 + 64 * (j))
#define XB_TOP      3328
#define XB_TOPGEN   3392
#define XCD_BAR_WORDS 3456
#define XB_SPIN_CAP (1u << 18)
#define LAS __attribute__((address_space(3)))

__device__ __forceinline__ unsigned xb_ld(unsigned* p)              { return __hip_atomic_load(p, __ATOMIC_RELAXED, __HIP_MEMORY_SCOPE_AGENT); }
__device__ __forceinline__ unsigned xb_add(unsigned* p, unsigned v) { return __hip_atomic_fetch_add(p, v, __ATOMIC_RELAXED, __HIP_MEMORY_SCOPE_AGENT); }
__device__ __forceinline__ unsigned xb_xcc_id() { return (unsigned)__builtin_amdgcn_s_getreg((3 << 11) | 20) & 0xFu; }
#define XB_SPIN(cond, bar) do { unsigned _sp = 0; while (cond) { __builtin_amdgcn_s_sleep(1); \
    if ((++_sp & 255u) == 0u) { if (xb_ld(&(bar)[XB_TMO])) break; if (_sp > XB_SPIN_CAP) { atomicAdd(&(bar)[XB_TMO], 1u); break; } } } } while (0)
struct XcdBarrier {
    unsigned* bar; unsigned x;
    volatile LAS unsigned* st;
};

__device__ __forceinline__ XcdBarrier xcd_barrier_post(unsigned* bar, volatile LAS unsigned* st) {
    XcdBarrier b; b.bar = bar; b.x = xb_xcc_id(); b.st = st;
    if (threadIdx.x == 0) (void)xb_add(&bar[XB_XCNT(b.x)], 1u);
    return b;
}
__device__ __forceinline__ void xcd_barrier_complete(unsigned* bar, unsigned x, unsigned& nloc, unsigned& nx) {
    const unsigned G = gridDim.x * gridDim.y * gridDim.z;
    unsigned sum, cnt, mine, sp = 0u;
    for (;;) {
        sum = 0u; cnt = 0u; mine = 0u;
#pragma unroll
        for (unsigned j = 0; j < 16; ++j) { const unsigned c = xb_ld(&bar[XB_XCNT(j)]); sum += c; cnt += (c > 0u) ? 1u : 0u; mine = (j == x) ? c : mine; }
        if (sum == G) break;
        __builtin_amdgcn_s_sleep(1);
        if ((++sp & 255u) == 0u) { if (xb_ld(&bar[XB_TMO])) break; if (sp > XB_SPIN_CAP) { atomicAdd(&bar[XB_TMO], 1u); break; } }
    }
    nloc = mine > 0u ? mine : 1u; nx = cnt > 0u ? cnt : 1u;
}

__device__ __forceinline__ void xcd_barrier(const XcdBarrier& b) {
    asm volatile("s_waitcnt vmcnt(0)" ::: "memory");
    __syncthreads();
    if (threadIdx.x == 0) {
        unsigned* bar = b.bar;
        __builtin_amdgcn_s_waitcnt(0);
        unsigned nloc = b.st[0], nx = b.st[1];
        if (nloc == 0u) { xcd_barrier_complete(bar, b.x, nloc, nx); b.st[0] = nloc; b.st[1] = nx; }
        const unsigned old = xb_add(&bar[XB_XSUB(b.x)], 1u);
        const unsigned gen = old / nloc;
        if (old + 1u == (gen + 1u) * nloc) {
            __builtin_amdgcn_fence(__ATOMIC_RELEASE, "agent");
            asm volatile("s_waitcnt vmcnt(0)" ::: "memory");
            const unsigned og = xb_add(&bar[XB_TOP], 1u);
            const unsigned tg = og / nx;
            if (og + 1u == (tg + 1u) * nx) xb_add(&bar[XB_TOPGEN], 1u);
            else XB_SPIN(xb_ld(&bar[XB_TOPGEN]) == tg, bar);
            __builtin_amdgcn_fence(__ATOMIC_ACQUIRE, "agent");
            xb_add(&bar[XB_XGEN(b.x)], 1u);
            asm volatile("s_waitcnt vmcnt(0)" ::: "memory");
        } else {
            XB_SPIN(xb_ld(&bar[XB_XGEN(b.x)]) == gen, bar);
            __builtin_amdgcn_fence(__ATOMIC_ACQUIRE, "agent");
            asm volatile("s_waitcnt vmcnt(0)" ::: "memory");
        }
    }
    __syncthreads();
}


__global__ void __launch_bounds__(NTHREADS, 2) mega_fwd(Params p) {
    extern __shared__ __attribute__((aligned(16))) unsigned char lds_raw[];
    cg::grid_group grid = cg::this_grid();
    PG8_LAS unsigned char* ldsp = (PG8_LAS unsigned char*)lds_raw;
    float* ldsf = (float*)lds_raw;
    unsigned char* ws = p.ws;
    volatile LAS unsigned* xst = (volatile LAS unsigned*)((PG8_LAS unsigned char*)lds_raw + (LDS_BYTES - 16));
    if (threadIdx.x == 0) { xst[0] = 0u; xst[1] = 0u; }
    __syncthreads();
    const XcdBarrier xbar = xcd_barrier_post((unsigned*)(ws + WS_BAR), xst);
    for (int ph = p.ph_lo; ph < p.ph_hi; ++ph) {
        if (ph == 0) { for (int rep = 0; rep < REP_EW; ++rep) { prep_phase(p, ldsf); __syncthreads(); } }
        else if (ph == 1) { for (int rep = 0; rep < REP_EW; ++rep) mod0_phase(p); }
        else {
            const int q = ph - 2, gl = q >> 3, s = q & 7;
            const int l = gl / 3, g = gl % 3;
            const u16* wb = (const u16*)(ws + WS_W + (size_t)l * W_LAYER);
            const u16* Hg = (const u16*)(ws + WS_H) + (size_t)g * TG * D;
            const int G = (int)gridDim.x;
            if (gl == 6) ln_phase(p, 1, 1, 2, 0, G);
            else if (s == 0) {
                { for (int rep = 0; rep < REP_GEMM; ++rep) { gemm_bf16out(ldsp, Hg, wb + W_IN / 2, (u16*)(ws + WS_P), TG, NINP, D); __syncthreads(); } }
                if (gl > 0) {
                    const int lead = 800 - 3 * G, wg0 = (lead > 0 && lead < G) ? lead : 0;
                    ln_phase(p, (gl - 1) / 3, 1, (gl - 1) % 3, wg0, G - wg0);
                }
            }
            else if (s == 1) { for (int rep = 0; rep < REP_SCAN; ++rep) { if (l == 0) ssd_scan_mfma(p, g, lds_raw); else gdn_scan_mfma(p, g, lds_raw); __syncthreads(); } }
            else if (s == 2) { if (l == 0) ssd_combine_phase(p); else gdn_combine_phase(p); }
            else if (s == 3) { for (int rep = 0; rep < REP_GEMM; ++rep) { gemm_f32out(ldsp, (const u16*)(ws + WS_G), wb + W_OUT / 2, (float*)(ws + WS_P), TG, D, DI); __syncthreads(); } }
            else if (s == 4) ln_phase(p, l, 0, g, 0, G);
            else if (s == 5) { for (int rep = 0; rep < REP_GEMM; ++rep) { gemm_bf16out(ldsp, Hg, wb + W_UP / 2, (u16*)(ws + WS_P), TG, FF2, D); __syncthreads(); } }
            else if (s == 6) { for (int rep = 0; rep < REP_EW; ++rep) convgate_phase(p, l, g); }
            else { for (int rep = 0; rep < REP_GEMM; ++rep) { gemm_f32out(ldsp, (const u16*)(ws + WS_G), wb + W_DN / 2, (float*)(ws + WS_YB), TG, D, FF); __syncthreads(); } }
        }
        if (ph + 1 < p.ph_hi) {
            if (p.ph_lo < 0) grid.sync();
            for (int rep = 0; rep < REP_SYNC; ++rep) xcd_barrier(xbar);
        }
    }
}

extern "C" void kernel_launch(void* const* d_in, const int* in_sizes, int n_in, void* d_out, int out_size, void* d_ws, size_t ws_size, hipStream_t stream) {
    static int grid = 0;
    if (grid == 0) {
        if (n_in != 30 || ws_size < WS_END) { fprintf(stderr, "kernel_launch: unexpected n_in %d or ws_size %zu (need %zu)\n", n_in, ws_size, (size_t)WS_END); grid = -1; return; }
        int dev = 0, cus = 0, per_cu = 0;
        hipGetDevice(&dev); hipDeviceGetAttribute(&cus, hipDeviceAttributeMultiprocessorCount, dev);
        if (hipFuncSetAttribute((const void*)mega_fwd, hipFuncAttributeMaxDynamicSharedMemorySize, LDS_BYTES) != hipSuccess) { fprintf(stderr, "kernel_launch: hipFuncSetAttribute failed\n"); grid = -1; return; }
        if (hipOccupancyMaxActiveBlocksPerMultiprocessor(&per_cu, (const void*)mega_fwd, NTHREADS, LDS_BYTES) != hipSuccess || per_cu < 1) per_cu = 1;
        (void)hipGetLastError();
        grid = cus * 1;
        if (grid <= 0) grid = 256;
    }
    if (grid < 0) return;
    Params p; memset(&p, 0, sizeof(p));
    const float** pp = (const float**)&p;
    for (int i = 0; i < 30; ++i) pp[i] = (const float*)d_in[i];
    p.out = (float*)d_out; p.ws = (unsigned char*)d_ws; p.ph_lo = 0; p.ph_hi = NPHASES;
    (void)hipMemsetAsync((char*)d_ws + WS_BAR, 0, XCD_BAR_WORDS * 4, stream);
    void* args[] = {&p};
    hipError_t e = hipLaunchCooperativeKernel((const void*)mega_fwd, dim3(grid), dim3(NTHREADS), args, LDS_BYTES, stream);
    if (e != hipSuccess) fprintf(stderr, "cooperative launch failed: %s (grid %d)\n", hipGetErrorString(e), grid);
}
```

```cpp
#include <hip/hip_runtime.h>
#include <hip/hip_cooperative_groups.h>
#include <cstdio>
#include <cstring>
namespace cg = cooperative_groups;
namespace pg8 {
#define PG8_LAS __attribute__((address_space(3)))
typedef unsigned short bf16_t;
typedef short bf16x8 __attribute__((ext_vector_type(8)));
typedef float f32x4 __attribute__((ext_vector_type(4)));
typedef unsigned u32x4 __attribute__((ext_vector_type(4)));
constexpr int BM = 256, BK = 64, HALF = 128, HTB = HALF * BK * 2  , STAGE_BYTES = 8 * HTB, NXCD = 8, WGM = 8;

__host__ __device__ __forceinline__ int lds_byte(int r, int c) { const int st = (r >> 4) * 2 + (c >> 5), rr = r & 15, cc = c & 31, ob = rr * 64 + cc * 2; return st * 1024 + (ob ^ (((ob >> 9) & 1) << 5)); }
__host__ __device__ __forceinline__ void stage_rc(int b, int& R, int& C) { const int st = b / 1024, sb = b % 1024, swz = sb ^ (((sb >> 9) & 1) << 5); R = (st >> 1) * 16 + swz / 64; C = (st & 1) * 32 + (swz % 64) / 2; }
__host__ __device__ __forceinline__ int perm32(int rho) { const int n = rho >> 4, i = rho & 15; return 8 * (i >> 2) + 4 * n + (i & 3); }

struct Unit { int pm, pn; };
struct Gemm { const bf16_t* A; const bf16_t* Bt; int M, N, K, ld, npn; };

struct StaticOrder {
    int nM, nN, nwg, G, c;
    __host__ __device__ void init(int M, int N, int G_, int c_) { nM = M / BM; nN = N / BM; nwg = nM * nN; G = G_; c = c_; }
    __host__ __device__ bool next(int i, Unit& u) const {
        const long L = (long)i * G + c; if (L >= nwg) return false;
        int wgid = (int)L; { const int q = nwg / NXCD, r = nwg % NXCD, xcd = wgid % NXCD, off = wgid / NXCD; wgid = (xcd < r ? xcd * (q + 1) : r * (q + 1) + (xcd - r) * q) + off; }
        const int nig = WGM * nN, gid = wgid / nig, fm = gid * WGM, gsz = (nM - fm) < WGM ? (nM - fm) : WGM;
        u.pm = fm + ((wgid % nig) % gsz); u.pn = (wgid % nig) / gsz; return true;
    }
    __device__ __forceinline__ void a_ready(const Unit&) const {}
    __device__ __forceinline__ void done(const Unit&) const {}
};
typedef __bf16 bf16x2_t __attribute__((ext_vector_type(2)));
typedef float f32x2_t __attribute__((ext_vector_type(2)));
__device__ __forceinline__ unsigned cvt_pk_bf16(float lo, float hi) { const f32x2_t f = {lo, hi}; const bf16x2_t v = __builtin_convertvector(f, bf16x2_t); return __builtin_bit_cast(unsigned, v); }
typedef unsigned u32x4 __attribute__((ext_vector_type(4)));
struct EpiF32 {
    static constexpr bool PERM = false, AFTER_DRAIN = false;
    float* C; int ldc; int npn; size_t split_stride;
    __device__ __forceinline__ void operator()(const f32x4 (&acc)[2][2][4][2], const Unit& u, int wr, int wc, int fr, int fq) const {
        const int row0 = u.pm * BM + wr * 64 + fr, col0 = (u.pn % npn) * BM + wc * 32 + 4 * fq;
        float* Cs = C + (size_t)(u.pn / npn) * split_stride;
#pragma unroll
        for (int ai = 0; ai < 2; ++ai)
#pragma unroll
            for (int m = 0; m < 4; ++m) { float* rowp = Cs + (size_t)(row0 + ai * HALF + m * 16) * ldc + col0;
#pragma unroll
                for (int bj = 0; bj < 2; ++bj)
#pragma unroll
                    for (int n = 0; n < 2; ++n) *(f32x4*)(rowp + bj * HALF + n * 16) = acc[ai][bj][m][n]; }
    }
};
struct EpiBf16 {
    static constexpr bool PERM = true, AFTER_DRAIN = false;
    bf16_t* O; int ldc; int npn; size_t split_stride;
    __device__ __forceinline__ void operator()(const f32x4 (&acc)[2][2][4][2], const Unit& u, int wr, int wc, int fr, int fq) const {
        const int row0 = u.pm * BM + wr * 64 + fr, col0 = (u.pn % npn) * BM + wc * 32 + 8 * fq;
        bf16_t* Os = O + (size_t)(u.pn / npn) * split_stride;
#pragma unroll
        for (int ai = 0; ai < 2; ++ai)
#pragma unroll
            for (int m = 0; m < 4; ++m) { bf16_t* rowp = Os + (size_t)(row0 + ai * HALF + m * 16) * ldc + col0;
#pragma unroll
                for (int bj = 0; bj < 2; ++bj) { const f32x4 v0 = acc[ai][bj][m][0], v1 = acc[ai][bj][m][1];
                    u32x4 w; w.x = cvt_pk_bf16(v0[0], v0[1]); w.y = cvt_pk_bf16(v0[2], v0[3]); w.z = cvt_pk_bf16(v1[0], v1[1]); w.w = cvt_pk_bf16(v1[2], v1[3]);
                    *(u32x4*)(rowp + bj * HALF) = w; } }
    }
};
template <class Epi, class Sched, bool STAMP = false>
__device__ __forceinline__ void gemm_phase(PG8_LAS unsigned char* lds, const Gemm g, const Sched& S, const Epi& E, unsigned long long* stamps) {
    int tid_ = threadIdx.x; asm volatile("" : "+v"(tid_)); const int tid = tid_, wid = __builtin_amdgcn_readfirstlane(tid >> 6), lane = tid & 63, wr = wid >> 2, wc = wid & 3, fr = lane & 15, fq = lane >> 4;
    const int K = g.K, nt = K / BK;
    int ts_lo = 0, ts_hi = 0, nts = 0; const unsigned long long rt_entry = STAMP ? (unsigned long long)wall_clock64() : 0ull;
#define PG8_STAMP() do { if (STAMP && wid == 0 && nts < 64) { const unsigned long long _c = (unsigned long long)clock64(); \
        ts_lo = (lane == nts) ? (int)(unsigned)_c : ts_lo; ts_hi = (lane == nts) ? (int)(unsigned)(_c >> 32) : ts_hi; ++nts; } } while (0)
    PG8_STAMP();
    unsigned voffA[2], voffB[2];
#pragma unroll
    for (int i = 0; i < 2; ++i) { int R, C; stage_rc(tid * 16 + i * 8192, R, C); const int Rb = Epi::PERM ? ((R & ~31) + perm32(R & 31)) : R;
        voffA[i] = (unsigned)(R * g.ld + C) * 2u; voffB[i] = (unsigned)(Rb * g.ld + C) * 2u; }
    const size_t kstep = (size_t)(BK * 2);
    const size_t hstep = (size_t)HALF * g.ld * 2;
    const size_t tstep = 2 * hstep;
    const unsigned ldsw = (unsigned)wid * 1024u;
    const int aoff = lds_byte(wr * 64 + fr, fq * 8), boff = lds_byte(wc * 32 + fr, fq * 8);
#define PG8_SA(b, h) (((b) * 2 + (h)) * HTB)
#define PG8_SB(b, h) ((4 + (b) * 2 + (h)) * HTB)
#define PG8_STAGE(bufoff, gbase, voff) do { _Pragma("unroll") for (int _i = 0; _i < 2; ++_i) \
        __builtin_amdgcn_global_load_lds((const unsigned*)((const char*)(gbase) + (voff)[_i]), (PG8_LAS unsigned*)(lds + (bufoff) + ldsw + _i * 8192), 16, 0, 0); } while (0)
#define PG8_LDA(dst, b, h) do { _Pragma("unroll") for (int m = 0; m < 4; ++m) _Pragma("unroll") for (int k = 0; k < 2; ++k) dst[m][k] = *(const PG8_LAS bf16x8*)(lds + PG8_SA(b, h) + aoff + m * 2048 + k * 1024); } while (0)
#define PG8_LDB(dst, b, h) do { _Pragma("unroll") for (int n = 0; n < 2; ++n) _Pragma("unroll") for (int k = 0; k < 2; ++k) dst[n][k] = *(const PG8_LAS bf16x8*)(lds + PG8_SB(b, h) + boff + n * 2048 + k * 1024); } while (0)
#define PG8_MMA(ai, bj, At, Bt) do { __builtin_amdgcn_s_setprio(1); _Pragma("unroll") for (int m = 0; m < 4; ++m) _Pragma("unroll") for (int n = 0; n < 2; ++n) _Pragma("unroll") for (int k = 0; k < 2; ++k) \
        acc[ai][bj][m][n] = __builtin_amdgcn_mfma_f32_16x16x32_bf16(Bt[n][k], At[m][k], acc[ai][bj][m][n], 0, 0, 0); __builtin_amdgcn_s_setprio(0); } while (0)
#define PG8_WAIT_V(n) asm volatile("s_waitcnt vmcnt(" #n ")" ::: "memory")
#define PG8_WAIT_L(n) asm volatile("s_waitcnt lgkmcnt(" #n ")" ::: "memory")
#define PG8_BAR __builtin_amdgcn_s_barrier()
#define PG8_SCHED __builtin_amdgcn_sched_barrier(0)
    Unit cur, nxt; int ui = 0;
    if (!S.next(0, cur)) return;
    f32x4 acc[2][2][4][2];
#pragma unroll
    for (int a = 0; a < 2; ++a)
#pragma unroll
        for (int b = 0; b < 2; ++b)
#pragma unroll
            for (int m = 0; m < 4; ++m)
#pragma unroll
                for (int n = 0; n < 2; ++n) acc[a][b][m][n] = (f32x4){0.f, 0.f, 0.f, 0.f};
    bf16x8 At[4][2], B0[2][2], B1[2][2];
    const size_t ksb = (size_t)K * 2;
    const char* cA = (const char*)g.A + (size_t)cur.pm * tstep + (size_t)(cur.pn / g.npn) * ksb; const char* cB = (const char*)g.Bt + (size_t)(cur.pn % g.npn) * tstep + (size_t)(cur.pn / g.npn) * ksb;
    S.a_ready(cur);
    PG8_STAGE(PG8_SB(0, 0), cB, voffB); PG8_STAGE(PG8_SA(0, 0), cA, voffA); PG8_STAGE(PG8_SB(0, 1), cB + hstep, voffB); PG8_STAGE(PG8_SA(0, 1), cA + hstep, voffA);
    if (wr == 1) PG8_BAR;
    PG8_WAIT_V(4); PG8_BAR;
    PG8_STAGE(PG8_SB(1, 0), cB + kstep, voffB); PG8_STAGE(PG8_SA(1, 0), cA + kstep, voffA); PG8_STAGE(PG8_SB(1, 1), cB + hstep + kstep, voffB);
    PG8_WAIT_V(6); PG8_BAR;
    PG8_STAMP();
    for (;;) {
        const bool has_next = S.next(ui + 1, nxt);
        const char* nA = has_next ? (const char*)g.A + (size_t)nxt.pm * tstep + (size_t)(nxt.pn / g.npn) * ksb : cA; const char* nB = has_next ? (const char*)g.Bt + (size_t)(nxt.pn % g.npn) * tstep + (size_t)(nxt.pn / g.npn) * ksb : cB;
        for (int t = 0; t < nt; t += 2) {
            const bool last = (t == nt - 2);
            const char* a1 = cA + (size_t)(t + 1) * kstep;
            const char* a2 = last ? nA : cA + (size_t)(t + 2) * kstep; const char* b2 = last ? nB : cB + (size_t)(t + 2) * kstep;
            const char* a3 = a2 + kstep; const char* b3 = b2 + kstep;
            if (last && has_next) S.a_ready(nxt);
            PG8_LDB(B0, 0, 0); PG8_SCHED; PG8_LDA(At, 0, 0); PG8_STAGE(PG8_SA(1, 1), a1 + hstep, voffA);
            PG8_WAIT_L(8); PG8_BAR; PG8_WAIT_L(0); PG8_MMA(0, 0, At, B0); PG8_BAR; PG8_SCHED;
            PG8_LDB(B1, 0, 1); PG8_STAGE(PG8_SB(0, 0), b2, voffB);
            PG8_BAR; PG8_WAIT_L(0); PG8_MMA(0, 1, At, B1); PG8_BAR;
            PG8_LDA(At, 0, 1); PG8_STAGE(PG8_SA(0, 0), a2, voffA);
            PG8_BAR; PG8_WAIT_L(0); PG8_MMA(1, 0, At, B0); PG8_BAR; PG8_SCHED;
            PG8_STAGE(PG8_SB(0, 1), b2 + hstep, voffB);
            PG8_WAIT_V(6); PG8_BAR; PG8_MMA(1, 1, At, B1); PG8_BAR;
            PG8_LDB(B0, 1, 0); PG8_SCHED; PG8_LDA(At, 1, 0); PG8_STAGE(PG8_SA(0, 1), a2 + hstep, voffA);
            PG8_WAIT_L(8); PG8_BAR; PG8_WAIT_L(0); PG8_MMA(0, 0, At, B0); PG8_BAR; PG8_SCHED;
            PG8_LDB(B1, 1, 1); PG8_STAGE(PG8_SB(1, 0), b3, voffB);
            PG8_BAR; PG8_WAIT_L(0); PG8_MMA(0, 1, At, B1); PG8_BAR;
            PG8_LDA(At, 1, 1); PG8_STAGE(PG8_SA(1, 0), a3, voffA);
            PG8_BAR; PG8_WAIT_L(0); PG8_MMA(1, 0, At, B0); PG8_BAR; PG8_SCHED;
            PG8_STAGE(PG8_SB(1, 1), b3 + hstep, voffB);
            PG8_WAIT_V(6); PG8_BAR; PG8_MMA(1, 1, At, B1); PG8_BAR;
        }
        PG8_STAMP();
        if constexpr (!Epi::AFTER_DRAIN) { E(acc, cur, wr, wc, fr, fq); S.done(cur); }
        PG8_STAMP();
        if (!has_next) break;
#pragma unroll
        for (int a = 0; a < 2; ++a)
#pragma unroll
            for (int b = 0; b < 2; ++b)
#pragma unroll
                for (int m = 0; m < 4; ++m)
#pragma unroll
                    for (int n = 0; n < 2; ++n) acc[a][b][m][n] = (f32x4){0.f, 0.f, 0.f, 0.f};
        cur = nxt; cA = nA; cB = nB; ++ui;
    }
    PG8_WAIT_V(0);
    if (wr == 0) PG8_BAR;
    PG8_BAR;
    if constexpr (Epi::AFTER_DRAIN) { E.fused(acc, cur, wr, wc, fr, fq, lds, wid, lane); S.done(cur); }
    PG8_STAMP();
    if (STAMP && wid == 0) { stamps[lane] = lane < nts ? (((unsigned long long)(unsigned)ts_hi << 32) | (unsigned)ts_lo) : 0ull;
        if (lane == 62) stamps[62] = rt_entry; if (lane == 63) stamps[63] = (unsigned long long)wall_clock64(); }
#undef PG8_STAMP
#undef PG8_SA
#undef PG8_SB
#undef PG8_STAGE
#undef PG8_LDA
#undef PG8_LDB
#undef PG8_MMA
#undef PG8_WAIT_V
#undef PG8_WAIT_L
#undef PG8_BAR
#undef PG8_SCHED
}
}

typedef unsigned short u16;
constexpr int D = 1024, T_ALL = 24576, TG = 8192, NGRP = 3;
constexpr int NINP = 6400, DI = 2048, FF = 2816, FF2 = 5632;
constexpr int NTHREADS = 512, LDS_BYTES = 143360;
constexpr float ALPHA = 1.4142135623730951f;
constexpr size_t WS_ADA = 0;
constexpr size_t WS_BAR = 499712;
constexpr size_t WS_W = 524288;
constexpr size_t W_IN = 0, W_OUT = W_IN + (size_t)NINP * D * 2, W_UP = W_OUT + (size_t)D * DI * 2, W_DN = W_UP + (size_t)FF2 * D * 2, W_LAYER = W_DN + (size_t)D * FF * 2;
constexpr size_t WS_H = WS_W + 2 * W_LAYER;
constexpr size_t WS_P = WS_H + (size_t)T_ALL * D * 2;
constexpr size_t WS_G = WS_P + (size_t)TG * NINP * 2;
constexpr size_t WS_YB = WS_G + (size_t)TG * FF * 2;
constexpr size_t WS_END = WS_YB + (size_t)TG * DI * 2;
constexpr size_t OUT_SSD_F = (size_t)T_ALL * D, OUT_SSD_B = OUT_SSD_F + 8388608, OUT_GDN_F = OUT_SSD_B + 8388608, OUT_GDN_B = OUT_GDN_F + 8388608;
#ifndef REP_SCAN
#define REP_SCAN 1
#endif
#ifndef REP_EW
#define REP_EW 1
#endif
#ifndef REP_SYNC
#define REP_SYNC 1
#endif
#ifndef REP_GEMM
#define REP_GEMM 1
#endif
constexpr int NPHASES = 2 + 2 * NGRP * 8 + 1;

struct Params {
    const float *x_prompt, *x_sample, *st_ssd_f, *st_ssd_b, *st_gdn_f, *st_gdn_b, *c, *c_ctx, *w_ada, *b_ada, *ln_g, *ln_b,
        *ssd_w_in, *ssd_conv_w, *ssd_conv_b, *ssd_dt_bias, *ssd_a_log, *ssd_d, *ssd_norm_w, *ssd_w_out,
        *gdn_w_in, *gdn_conv_w, *gdn_dt_bias, *gdn_a_log, *gdn_norm_w, *gdn_w_out,
        *ffn_w_up, *ffn_conv_w, *ffn_conv_b, *ffn_w_down;
    float* out; unsigned char* ws; int ph_lo, ph_hi;
};

__device__ __forceinline__ int otid() { int t = threadIdx.x; asm volatile("" : "+v"(t)); return t; }
__device__ __forceinline__ float bf2f(u16 b) { return __uint_as_float(((unsigned)b) << 16); }
__device__ __forceinline__ unsigned pk2(float lo, float hi) { return pg8::cvt_pk_bf16(lo, hi); }
__device__ __forceinline__ float siluf(float x) { return x * __builtin_amdgcn_rcpf(1.f + __expf(-x)); }
__device__ __forceinline__ float softplusf(float x) { return x > 15.f ? x : __logf(1.f + __expf(x)); }
__device__ __forceinline__ void unpack8(const uint4 v, float* f) {
    f[0] = __uint_as_float(v.x << 16); f[1] = __uint_as_float(v.x & 0xffff0000u); f[2] = __uint_as_float(v.y << 16); f[3] = __uint_as_float(v.y & 0xffff0000u);
    f[4] = __uint_as_float(v.z << 16); f[5] = __uint_as_float(v.z & 0xffff0000u); f[6] = __uint_as_float(v.w << 16); f[7] = __uint_as_float(v.w & 0xffff0000u);
}
__device__ __forceinline__ void unpack4(const uint2 v, float* f) {
    f[0] = __uint_as_float(v.x << 16); f[1] = __uint_as_float(v.x & 0xffff0000u); f[2] = __uint_as_float(v.y << 16); f[3] = __uint_as_float(v.y & 0xffff0000u);
}
__device__ __forceinline__ uint4 pack8(const float* f) { uint4 r; r.x = pk2(f[0], f[1]); r.y = pk2(f[2], f[3]); r.z = pk2(f[4], f[5]); r.w = pk2(f[6], f[7]); return r; }
typedef unsigned ntl_u32x4 __attribute__((ext_vector_type(4)));
typedef unsigned ntl_u32x2 __attribute__((ext_vector_type(2)));
typedef float ntl_f32x4 __attribute__((ext_vector_type(4)));
__device__ __forceinline__ uint4 ldnt16(const void* p) { const ntl_u32x4 v = __builtin_nontemporal_load((const ntl_u32x4*)p); return make_uint4(v.x, v.y, v.z, v.w); }
__device__ __forceinline__ uint2 ldnt8(const void* p) { const ntl_u32x2 v = __builtin_nontemporal_load((const ntl_u32x2*)p); return make_uint2(v.x, v.y); }
__device__ __forceinline__ float4 ldnt16f(const float* p) { const ntl_f32x4 v = __builtin_nontemporal_load((const ntl_f32x4*)p); return make_float4(v.x, v.y, v.z, v.w); }
__device__ __forceinline__ int cond_of(int t) { return t < 8192 ? 0 : 1 + ((t - 8192) >> 11); }
__device__ __forceinline__ const float* xin_row(const Params& p, int t) { return t < 8192 ? p.x_prompt + (size_t)t * D : p.x_sample + (size_t)(t - 8192) * D; }
__device__ __forceinline__ float wave_sum(float v) {
    v += __shfl_xor(v, 1); v += __shfl_xor(v, 2); v += __shfl_xor(v, 4); v += __shfl_xor(v, 8); v += __shfl_xor(v, 16); v += __shfl_xor(v, 32); return v;
}


#define DPP_STEP(v, ctrl, rmask, bctl) (v) += __int_as_float(__builtin_amdgcn_update_dpp(0, __float_as_int(v), (ctrl), (rmask), 0xF, (bctl)))
__device__ __forceinline__ float wave_prefix_sum(float v) {
    DPP_STEP(v, 0x111, 0xF, true); DPP_STEP(v, 0x112, 0xF, true); DPP_STEP(v, 0x114, 0xF, true); DPP_STEP(v, 0x118, 0xF, true);
    DPP_STEP(v, 0x142, 0xA, false);
    DPP_STEP(v, 0x143, 0xC, false);
    return v;
}
__device__ __forceinline__ float wave_last(float v) { return __int_as_float(__builtin_amdgcn_readlane(__float_as_int(v), 63)); }
__device__ __forceinline__ void wprep(const float* __restrict__ src, u16* __restrict__ dst, int K, int N, int Npad, float* tile) {
    const int tid = otid(); const int nkt = K >> 6, nnt = Npad >> 6;
    for (int t = blockIdx.x; t < nkt * nnt; t += gridDim.x) {
        const int kt = t % nkt, nt = t / nkt; const int k0 = kt * 64, n0 = nt * 64;
#pragma unroll
        for (int e = 0; e < 8; ++e) { const int idx = e * 512 + tid; const int kk = idx >> 6, nn = idx & 63; float v = 0.f;
            if (n0 + nn < N) v = src[(size_t)(k0 + kk) * N + n0 + nn];
            tile[kk * 65 + nn] = v; }
        __syncthreads();
#pragma unroll
        for (int e = 0; e < 4; ++e) { const int idx = e * 512 + tid; const int nn = idx >> 5, kp = idx & 31;
            const unsigned w = pk2(tile[(2 * kp) * 65 + nn], tile[(2 * kp + 1) * 65 + nn]);
            *(unsigned*)(dst + (size_t)(n0 + nn) * K + k0 + 2 * kp) = w; }
        __syncthreads();
    }
}
__device__ __forceinline__ void adaln_phase(const Params& p, float* lds) {
    float* s = lds; float* red = lds + 9 * 1024;
    const int tid = otid(), wave = tid >> 6, lane = tid & 63;
    if ((int)blockIdx.x >= 192) return;
    for (int i = tid; i < 9 * 1024; i += NTHREADS) { const int c = i >> 10, k = i & 1023; const float v = c == 0 ? p.c_ctx[k] : p.c[(c - 1) * 1024 + k]; s[i] = siluf(v); }
    __syncthreads();
    float* ada = (float*)(p.ws + WS_ADA);
    for (int ch = blockIdx.x; ch < 192; ch += gridDim.x) {
        const int l = ch / 96, col0 = (ch % 96) * 64;
        const float* w = p.w_ada + (size_t)l * 1024 * 6144 + col0 + lane;
        float acc[9];
#pragma unroll
        for (int c = 0; c < 9; ++c) acc[c] = 0.f;
#pragma unroll 8
        for (int k = wave * 128; k < wave * 128 + 128; ++k) { const float wv = w[(size_t)k * 6144];
#pragma unroll
            for (int c = 0; c < 9; ++c) acc[c] += s[c * 1024 + k] * wv; }
#pragma unroll
        for (int c = 0; c < 9; ++c) red[(wave * 9 + c) * 64 + lane] = acc[c];
        __syncthreads();
        for (int i = tid; i < 576; i += NTHREADS) { const int c = i >> 6, col = i & 63; float v = p.b_ada[l * 6144 + col0 + col];
#pragma unroll
            for (int w8 = 0; w8 < 8; ++w8) v += red[(w8 * 9 + c) * 64 + col];
            ada[(size_t)(l * 9 + c) * 6144 + col0 + col] = v; }
        __syncthreads();
    }
}
__device__ __forceinline__ void prep_phase(const Params& p, float* lds) {
    adaln_phase(p, lds);
    __syncthreads();
    for (int l = 0; l < 2; ++l) {
        u16* wb = (u16*)(p.ws + WS_W + (size_t)l * W_LAYER);
        wprep(l == 0 ? p.ssd_w_in : p.gdn_w_in, wb + W_IN / 2, 1024, 6208, NINP, lds);
        wprep(l == 0 ? p.ssd_w_out : p.gdn_w_out, wb + W_OUT / 2, 2048, 1024, 1024, lds);
        wprep(p.ffn_w_up + (size_t)l * 1024 * FF2, wb + W_UP / 2, 1024, FF2, FF2, lds);
        wprep(p.ffn_w_down + (size_t)l * FF * 1024, wb + W_DN / 2, FF, 1024, 1024, lds);
    }
}
__device__ __forceinline__ void mod0_phase(const Params& p) {
    const float* ada = (const float*)(p.ws + WS_ADA); u16* H = (u16*)(p.ws + WS_H);
    for (size_t i = (size_t)blockIdx.x * NTHREADS + otid(); i < (size_t)T_ALL * 256; i += (size_t)gridDim.x * NTHREADS) {
        const int t = (int)(i >> 8), c = (int)(i & 255) * 4;
        const float4 x = *(const float4*)(xin_row(p, t) + c);
        const float* a = ada + (size_t)cond_of(t) * 6144;
        const float4 sh = *(const float4*)(a + c), sc = *(const float4*)(a + 1024 + c);
        uint2 w; w.x = pk2(x.x * (1.f + sc.x) + sh.x, x.y * (1.f + sc.y) + sh.y); w.y = pk2(x.z * (1.f + sc.z) + sh.z, x.w * (1.f + sc.w) + sh.w);
        *(uint2*)(H + (size_t)t * D + c) = w;
    }
}
__device__ __forceinline__ void conv8(const u16* r1, int rs, bool hm, bool hp, const float* w, int wstride, float* o) {
    const uint4 z = {0u, 0u, 0u, 0u};
    const uint4 v0 = hm ? *(const uint4*)(r1 - rs) : z, v1 = *(const uint4*)r1, v2 = hp ? *(const uint4*)(r1 + rs) : z;
    float a0[8], a1[8], a2[8]; unpack8(v0, a0); unpack8(v1, a1); unpack8(v2, a2);
    float w0[8], w1[8], w2[8];
    *(float4*)w0 = *(const float4*)w; *(float4*)(w0 + 4) = *(const float4*)(w + 4);
    *(float4*)w1 = *(const float4*)(w + wstride); *(float4*)(w1 + 4) = *(const float4*)(w + wstride + 4);
    *(float4*)w2 = *(const float4*)(w + 2 * wstride); *(float4*)(w2 + 4) = *(const float4*)(w + 2 * wstride + 4);
#pragma unroll
    for (int j = 0; j < 8; ++j) o[j] = w0[j] * a0[j] + w1[j] * a1[j] + w2[j] * a2[j];
}
__device__ __forceinline__ void conv4(const u16* r1, int rs, bool hm, bool hp, const float* w, int wstride, float* o) {
    const uint2 z = {0u, 0u};
    const uint2 v0 = hm ? *(const uint2*)(r1 - rs) : z, v1 = *(const uint2*)r1, v2 = hp ? *(const uint2*)(r1 + rs) : z;
    float a0[4], a1[4], a2[4]; unpack4(v0, a0); unpack4(v1, a1); unpack4(v2, a2);
    const float4 w0 = *(const float4*)w, w1 = *(const float4*)(w + wstride), w2 = *(const float4*)(w + 2 * wstride);
    o[0] = w0.x * a0[0] + w1.x * a1[0] + w2.x * a2[0]; o[1] = w0.y * a0[1] + w1.y * a1[1] + w2.y * a2[1];
    o[2] = w0.z * a0[2] + w1.z * a1[2] + w2.z * a2[2]; o[3] = w0.w * a0[3] + w1.w * a1[3] + w2.w * a2[3];
}
__device__ __forceinline__ void ssd_scan_phase(const Params& p, int g, float* lds) {
    const int tid = otid(), wave = tid >> 6, lane = tid & 63;
    const int L = g == 0 ? 256 : 2048, nseq = g == 0 ? 32 : 4, nitems = nseq * 64;
    float* Bs = lds; float* Cs = lds + 4096; float* xs = lds + 8192; float* ybuf = lds + 10240; float* dts = lds + 12288; float* dAs = lds + 12320;
    const u16* P = (const u16*)(p.ws + WS_P);
    const int tok = tid >> 4, cgi = tid & 15;
    const int pl = lane >> 3, ng = lane & 7, pp = wave * 8 + pl;
    for (int item = blockIdx.x; item < nitems; item += gridDim.x) {
        const int d = item & 1, h = (item >> 1) & 31, seq = item >> 6, grp = h >> 2;
        const int row0 = seq * L;
        const float a_neg = -__expf(p.ssd_a_log[d * 32 + h]), dtb = p.ssd_dt_bias[d * 32 + h], dskip = d == 0 ? p.ssd_d[h] : 0.f;
        float S[16];
        if (g == 0) {
#pragma unroll
            for (int i = 0; i < 16; ++i) S[i] = 0.f;
        } else {
            const float* s0 = (d ? p.st_ssd_b : p.st_ssd_f) + ((size_t)(((g - 1) * 4 + seq) * 32 + h) * 64 + pp) * 128;
#pragma unroll
            for (int i = 0; i < 4; ++i) { const float4 v = *(const float4*)(s0 + 32 * i + 4 * ng); S[4 * i] = v.x; S[4 * i + 1] = v.y; S[4 * i + 2] = v.z; S[4 * i + 3] = v.w; }
        }
        const int chx = h * 64 + cgi * 4, chb = 2048 + grp * 128 + cgi * 8, chc = 3072 + grp * 128 + cgi * 8;
        u16* ydst = (u16*)(p.ws + (d ? WS_YB : WS_G));
        for (int tile = 0; tile < L / 32; ++tile) {
            const int sidx = tile * 32 + tok; const int tp = d ? L - 1 - sidx : sidx;
            {
                const u16* r1 = P + (size_t)(row0 + tp) * NINP + 2048;
                const bool hm = tp > 0, hp = tp < L - 1;
                float o4[4]; conv4(r1 + chx, NINP, hm, hp, p.ssd_conv_w + chx, 4096, o4);
                const float4 bx = *(const float4*)(p.ssd_conv_b + chx);
                float4 xo; xo.x = siluf(o4[0] + bx.x); xo.y = siluf(o4[1] + bx.y); xo.z = siluf(o4[2] + bx.z); xo.w = siluf(o4[3] + bx.w);
                *(float4*)(xs + tok * 64 + cgi * 4) = xo;
                float o8[8], bb[8];
                conv8(r1 + chb, NINP, hm, hp, p.ssd_conv_w + chb, 4096, o8);
                *(float4*)bb = *(const float4*)(p.ssd_conv_b + chb); *(float4*)(bb + 4) = *(const float4*)(p.ssd_conv_b + chb + 4);
#pragma unroll
                for (int j = 0; j < 8; ++j) o8[j] = siluf(o8[j] + bb[j]);
                *(float4*)(Bs + tok * 128 + cgi * 8) = *(float4*)o8; *(float4*)(Bs + tok * 128 + cgi * 8 + 4) = *(float4*)(o8 + 4);
                conv8(r1 + chc, NINP, hm, hp, p.ssd_conv_w + chc, 4096, o8);
                *(float4*)bb = *(const float4*)(p.ssd_conv_b + chc); *(float4*)(bb + 4) = *(const float4*)(p.ssd_conv_b + chc + 4);
#pragma unroll
                for (int j = 0; j < 8; ++j) o8[j] = siluf(o8[j] + bb[j]);
                *(float4*)(Cs + tok * 128 + cgi * 8) = *(float4*)o8; *(float4*)(Cs + tok * 128 + cgi * 8 + 4) = *(float4*)(o8 + 4);
                if (cgi == 0) { const float raw = bf2f(P[(size_t)(row0 + tp) * NINP + 6144 + d * 32 + h]); const float dt = softplusf(raw + dtb); dts[tok] = dt; dAs[tok] = __expf(dt * a_neg); }
            }
            __syncthreads();
            for (int tt = 0; tt < 32; ++tt) {
                const float dA = dAs[tt], x = xs[tt * 64 + pp]; const float xdt = x * dts[tt];
                float acc = 0.f;
#pragma unroll
                for (int i = 0; i < 4; ++i) {
                    const float4 b = *(const float4*)(Bs + tt * 128 + 32 * i + 4 * ng), c = *(const float4*)(Cs + tt * 128 + 32 * i + 4 * ng);
                    S[4 * i] = S[4 * i] * dA + xdt * b.x; S[4 * i + 1] = S[4 * i + 1] * dA + xdt * b.y; S[4 * i + 2] = S[4 * i + 2] * dA + xdt * b.z; S[4 * i + 3] = S[4 * i + 3] * dA + xdt * b.w;
                    acc += S[4 * i] * c.x + S[4 * i + 1] * c.y + S[4 * i + 2] * c.z + S[4 * i + 3] * c.w;
                }
                acc += __shfl_xor(acc, 1); acc += __shfl_xor(acc, 2); acc += __shfl_xor(acc, 4);
                if (ng == 0) ybuf[tt * 64 + pp] = acc + dskip * x;
            }
            __syncthreads();
            {   const float4 y = *(const float4*)(ybuf + tok * 64 + cgi * 4); uint2 w; w.x = pk2(y.x, y.y); w.y = pk2(y.z, y.w);
                *(uint2*)(ydst + (size_t)(row0 + tp) * DI + h * 64 + cgi * 4) = w; }
        }
        if (g == 0) {
            float* so = p.out + (d ? OUT_SSD_B : OUT_SSD_F) + ((size_t)(seq * 32 + h) * 64 + pp) * 128;
#pragma unroll
            for (int i = 0; i < 4; ++i) { float4 v; v.x = S[4 * i]; v.y = S[4 * i + 1]; v.z = S[4 * i + 2]; v.w = S[4 * i + 3]; *(float4*)(so + 32 * i + 4 * ng) = v; }
        }
        __syncthreads();
    }
}

typedef pg8::bf16x8 bfx8; typedef pg8::f32x4 fx4;
__device__ __forceinline__ fx4 mma16(bfx8 a, bfx8 b, fx4 c) { return __builtin_amdgcn_mfma_f32_16x16x32_bf16(a, b, c, 0, 0, 0); }
__device__ __forceinline__ uint2 pack4v(fx4 v) { uint2 r; r.x = pk2(v[0], v[1]); r.y = pk2(v[2], v[3]); return r; }
__device__ __forceinline__ void ssd_scan_mfma(const Params& p, int g, unsigned char* lds) {
    const int tid = otid(), wave = tid >> 6, lane = tid & 63, fr = lane & 15, fq = lane >> 4;
    const int L = g == 0 ? 256 : 2048, nseq = g == 0 ? 32 : 4, nitems = nseq * 64, nchunk = L / 64;
    u16* Cs = (u16*)lds; u16* Bs = Cs + 64 * 144; u16* BT = Bs + 64 * 144; u16* XT = BT + 128 * 80; u16* XwT = XT + 64 * 80; u16* Ms = XwT + 64 * 80; u16* Sb = Ms + 64 * 80;
    float* cum = (float*)(Sb + 64 * 144); float* dtv = cum + 64; float* wgt = cum + 128; float* ecum = cum + 192; float* misc = cum + 256;
    const u16* P = (const u16*)(p.ws + WS_P);
    for (int item0 = ((gridDim.x & 7) == 0 ? (int)((blockIdx.x & 7) * (gridDim.x >> 3) + (blockIdx.x >> 3)) : (int)blockIdx.x); item0 < nitems; item0 += gridDim.x) {
        const int item = item0;
        const int d = item & 1, h = (item >> 1) & 31, seq = item >> 6, grp = h >> 2;
        const int row0 = seq * L;
        const float a_neg = -__expf(p.ssd_a_log[d * 32 + h]), dtb = p.ssd_dt_bias[d * 32 + h], dskip = p.ssd_d[h];
        fx4 st[4];
        const int n0 = wave * 16 + 4 * fq;
#pragma unroll
        for (int pt = 0; pt < 4; ++pt) {
            if (g == 0) st[pt] = (fx4){0.f, 0.f, 0.f, 0.f};
            else st[pt] = *(const fx4*)((d ? p.st_ssd_b : p.st_ssd_f) + ((size_t)(((g - 1) * 4 + seq) * 32 + h) * 64 + pt * 16 + fr) * 128 + n0);
            *(uint2*)(Sb + (pt * 16 + fr) * 144 + n0) = pack4v(st[pt]);
        }
        const int oc = tid & 31, tq = tid >> 5; const int cha = (oc < 16 ? 2048 + grp * 128 + oc * 8 : 3072 + grp * 128 + (oc - 16) * 8);
        float wa0[8], wa1[8], wa2[8], ba[8];
        *(float4*)wa0 = *(const float4*)(p.ssd_conv_w + cha); *(float4*)(wa0 + 4) = *(const float4*)(p.ssd_conv_w + cha + 4);
        *(float4*)wa1 = *(const float4*)(p.ssd_conv_w + 4096 + cha); *(float4*)(wa1 + 4) = *(const float4*)(p.ssd_conv_w + 4096 + cha + 4);
        *(float4*)wa2 = *(const float4*)(p.ssd_conv_w + 8192 + cha); *(float4*)(wa2 + 4) = *(const float4*)(p.ssd_conv_w + 8192 + cha + 4);
        *(float4*)ba = *(const float4*)(p.ssd_conv_b + cha); *(float4*)(ba + 4) = *(const float4*)(p.ssd_conv_b + cha + 4);
        const int cx = h * 64 + (tid & 63);
        const float wx0 = p.ssd_conv_w[cx], wx1 = p.ssd_conv_w[4096 + cx], wx2 = p.ssd_conv_w[8192 + cx], bx = p.ssd_conv_b[cx];
        u16* ydst = (u16*)(p.ws + (d ? WS_YB : WS_G));
        uint4 pa[6]; unsigned px[10]; unsigned pdt = 0;
#define SSD_PREFETCH(T0) do { const int _t0 = (T0); \
            _Pragma("unroll") for (int k = 0; k < 6; ++k) { const int tp = _t0 + tq * 4 - 1 + k; \
                pa[k] = (tp >= 0 && tp < L) ? *(const uint4*)(P + (size_t)(row0 + tp) * NINP + 2048 + cha) : make_uint4(0u, 0u, 0u, 0u); } \
            _Pragma("unroll") for (int k = 0; k < 10; ++k) { const int tp = _t0 + (tid >> 6) * 8 - 1 + k; \
                px[k] = (tp >= 0 && tp < L) ? (unsigned)P[(size_t)(row0 + tp) * NINP + 2048 + cx] : 0u; } \
            if (wave == 0) pdt = (unsigned)P[(size_t)(row0 + _t0 + lane) * NINP + 6144 + d * 32 + h]; } while (0)
        SSD_PREFETCH((d ? nchunk - 1 : 0) * 64);
        for (int ci = 0; ci < nchunk; ++ci) {
            const int t0 = (d ? nchunk - 1 - ci : ci) * 64;
            if (wave == 0) {
                const float raw = bf2f((u16)pdt);
                const float dt = softplusf(raw + dtb), la = dt * a_neg;
                const float c = wave_prefix_sum(la);
                const float tot = wave_last(c);
                const float cm = d ? (tot - c + la) : c;
                cum[lane] = cm; dtv[lane] = dt; ecum[lane] = __expf(cm); wgt[lane] = dt * __expf(tot - cm);
                if (lane == 0) misc[0] = __expf(tot);
            }
            __syncthreads();
            {
                float rw[6][8];
#pragma unroll
                for (int k = 0; k < 6; ++k) unpack8(pa[k], rw[k]);
#pragma unroll
                for (int m = 0; m < 4; ++m) { float o[8];
#pragma unroll
                    for (int k = 0; k < 8; ++k) o[k] = siluf(wa0[k] * rw[m][k] + wa1[k] * rw[m + 1][k] + wa2[k] * rw[m + 2][k] + ba[k]);
                    *(uint4*)((oc < 16 ? Bs : Cs) + (tq * 4 + m) * 144 + (oc & 15) * 8) = pack8(o); }
            }
            {
                const int c = tid & 63, j0 = (tid >> 6) * 8;
                float o[8], ow[8];
#pragma unroll
                for (int k = 0; k < 8; ++k) { o[k] = siluf(wx0 * bf2f((u16)px[k]) + wx1 * bf2f((u16)px[k + 1]) + wx2 * bf2f((u16)px[k + 2]) + bx); ow[k] = o[k] * wgt[j0 + k]; }
                *(uint4*)(XT + c * 80 + j0) = pack8(o); *(uint4*)(XwT + c * 80 + j0) = pack8(ow);
            }
            __syncthreads();
            if (ci + 1 < nchunk) SSD_PREFETCH((d ? nchunk - 2 - ci : ci + 1) * 64);
#pragma unroll
            for (int it = 0; it < 2; ++it) {
                const int n = tid & 127, j0 = ((tid >> 7) + 4 * it) * 8;
                uint4 w; unsigned e[8];
#pragma unroll
                for (int k = 0; k < 8; ++k) e[k] = Bs[(j0 + k) * 144 + n];
                w.x = e[0] | (e[1] << 16); w.y = e[2] | (e[3] << 16); w.z = e[4] | (e[5] << 16); w.w = e[6] | (e[7] << 16);
                *(uint4*)(BT + n * 80 + j0) = w;
            }
#pragma unroll
            for (int tt = 0; tt < 2; ++tt) {
                const int id = wave * 2 + tt, jt = id >> 2, it = id & 3;
                fx4 acc = {0.f, 0.f, 0.f, 0.f};
#pragma unroll
                for (int ks = 0; ks < 4; ++ks) acc = mma16(*(const bfx8*)(Bs + (jt * 16 + fr) * 144 + ks * 32 + fq * 8), *(const bfx8*)(Cs + (it * 16 + fr) * 144 + ks * 32 + fq * 8), acc);
                asm volatile("s_nop 15" : "+v"(acc));
                const int i = it * 16 + fr; const float cmi = cum[i];
                fx4 m;
#pragma unroll
                for (int r = 0; r < 4; ++r) { const int j = jt * 16 + 4 * fq + r; const bool valid = d ? (j >= i) : (j <= i);
                    const float e = __expf(valid ? cmi - cum[j] : 0.f) * dtv[j]; m[r] = valid ? acc[r] * e : 0.f; }
                *(uint2*)(Ms + i * 80 + jt * 16 + 4 * fq) = pack4v(m);
            }
            __syncthreads();
#pragma unroll
            for (int tt = 0; tt < 2; ++tt) {
                const int id = wave * 2 + tt, pt = id >> 2, it = id & 3;
                fx4 acc = {0.f, 0.f, 0.f, 0.f};
#pragma unroll
                for (int ks = 0; ks < 4; ++ks) acc = mma16(*(const bfx8*)(Sb + (pt * 16 + fr) * 144 + ks * 32 + fq * 8), *(const bfx8*)(Cs + (it * 16 + fr) * 144 + ks * 32 + fq * 8), acc);
                asm volatile("s_nop 15" : "+v"(acc));
                const int i = it * 16 + fr; const float e = ecum[i];
                acc *= e;
#pragma unroll
                for (int ks = 0; ks < 2; ++ks) acc = mma16(*(const bfx8*)(XT + (pt * 16 + fr) * 80 + ks * 32 + fq * 8), *(const bfx8*)(Ms + (it * 16 + fr) * 80 + ks * 32 + fq * 8), acc);
                asm volatile("s_nop 15" : "+v"(acc));
                if (d == 0) {
#pragma unroll
                    for (int r = 0; r < 4; ++r) acc[r] += dskip * bf2f(XT[(pt * 16 + 4 * fq + r) * 80 + i]);
                }
                *(uint2*)(ydst + (size_t)(row0 + t0 + i) * DI + h * 64 + pt * 16 + 4 * fq) = pack4v(acc);
            }
            {
                const float cd = misc[0];
#pragma unroll
                for (int pt = 0; pt < 4; ++pt) {
                    st[pt] *= cd;
#pragma unroll
                    for (int ks = 0; ks < 2; ++ks) st[pt] = mma16(*(const bfx8*)(BT + (wave * 16 + fr) * 80 + ks * 32 + fq * 8), *(const bfx8*)(XwT + (pt * 16 + fr) * 80 + ks * 32 + fq * 8), st[pt]);
                    asm volatile("s_nop 15" : "+v"(st[pt]));
                }
            }
            __syncthreads();
#pragma unroll
            for (int pt = 0; pt < 4; ++pt) *(uint2*)(Sb + (pt * 16 + fr) * 144 + n0) = pack4v(st[pt]);
        }
        if (g == 0) {
#pragma unroll
            for (int pt = 0; pt < 4; ++pt) *(fx4*)(p.out + (d ? OUT_SSD_B : OUT_SSD_F) + ((size_t)(seq * 32 + h) * 64 + pt * 16 + fr) * 128 + n0) = st[pt];
        }
        __syncthreads();
    }
}
__device__ __forceinline__ void ssd_combine_phase(const Params& p) {
    const int tid = otid(), wave = tid >> 6, lane = tid & 63;
    u16* YF = (u16*)(p.ws + WS_G); const u16* YB = (const u16*)(p.ws + WS_YB); const u16* P = (const u16*)(p.ws + WS_P);
    for (int row = blockIdx.x * 8 + wave; row < TG; row += gridDim.x * 8) {
        float gv[32]; float ss = 0.f;
#pragma unroll
        for (int i = 0; i < 4; ++i) { const int c = i * 512 + lane * 8;
            float a[8], b[8], z[8]; unpack8(ldnt16(YF + (size_t)row * DI + c), a); unpack8(ldnt16(YB + (size_t)row * DI + c), b); unpack8(ldnt16(P + (size_t)row * NINP + c), z);
#pragma unroll
            for (int j = 0; j < 8; ++j) { const float v = (a[j] + b[j]) * siluf(z[j]); gv[i * 8 + j] = v; ss += v * v; } }
        ss = wave_sum(ss);
        const float r = rsqrtf(ss * (1.f / 2048.f) + 1e-6f);
#pragma unroll
        for (int i = 0; i < 4; ++i) { const int c = i * 512 + lane * 8; float nw[8], o[8];
            *(float4*)nw = *(const float4*)(p.ssd_norm_w + c); *(float4*)(nw + 4) = *(const float4*)(p.ssd_norm_w + c + 4);
#pragma unroll
            for (int j = 0; j < 8; ++j) o[j] = gv[i * 8 + j] * r * nw[j];
            *(uint4*)(YF + (size_t)row * DI + c) = pack8(o); }
    }
}
__device__ __forceinline__ void gdn_scan_phase(const Params& p, int g, float* lds) {
    const int tid = otid(), wave = tid >> 6, lane = tid & 63;
    const int L = g == 0 ? 256 : 2048, nseq = g == 0 ? 32 : 4, nitems = nseq * 64;
    float* qs = lds; float* ks = lds + 4096; float* vs = lds + 8192; float* obuf = lds + 10240; float* egs = lds + 12288; float* betas = lds + 12320; float* kqs = lds + 12352;
    const u16* P = (const u16*)(p.ws + WS_P);
    const int tok = tid >> 4, cgi = tid & 15;
    const int dvl = lane >> 3, dkg = lane & 7, dv = wave * 8 + dvl;
    for (int item = blockIdx.x; item < nitems; item += gridDim.x) {
        const int e = item & 1, d = (item >> 1) & 1, hv = (item >> 2) & 15, seq = item >> 6, kh = hv >> 1;
        const int row0 = seq * L;
        const float a_neg = -__expf(p.gdn_a_log[d * 16 + hv]), dtb = p.gdn_dt_bias[d * 16 + hv];
        float S[16];
        if (g == 0) {
#pragma unroll
            for (int i = 0; i < 16; ++i) S[i] = 0.f;
        } else {
            const float* s0 = (d ? p.st_gdn_b : p.st_gdn_f) + (size_t)(((g - 1) * 4 + seq) * 16 + hv) * 16384 + e * 64 + dv;
#pragma unroll
            for (int i = 0; i < 4; ++i)
#pragma unroll
                for (int j = 0; j < 4; ++j) S[4 * i + j] = s0[(size_t)(32 * i + 4 * dkg + j) * 128];
        }
        const int chq = kh * 128 + cgi * 8, chk = 1024 + kh * 128 + cgi * 8, chv = 2048 + hv * 128 + e * 64 + cgi * 4;
        u16* odst = (u16*)(p.ws + (d ? WS_YB : WS_G));
        for (int tile = 0; tile < L / 32; ++tile) {
            const int sidx = tile * 32 + tok; const int tp = d ? L - 1 - sidx : sidx;
            {
                const u16* r1 = P + (size_t)(row0 + tp) * NINP;
                const bool hm = tp > 0, hp = tp < L - 1;
                float q8[8], k8[8], v4[4];
                conv8(r1 + chq, NINP, hm, hp, p.gdn_conv_w + chq, 4096, q8);
                conv8(r1 + chk, NINP, hm, hp, p.gdn_conv_w + chk, 4096, k8);
                conv4(r1 + chv, NINP, hm, hp, p.gdn_conv_w + chv, 4096, v4);
                float sq = 0.f, sk = 0.f;
#pragma unroll
                for (int j = 0; j < 8; ++j) { q8[j] = siluf(q8[j]); k8[j] = siluf(k8[j]); sq += q8[j] * q8[j]; sk += k8[j] * k8[j]; }
                sq += __shfl_xor(sq, 1); sq += __shfl_xor(sq, 2); sq += __shfl_xor(sq, 4); sq += __shfl_xor(sq, 8);
                sk += __shfl_xor(sk, 1); sk += __shfl_xor(sk, 2); sk += __shfl_xor(sk, 4); sk += __shfl_xor(sk, 8);
                const float rq = rsqrtf(sq + 1e-6f) * 0.08838834764831845f, rk = rsqrtf(sk + 1e-6f);
                float kq = 0.f;
#pragma unroll
                for (int j = 0; j < 8; ++j) { q8[j] *= rq; k8[j] *= rk; kq += q8[j] * k8[j]; }
                kq += __shfl_xor(kq, 1); kq += __shfl_xor(kq, 2); kq += __shfl_xor(kq, 4); kq += __shfl_xor(kq, 8);
                *(float4*)(qs + tok * 128 + cgi * 8) = *(float4*)q8; *(float4*)(qs + tok * 128 + cgi * 8 + 4) = *(float4*)(q8 + 4);
                *(float4*)(ks + tok * 128 + cgi * 8) = *(float4*)k8; *(float4*)(ks + tok * 128 + cgi * 8 + 4) = *(float4*)(k8 + 4);
                float4 vo; vo.x = siluf(v4[0]); vo.y = siluf(v4[1]); vo.z = siluf(v4[2]); vo.w = siluf(v4[3]);
                *(float4*)(vs + tok * 64 + cgi * 4) = vo;
                if (cgi == 0) {
                    const float a_raw = bf2f(r1[6144 + d * 16 + hv]), b_raw = bf2f(r1[6176 + d * 16 + hv]);
                    egs[tok] = __expf(a_neg * softplusf(a_raw + dtb)); betas[tok] = 1.f / (1.f + __expf(-b_raw)); kqs[tok] = kq;
                }
            }
            __syncthreads();
            for (int tt = 0; tt < 32; ++tt) {
                const float eg = egs[tt], be = betas[tt], kq = kqs[tt], v = vs[tt * 64 + dv];
                float kk[16]; float u = 0.f, w = 0.f;
#pragma unroll
                for (int i = 0; i < 4; ++i) {
                    const float4 k4 = *(const float4*)(ks + tt * 128 + 32 * i + 4 * dkg), q4 = *(const float4*)(qs + tt * 128 + 32 * i + 4 * dkg);
                    kk[4 * i] = k4.x; kk[4 * i + 1] = k4.y; kk[4 * i + 2] = k4.z; kk[4 * i + 3] = k4.w;
                    u += S[4 * i] * k4.x + S[4 * i + 1] * k4.y + S[4 * i + 2] * k4.z + S[4 * i + 3] * k4.w;
                    w += S[4 * i] * q4.x + S[4 * i + 1] * q4.y + S[4 * i + 2] * q4.z + S[4 * i + 3] * q4.w;
                }
                u += __shfl_xor(u, 1); w += __shfl_xor(w, 1); u += __shfl_xor(u, 2); w += __shfl_xor(w, 2); u += __shfl_xor(u, 4); w += __shfl_xor(w, 4);
                const float delta = be * (v - eg * u);
#pragma unroll
                for (int i = 0; i < 16; ++i) S[i] = S[i] * eg + kk[i] * delta;
                if (dkg == 0) obuf[tt * 64 + dv] = eg * w + delta * kq;
            }
            __syncthreads();
            {   const float4 y = *(const float4*)(obuf + tok * 64 + cgi * 4); uint2 w; w.x = pk2(y.x, y.y); w.y = pk2(y.z, y.w);
                *(uint2*)(odst + (size_t)(row0 + tp) * DI + hv * 128 + e * 64 + cgi * 4) = w; }
        }
        if (g == 0) {
            float* so = p.out + (d ? OUT_GDN_B : OUT_GDN_F) + (size_t)(seq * 16 + hv) * 16384 + e * 64 + dv;
#pragma unroll
            for (int i = 0; i < 4; ++i)
#pragma unroll
                for (int j = 0; j < 4; ++j) so[(size_t)(32 * i + 4 * dkg + j) * 128] = S[4 * i + j];
        }
        __syncthreads();
    }
}

__device__ __forceinline__ void gdn_scan_mfma(const Params& p, int g, unsigned char* lds) {
    const int tid = otid(), wave = tid >> 6, lane = tid & 63, fr = lane & 15, fq = lane >> 4;
    const int L = g == 0 ? 256 : 2048, nseq = g == 0 ? 32 : 4, nitems = nseq * 64, nchunk = L / 64;
    float* R32 = (float*)lds; float* Adg = R32 + 64 * 64; u16* VnT = (u16*)(Adg + 64 * 20); u16* QKm = VnT + 64 * 80; u16* Abf = QKm + 64 * 80; u16* TB = Abf + 64 * 80; u16* RT = TB + 64 * 40;
    float* const fset = (float*)(RT + 64 * 40);
    u16* Kn = (u16*)(fset + 640); u16* Qn = Kn + 64 * 144; u16* KdT = Qn + 64 * 144; u16* ST = KdT + 128 * 80;
    const u16* P = (const u16*)(p.ws + WS_P);
    const int tok = tid >> 4, cgi = tid & 15;
    for (int item0 = ((gridDim.x & 7) == 0 ? (int)((blockIdx.x & 7) * (gridDim.x >> 3) + (blockIdx.x >> 3)) : (int)blockIdx.x); item0 < nitems; item0 += gridDim.x) {
        const int item = item0;
        const int e = item & 1, d = (item >> 1) & 1, hv = (item >> 2) & 15, seq = item >> 6, kh = hv >> 1;
        const int row0 = seq * L;
        const float a_neg = -__expf(p.gdn_a_log[d * 16 + hv]), dtb = p.gdn_dt_bias[d * 16 + hv];
        fx4 st[4];
        const int dk0 = wave * 16 + 4 * fq;
#pragma unroll
        for (int pt = 0; pt < 4; ++pt) {
            if (g == 0) st[pt] = (fx4){0.f, 0.f, 0.f, 0.f};
            else { const float* s0 = (d ? p.st_gdn_b : p.st_gdn_f) + (size_t)(((g - 1) * 4 + seq) * 16 + hv) * 16384 + e * 64 + pt * 16 + fr;
#pragma unroll
                for (int r = 0; r < 4; ++r) st[pt][r] = s0[(size_t)(dk0 + r) * 128]; }
            *(uint2*)(ST + (pt * 16 + fr) * 144 + dk0) = pack4v(st[pt]);
        }
        for (int z = tid; z < 640; z += NTHREADS) ((uint4*)TB)[z] = make_uint4(0u, 0u, 0u, 0u);
        u16* odst = (u16*)(p.ws + (d ? WS_YB : WS_G));
        uint4 pq[4], pk[4]; uint2 pv[4]; unsigned pa_raw = 0, pb_raw = 0;
#define GDN_PREFETCH(T0) do { const int _t0 = (T0); const int _tok = tid >> 4, _cg = tid & 15; \
            const int _tpl = d ? _t0 + 62 - 2 * _tok : _t0 + 2 * _tok; \
            _Pragma("unroll") for (int k = 0; k < 4; ++k) { const int tp = _tpl - 1 + k; const bool ok = tp >= 0 && tp < L; const u16* r1 = P + (size_t)(row0 + tp) * NINP; \
                pq[k] = ok ? *(const uint4*)(r1 + kh * 128 + _cg * 8) : make_uint4(0u, 0u, 0u, 0u); \
                pk[k] = ok ? *(const uint4*)(r1 + 1024 + kh * 128 + _cg * 8) : make_uint4(0u, 0u, 0u, 0u); \
                pv[k] = ok ? *(const uint2*)(r1 + 2048 + hv * 128 + e * 64 + _cg * 4) : make_uint2(0u, 0u); } \
            if ((tid >> 6) == 7) { const int tp = d ? _t0 + 63 - (tid & 63) : _t0 + (tid & 63); const u16* r1 = P + (size_t)(row0 + tp) * NINP; \
                pa_raw = (unsigned)r1[6144 + d * 16 + hv]; pb_raw = (unsigned)r1[6176 + d * 16 + hv]; } } while (0)
        GDN_PREFETCH((d ? nchunk - 1 : 0) * 64);
#define GDN_S0(SET) do { if ((tid >> 6) == 7) { float* _f = fset + (SET) * 320; const int _ln = tid & 63; \
            const float a_raw = bf2f((u16)pa_raw), b_raw = bf2f((u16)pb_raw); \
            const float c = wave_prefix_sum(a_neg * softplusf(a_raw + dtb)); \
            const float tot = wave_last(c); \
            _f[_ln] = c; _f[64 + _ln] = __expf(c); _f[128 + _ln] = __builtin_amdgcn_rcpf(1.f + __expf(-b_raw)); _f[192 + _ln] = __expf(tot - c); \
            if (_ln == 0) _f[256] = __expf(tot); } } while (0)
        GDN_S0(0);
        __syncthreads();
        float wq[3][8], wk[3][8], wv[3][4];
        { const int _cg = tid & 15; const int chq = kh * 128 + _cg * 8, chk = 1024 + kh * 128 + _cg * 8, chv = 2048 + hv * 128 + e * 64 + _cg * 4;
#pragma unroll
          for (int t = 0; t < 3; ++t) {
            *(float4*)wq[t] = *(const float4*)(p.gdn_conv_w + t * 4096 + chq); *(float4*)(wq[t] + 4) = *(const float4*)(p.gdn_conv_w + t * 4096 + chq + 4);
            *(float4*)wk[t] = *(const float4*)(p.gdn_conv_w + t * 4096 + chk); *(float4*)(wk[t] + 4) = *(const float4*)(p.gdn_conv_w + t * 4096 + chk + 4);
            *(float4*)wv[t] = *(const float4*)(p.gdn_conv_w + t * 4096 + chv); } }
        for (int ci = 0; ci < nchunk; ++ci) {
            const int t0 = (d ? nchunk - 1 - ci : ci) * 64;
            const int tid = otid(), wave = tid >> 6, lane = tid & 63, fr = lane & 15, fq = lane >> 4, tok = tid >> 4, cgi = tid & 15, dk0 = wave * 16 + 4 * fq;
            int lz = 0; asm volatile("" : "+v"(lz));
            unsigned char* lb = lds + lz;
            float* R32 = (float*)lb; float* Adg = R32 + 64 * 64; u16* VnT = (u16*)(Adg + 64 * 20); u16* QKm = VnT + 64 * 80; u16* Abf = QKm + 64 * 80; u16* TB = Abf + 64 * 80; u16* RT = TB + 64 * 40;
            float* const fset = (float*)(RT + 64 * 40);
            float* cum = fset + (ci & 1) * 320; float* ecum = cum + 64; float* beta = cum + 128; float* edec = cum + 192; float* misc = cum + 256;
            u16* Kn = (u16*)(fset + 640); u16* Qn = Kn + 64 * 144; u16* KdT = Qn + 64 * 144; u16* ST = KdT + 128 * 80;
            const int chq = kh * 128 + cgi * 8, chk = 1024 + kh * 128 + cgi * 8, chv = 2048 + hv * 128 + e * 64 + cgi * 4;
            for (int z = tid; z < 640; z += NTHREADS) ((uint4*)VnT)[z] = make_uint4(0u, 0u, 0u, 0u);
            {
                float rq[4][8], rk[4][8], rv[4][4];
#pragma unroll
                for (int k = 0; k < 4; ++k) { unpack8(pq[k], rq[k]); unpack8(pk[k], rk[k]); unpack4(pv[k], rv[k]); }
#pragma unroll
                for (int m = 0; m < 2; ++m) {
                    const int i = (m == 0) ? (d ? 2 * tok + 1 : 2 * tok) : (d ? 2 * tok : 2 * tok + 1);
                    float q8[8], k8[8], v4[4]; float sq = 0.f, sk = 0.f;
#pragma unroll
                    for (int k = 0; k < 8; ++k) { q8[k] = siluf(wq[0][k] * rq[m][k] + wq[1][k] * rq[m + 1][k] + wq[2][k] * rq[m + 2][k]); sq += q8[k] * q8[k];
                        k8[k] = siluf(wk[0][k] * rk[m][k] + wk[1][k] * rk[m + 1][k] + wk[2][k] * rk[m + 2][k]); sk += k8[k] * k8[k]; }
#pragma unroll
                    for (int k = 0; k < 4; ++k) v4[k] = siluf(wv[0][k] * rv[m][k] + wv[1][k] * rv[m + 1][k] + wv[2][k] * rv[m + 2][k]);
                    sq += __shfl_xor(sq, 1); sq += __shfl_xor(sq, 2); sq += __shfl_xor(sq, 4); sq += __shfl_xor(sq, 8);
                    sk += __shfl_xor(sk, 1); sk += __shfl_xor(sk, 2); sk += __shfl_xor(sk, 4); sk += __shfl_xor(sk, 8);
                    const float rqn = rsqrtf(sq + 1e-6f) * 0.08838834764831845f, rkn = rsqrtf(sk + 1e-6f);
#pragma unroll
                    for (int k = 0; k < 8; ++k) { q8[k] *= rqn; k8[k] *= rkn; }
                    *(uint4*)(Qn + i * 144 + cgi * 8) = pack8(q8); *(uint4*)(Kn + i * 144 + cgi * 8) = pack8(k8);
                    const float bi = beta[i];
                    float4 rvv; rvv.x = bi * v4[0]; rvv.y = bi * v4[1]; rvv.z = bi * v4[2]; rvv.w = bi * v4[3];
                    *(float4*)(R32 + i * 64 + cgi * 4) = rvv;
                }
            }
            __syncthreads();
            if (ci + 1 < nchunk) GDN_PREFETCH((d ? nchunk - 2 - ci : ci + 1) * 64);
#pragma unroll
            for (int tt = 0; tt < 2; ++tt) {
                const int id = wave * 2 + tt, jt = id >> 2, it = id & 3;
                fx4 accA = {0.f, 0.f, 0.f, 0.f}, accQ = {0.f, 0.f, 0.f, 0.f};
#pragma unroll
                for (int ks = 0; ks < 4; ++ks) { const bfx8 a = *(const bfx8*)(Kn + (jt * 16 + fr) * 144 + ks * 32 + fq * 8);
                    accA = mma16(a, *(const bfx8*)(Kn + (it * 16 + fr) * 144 + ks * 32 + fq * 8), accA);
                    accQ = mma16(a, *(const bfx8*)(Qn + (it * 16 + fr) * 144 + ks * 32 + fq * 8), accQ); }
                asm volatile("s_nop 15" : "+v"(accA), "+v"(accQ));
                const int i = it * 16 + fr; const float cmi = cum[i], bi = beta[i];
                fx4 mA, mQ;
#pragma unroll
                for (int r = 0; r < 4; ++r) { const int j = jt * 16 + 4 * fq + r;
                    const float dec = __expf(j <= i ? cmi - cum[j] : 0.f);
                    mA[r] = j < i ? bi * accA[r] * dec : 0.f; mQ[r] = j <= i ? accQ[r] * dec : 0.f; }
                *(uint2*)(Abf + i * 80 + jt * 16 + 4 * fq) = pack4v(mA);
                if (jt == it) *(fx4*)(Adg + i * 20 + 4 * fq) = mA;
                *(uint2*)(QKm + i * 80 + jt * 16 + 4 * fq) = pack4v(mQ);
            }
            __syncthreads();
            if (wave == 4) {
                const int tb = lane >> 4, tc = lane & 15;
                float t[16]; float4 nx[4];
#pragma unroll
                for (int j4 = 0; j4 < 1; ++j4) nx[j4] = *(const float4*)(Adg + (tb * 16 + 1) * 20 + j4 * 4);
#pragma unroll
                for (int i = 0; i < 16; ++i) {
                    float4 cu[4];
#pragma unroll
                    for (int j4 = 0; j4 < 4; ++j4) cu[j4] = nx[j4];
                    if (i >= 1 && i < 15) {
#pragma unroll
                        for (int j4 = 0; j4 < (i + 4) / 4; ++j4) nx[j4] = *(const float4*)(Adg + (tb * 16 + i + 1) * 20 + j4 * 4);
                    }
                    float acc = (i == tc) ? 1.f : 0.f;
#pragma unroll
                    for (int j4 = 0; j4 < (i + 3) / 4; ++j4) {
                        const float4 a = cu[j4];
                        if (j4 * 4 + 0 < i) acc -= a.x * t[j4 * 4 + 0];
                        if (j4 * 4 + 1 < i) acc -= a.y * t[j4 * 4 + 1];
                        if (j4 * 4 + 2 < i) acc -= a.z * t[j4 * 4 + 2];
                        if (j4 * 4 + 3 < i) acc -= a.w * t[j4 * 4 + 3];
                    }
                    t[i] = acc;
                    __builtin_amdgcn_sched_barrier(0);
                }
#pragma unroll
                for (int i = 0; i < 16; ++i) TB[(tb * 16 + i) * 40 + tc] = (u16)(pk2(t[i], 0.f) & 0xffffu);
            }
            fx4 oacc[2];
#pragma unroll
            for (int tt = 0; tt < 2; ++tt) {
                const int id = wave * 2 + tt, pt = id >> 2, it = id & 3;
                fx4 accK = {0.f, 0.f, 0.f, 0.f}, accQ = {0.f, 0.f, 0.f, 0.f};
#pragma unroll
                for (int ks = 0; ks < 4; ++ks) { const bfx8 a = *(const bfx8*)(ST + (pt * 16 + fr) * 144 + ks * 32 + fq * 8);
                    accK = mma16(a, *(const bfx8*)(Kn + (it * 16 + fr) * 144 + ks * 32 + fq * 8), accK);
                    accQ = mma16(a, *(const bfx8*)(Qn + (it * 16 + fr) * 144 + ks * 32 + fq * 8), accQ); }
                asm volatile("s_nop 15" : "+v"(accK), "+v"(accQ));
                const int i = it * 16 + fr; const float ei = ecum[i], bei = beta[i] * ei;
                fx4 rr = *(const fx4*)(R32 + i * 64 + pt * 16 + 4 * fq);
                rr -= accK * bei;
                *(fx4*)(R32 + i * 64 + pt * 16 + 4 * fq) = rr;
                oacc[tt] = accQ * ei;
            }
            __syncthreads();
            if (wave >= 4) {
                const int t4 = tid - 256;
#pragma unroll
                for (int it2 = 0; it2 < 4; ++it2) {
                    const int dk = t4 & 127, j0 = ((t4 >> 7) + 2 * it2) * 8;
                    float o[8];
#pragma unroll
                    for (int k = 0; k < 8; ++k) o[k] = bf2f(Kn[(j0 + k) * 144 + dk]) * edec[j0 + k];
                    *(uint4*)(KdT + dk * 80 + j0) = pack8(o);
                }
                if (ci + 1 < nchunk) GDN_S0((ci + 1) & 1);
            }
            if (wave < 4) {
#pragma unroll
                for (int b = 0; b < 4; ++b) {
                    fx4 u = {0.f, 0.f, 0.f, 0.f};
                    if (b > 0) {
#pragma unroll
                        for (int ks = 0; ks < 2; ++ks) u = mma16(*(const bfx8*)(VnT + (wave * 16 + fr) * 80 + ks * 32 + fq * 8), *(const bfx8*)(Abf + (b * 16 + fr) * 80 + ks * 32 + fq * 8), u);
                        asm volatile("s_nop 15" : "+v"(u));
                    }
                    fx4 rr = *(const fx4*)(R32 + (b * 16 + fr) * 64 + wave * 16 + 4 * fq);
                    rr -= u;
#pragma unroll
                    for (int r = 0; r < 4; ++r) RT[(wave * 16 + 4 * fq + r) * 40 + fr] = (u16)(pk2(rr[r], 0.f) & 0xffffu);
                    asm volatile("s_waitcnt lgkmcnt(0)" ::: "memory");
                    fx4 xb = {0.f, 0.f, 0.f, 0.f};
                    xb = mma16(*(const bfx8*)(RT + (wave * 16 + fr) * 40 + fq * 8), *(const bfx8*)(TB + (b * 16 + fr) * 40 + fq * 8), xb);
                    asm volatile("s_nop 15" : "+v"(xb));
#pragma unroll
                    for (int r = 0; r < 4; ++r) VnT[(wave * 16 + 4 * fq + r) * 80 + b * 16 + fr] = (u16)(pk2(xb[r], 0.f) & 0xffffu);
                    asm volatile("s_waitcnt lgkmcnt(0)" ::: "memory");
                }
            }
            __syncthreads();
#pragma unroll
            for (int tt = 0; tt < 2; ++tt) {
                const int id = wave * 2 + tt, pt = id >> 2, it = id & 3;
#pragma unroll
                for (int ks = 0; ks < 2; ++ks) oacc[tt] = mma16(*(const bfx8*)(VnT + (pt * 16 + fr) * 80 + ks * 32 + fq * 8), *(const bfx8*)(QKm + (it * 16 + fr) * 80 + ks * 32 + fq * 8), oacc[tt]);
                asm volatile("s_nop 15" : "+v"(oacc[tt]));
                const int i = it * 16 + fr, tp = d ? t0 + 63 - i : t0 + i;
                *(uint2*)(odst + (size_t)(row0 + tp) * DI + hv * 128 + e * 64 + pt * 16 + 4 * fq) = pack4v(oacc[tt]);
            }
            __syncthreads();
            {
                const float cd = misc[0];
#pragma unroll
                for (int pt = 0; pt < 4; ++pt) {
                    st[pt] *= cd;
#pragma unroll
                    for (int ks = 0; ks < 2; ++ks) st[pt] = mma16(*(const bfx8*)(KdT + (wave * 16 + fr) * 80 + ks * 32 + fq * 8), *(const bfx8*)(VnT + (pt * 16 + fr) * 80 + ks * 32 + fq * 8), st[pt]);
                    asm volatile("s_nop 15" : "+v"(st[pt]));
                }
            }
            __syncthreads();
#pragma unroll
            for (int pt = 0; pt < 4; ++pt) *(uint2*)(ST + (pt * 16 + fr) * 144 + dk0) = pack4v(st[pt]);
        }
        if (g == 0) {
            float* so = p.out + (d ? OUT_GDN_B : OUT_GDN_F) + (size_t)(seq * 16 + hv) * 16384 + e * 64;
#pragma unroll
            for (int pt = 0; pt < 4; ++pt)
#pragma unroll
                for (int r = 0; r < 4; ++r) so[(size_t)(dk0 + r) * 128 + pt * 16 + fr] = st[pt][r];
        }
        __syncthreads();
    }
}
__device__ __forceinline__ void gdn_combine_phase(const Params& p) {
    const int tid = otid(), wave = tid >> 6, lane = tid & 63;
    u16* YF = (u16*)(p.ws + WS_G); const u16* YB = (const u16*)(p.ws + WS_YB); const u16* P = (const u16*)(p.ws + WS_P);
    float nw[8];
    *(float4*)nw = *(const float4*)(p.gdn_norm_w + (lane & 15) * 8); *(float4*)(nw + 4) = *(const float4*)(p.gdn_norm_w + (lane & 15) * 8 + 4);
    for (int row = blockIdx.x * 8 + wave; row < TG; row += gridDim.x * 8) {
#pragma unroll
        for (int i = 0; i < 4; ++i) { const int c = i * 512 + lane * 8;
            float a[8], b[8], z[8], o[8]; unpack8(ldnt16(YF + (size_t)row * DI + c), a); unpack8(ldnt16(YB + (size_t)row * DI + c), b); unpack8(ldnt16(P + (size_t)row * NINP + 4096 + c), z);
            float ss = 0.f;
#pragma unroll
            for (int j = 0; j < 8; ++j) { a[j] += b[j]; ss += a[j] * a[j]; }
            ss += __shfl_xor(ss, 1); ss += __shfl_xor(ss, 2); ss += __shfl_xor(ss, 4); ss += __shfl_xor(ss, 8);
            const float r = rsqrtf(ss * (1.f / 128.f) + 1e-6f);
#pragma unroll
            for (int j = 0; j < 8; ++j) o[j] = a[j] * r * nw[j] * siluf(z[j]);
            *(uint4*)(YF + (size_t)row * DI + c) = pack8(o); }
    }
}
__device__ __forceinline__ void ln_phase(const Params& p, int l, int which, int g, int wg0, int nwg) {
    const int tid = otid(), wave = tid >> 6, lane = tid & 63;
    if ((int)blockIdx.x < wg0) return;
    const u16* O = (const u16*)(p.ws + (which ? WS_YB : WS_P));
    const float* adab = (const float*)(p.ws + WS_ADA); u16* H = (u16*)(p.ws + WS_H);
    const float* lg = p.ln_g + (l * 2 + which) * 1024; const float* lb = p.ln_b + (l * 2 + which) * 1024;
    const bool has_next = !(l == 1 && which == 1);
    for (int row = ((int)blockIdx.x - wg0) * 8 + wave; row < TG; row += nwg * 8) {
        const int t = g * TG + row, cond = cond_of(t);
        const float* xr = (l == 0 && which == 0) ? xin_row(p, t) : p.out + (size_t)t * D;
        const float* ada = adab + (size_t)(l * 9 + cond) * 6144;
        const float* gate = ada + (which ? 5120 : 2048);
        float v[16]; float s = 0.f;
#pragma unroll
        for (int i = 0; i < 4; ++i) { const int c = i * 256 + lane * 4;
            const float4 x = ldnt16f(xr + c), gt = *(const float4*)(gate + c);
            float o0[4], o1[4]; unpack4(ldnt8(O + (size_t)row * D + c), o0); unpack4(ldnt8(O + (size_t)TG * D + (size_t)row * D + c), o1);
            float4 o; o.x = o0[0] + o1[0]; o.y = o0[1] + o1[1]; o.z = o0[2] + o1[2]; o.w = o0[3] + o1[3];
            v[4 * i] = ALPHA * x.x + gt.x * o.x; v[4 * i + 1] = ALPHA * x.y + gt.y * o.y; v[4 * i + 2] = ALPHA * x.z + gt.z * o.z; v[4 * i + 3] = ALPHA * x.w + gt.w * o.w;
            s += v[4 * i] + v[4 * i + 1] + v[4 * i + 2] + v[4 * i + 3]; }
        const float mean = wave_sum(s) * (1.f / 1024.f);
        float q = 0.f;
#pragma unroll
        for (int i = 0; i < 16; ++i) { v[i] -= mean; q += v[i] * v[i]; }
        const float rstd = rsqrtf(wave_sum(q) * (1.f / 1024.f) + 1e-5f);
        const float* nsh = which == 0 ? ada + 3072 : adab + (size_t)((l + 1) * 9 + cond) * 6144;
        const float* nsc = nsh + 1024;
#pragma unroll
        for (int i = 0; i < 4; ++i) { const int c = i * 256 + lane * 4;
            const float4 gg = *(const float4*)(lg + c), bb = *(const float4*)(lb + c);
            float4 y; y.x = v[4 * i] * rstd * gg.x + bb.x; y.y = v[4 * i + 1] * rstd * gg.y + bb.y; y.z = v[4 * i + 2] * rstd * gg.z + bb.z; y.w = v[4 * i + 3] * rstd * gg.w + bb.w;
            *(float4*)(p.out + (size_t)t * D + c) = y;
            if (has_next) { const float4 sh = *(const float4*)(nsh + c), sc = *(const float4*)(nsc + c);
                uint2 w; w.x = pk2(y.x * (1.f + sc.x) + sh.x, y.y * (1.f + sc.y) + sh.y); w.y = pk2(y.z * (1.f + sc.z) + sh.z, y.w * (1.f + sc.w) + sh.w);
                *(uint2*)(H + (size_t)t * D + c) = w; } }
    }
}
__device__ __forceinline__ void convgate_phase(const Params& p, int l, int g) {
    const int tid = otid();
    const u16* U = (const u16*)(p.ws + WS_P); u16* G = (u16*)(p.ws + WS_G);
    const int rpb = (TG + gridDim.x - 1) / gridDim.x;
    const int r_lo = blockIdx.x * rpb, r_hi = min(TG, r_lo + rpb);
    if (tid >= 352) return;
    const int c = tid * 8;
    const float* cw = p.ffn_conv_w + (size_t)l * 9 * FF + c;
    float bias[8]; *(float4*)bias = *(const float4*)(p.ffn_conv_b + l * FF + c); *(float4*)(bias + 4) = *(const float4*)(p.ffn_conv_b + l * FF + c + 4);
    if (g == 0) {
        float w[3][8];
#pragma unroll
        for (int j = 0; j < 3; ++j) { *(float4*)w[j] = *(const float4*)(cw + (3 + j) * FF); *(float4*)(w[j] + 4) = *(const float4*)(cw + (3 + j) * FF + 4); }
        for (int row = r_lo; row < r_hi; ++row) {
            const int tp = row & 255;
            uint4 dv[3];
#pragma unroll
            for (int j = 0; j < 3; ++j) { const bool ok = (unsigned)(tp + j - 1) < 256u; dv[j] = *(const uint4*)(U + (size_t)(row + (ok ? j - 1 : 0)) * FF2 + c); }
            const uint4 vraw = *(const uint4*)(U + (size_t)row * FF2 + FF + c);
            float acc[8];
#pragma unroll
            for (int k = 0; k < 8; ++k) acc[k] = bias[k];
#pragma unroll
            for (int j = 0; j < 3; ++j) { const float m = (unsigned)(tp + j - 1) < 256u ? 1.f : 0.f; float a[8]; unpack8(dv[j], a);
#pragma unroll
                for (int k = 0; k < 8; ++k) acc[k] += (m * w[j][k]) * a[k]; }
            float vv[8], o[8]; unpack8(vraw, vv);
#pragma unroll
            for (int k = 0; k < 8; ++k) o[k] = siluf(acc[k]) * vv[k];
            *(uint4*)(G + (size_t)row * FF + c) = pack8(o);
        }
    } else {
        float w[9][8];
#pragma unroll
        for (int t = 0; t < 9; ++t) { *(float4*)w[t] = *(const float4*)(cw + t * FF); *(float4*)(w[t] + 4) = *(const float4*)(cw + t * FF + 4); }
        for (int row = r_lo; row < r_hi; ++row) {
            const int tp = row & 2047, gr = tp >> 6, gc = tp & 63;
            uint4 dv[9];
#pragma unroll
            for (int i = 0; i < 3; ++i)
#pragma unroll
                for (int j = 0; j < 3; ++j) { const bool ok = (unsigned)(gr + i - 1) < 32u && (unsigned)(gc + j - 1) < 64u;
                    dv[i * 3 + j] = *(const uint4*)(U + (size_t)(row + (ok ? (i - 1) * 64 + (j - 1) : 0)) * FF2 + c); }
            const uint4 vraw = *(const uint4*)(U + (size_t)row * FF2 + FF + c);
            float acc[8];
#pragma unroll
            for (int k = 0; k < 8; ++k) acc[k] = bias[k];
#pragma unroll
            for (int i = 0; i < 3; ++i)
#pragma unroll
                for (int j = 0; j < 3; ++j) { const float m = ((unsigned)(gr + i - 1) < 32u && (unsigned)(gc + j - 1) < 64u) ? 1.f : 0.f; float a[8]; unpack8(dv[i * 3 + j], a);
#pragma unroll
                    for (int k = 0; k < 8; ++k) acc[k] += (m * w[i * 3 + j][k]) * a[k]; }
            float vv[8], o[8]; unpack8(vraw, vv);
#pragma unroll
            for (int k = 0; k < 8; ++k) o[k] = siluf(acc[k]) * vv[k];
            *(uint4*)(G + (size_t)row * FF + c) = pack8(o);
        }
    }
}
__device__ __forceinline__ void gemm_bf16out(PG8_LAS unsigned char* lds, const u16* A, const u16* Bt, u16* O, int M, int N, int K) {
    pg8::Gemm gg{A, Bt, M, N, K, K, N / 256}; pg8::StaticOrder S; S.init(M, N, (int)gridDim.x, (int)blockIdx.x);
    pg8::EpiBf16 E{O, N, N / 256, 0};
    pg8::gemm_phase<pg8::EpiBf16, pg8::StaticOrder>(lds, gg, S, E, nullptr);
}
__device__ __forceinline__ void gemm_f32out(PG8_LAS unsigned char* lds, const u16* A, const u16* Bt, float* C, int M, int N, int K) {
    pg8::Gemm gg{A, Bt, M, 2 * N, K / 2, K, N / 256}; pg8::StaticOrder S; S.init(M, 2 * N, (int)gridDim.x, (int)blockIdx.x);
    pg8::EpiBf16 E{(u16*)C, N, N / 256, (size_t)M * N};
    pg8::gemm_phase<pg8::EpiBf16, pg8::StaticOrder>(lds, gg, S, E, nullptr);
}


__device__ __forceinline__ void grid_bar(unsigned* ctr, unsigned target) {
    asm volatile("s_waitcnt vmcnt(0)" ::: "memory");
    __syncthreads();
    if (threadIdx.x < 64) {
        if (threadIdx.x == 0) {
            __builtin_amdgcn_fence(__ATOMIC_RELEASE, "agent");
            asm volatile("s_waitcnt vmcnt(0)" ::: "memory");
            __hip_atomic_fetch_add(ctr, 1u, __ATOMIC_RELAXED, __HIP_MEMORY_SCOPE_AGENT);
            while (__hip_atomic_load(ctr, __ATOMIC_RELAXED, __HIP_MEMORY_SCOPE_AGENT) < target) __builtin_amdgcn_s_sleep(1);
        }
        __builtin_amdgcn_fence(__ATOMIC_ACQUIRE, "agent");
        asm volatile("s_waitcnt vmcnt(0)" ::: "memory");
    }
    __syncthreads();
}

#define XB_TMO      128
#define XB_XCNT(j)  (256  + 64 * (j))
#define XB_XSUB(j)  (1280 + 64 * (j))
#define XB_XGEN(j)  (2304 + 64 * (j))
#define XB_TOP      3328
#define XB_TOPGEN   3392
#define XCD_BAR_WORDS 3456
#define XB_SPIN_CAP (1u << 18)
#define LAS __attribute__((address_space(3)))

__device__ __forceinline__ unsigned xb_ld(unsigned* p)              { return __hip_atomic_load(p, __ATOMIC_RELAXED, __HIP_MEMORY_SCOPE_AGENT); }
__device__ __forceinline__ unsigned xb_add(unsigned* p, unsigned v) { return __hip_atomic_fetch_add(p, v, __ATOMIC_RELAXED, __HIP_MEMORY_SCOPE_AGENT); }
__device__ __forceinline__ unsigned xb_xcc_id() { return (unsigned)__builtin_amdgcn_s_getreg((3 << 11) | 20) & 0xFu; }
#define XB_SPIN(cond, bar) do { unsigned _sp = 0; while (cond) { __builtin_amdgcn_s_sleep(1); \
    if ((++_sp & 255u) == 0u) { if (xb_ld(&(bar)[XB_TMO])) break; if (_sp > XB_SPIN_CAP) { atomicAdd(&(bar)[XB_TMO], 1u); break; } } } } while (0)
struct XcdBarrier {
    unsigned* bar; unsigned x;
    volatile LAS unsigned* st;
};

__device__ __forceinline__ XcdBarrier xcd_barrier_post(unsigned* bar, volatile LAS unsigned* st) {
    XcdBarrier b; b.bar = bar; b.x = xb_xcc_id(); b.st = st;
    if (threadIdx.x == 0) (void)xb_add(&bar[XB_XCNT(b.x)], 1u);
    return b;
}
__device__ __forceinline__ void xcd_barrier_complete(unsigned* bar, unsigned x, unsigned& nloc, unsigned& nx) {
    const unsigned G = gridDim.x * gridDim.y * gridDim.z;
    unsigned sum, cnt, mine, sp = 0u;
    for (;;) {
        sum = 0u; cnt = 0u; mine = 0u;
#pragma unroll
        for (unsigned j = 0; j < 16; ++j) { const unsigned c = xb_ld(&bar[XB_XCNT(j)]); sum += c; cnt += (c > 0u) ? 1u : 0u; mine = (j == x) ? c : mine; }
        if (sum == G) break;
        __builtin_amdgcn_s_sleep(1);
        if ((++sp & 255u) == 0u) { if (xb_ld(&bar[XB_TMO])) break; if (sp > XB_SPIN_CAP) { atomicAdd(&bar[XB_TMO], 1u); break; } }
    }
    nloc = mine > 0u ? mine : 1u; nx = cnt > 0u ? cnt : 1u;
}

__device__ __forceinline__ void xcd_barrier(const XcdBarrier& b) {
    asm volatile("s_waitcnt vmcnt(0)" ::: "memory");
    __syncthreads();
    if (threadIdx.x == 0) {
        unsigned* bar = b.bar;
        __builtin_amdgcn_s_waitcnt(0);
        unsigned nloc = b.st[0], nx = b.st[1];
        if (nloc == 0u) { xcd_barrier_complete(bar, b.x, nloc, nx); b.st[0] = nloc; b.st[1] = nx; }
        const unsigned old = xb_add(&bar[XB_XSUB(b.x)], 1u);
        const unsigned gen = old / nloc;
        if (old + 1u == (gen + 1u) * nloc) {
            __builtin_amdgcn_fence(__ATOMIC_RELEASE, "agent");
            asm volatile("s_waitcnt vmcnt(0)" ::: "memory");
            const unsigned og = xb_add(&bar[XB_TOP], 1u);
            const unsigned tg = og / nx;
            if (og + 1u == (tg + 1u) * nx) xb_add(&bar[XB_TOPGEN], 1u);
            else XB_SPIN(xb_ld(&bar[XB_TOPGEN]) == tg, bar);
            __builtin_amdgcn_fence(__ATOMIC_ACQUIRE, "agent");
            xb_add(&bar[XB_XGEN(b.x)], 1u);
            asm volatile("s_waitcnt vmcnt(0)" ::: "memory");
        } else {
            XB_SPIN(xb_ld(&bar[XB_XGEN(b.x)]) == gen, bar);
            __builtin_amdgcn_fence(__ATOMIC_ACQUIRE, "agent");
            asm volatile("s_waitcnt vmcnt(0)" ::: "memory");
        }
    }
    __syncthreads();
}


__global__ void __launch_bounds__(NTHREADS, 2) mega_fwd(Params p) {
    extern __shared__ __attribute__((aligned(16))) unsigned char lds_raw[];
    cg::grid_group grid = cg::this_grid();
    PG8_LAS unsigned char* ldsp = (PG8_LAS unsigned char*)lds_raw;
    float* ldsf = (float*)lds_raw;
    unsigned char* ws = p.ws;
    volatile LAS unsigned* xst = (volatile LAS unsigned*)((PG8_LAS unsigned char*)lds_raw + (LDS_BYTES - 16));
    if (threadIdx.x == 0) { xst[0] = 0u; xst[1] = 0u; }
    __syncthreads();
    const XcdBarrier xbar = xcd_barrier_post((unsigned*)(ws + WS_BAR), xst);
    for (int ph = p.ph_lo; ph < p.ph_hi; ++ph) {
        if (ph == 0) { for (int rep = 0; rep < REP_EW; ++rep) { prep_phase(p, ldsf); __syncthreads(); } }
        else if (ph == 1) { for (int rep = 0; rep < REP_EW; ++rep) mod0_phase(p); }
        else {
            const int q = ph - 2, gl = q >> 3, s = q & 7;
            const int l = gl / 3, g = gl % 3;
            const u16* wb = (const u16*)(ws + WS_W + (size_t)l * W_LAYER);
            const u16* Hg = (const u16*)(ws + WS_H) + (size_t)g * TG * D;
            const int G = (int)gridDim.x;
            if (gl == 6) ln_phase(p, 1, 1, 2, 0, G);
            else if (s == 0) {
                { for (int rep = 0; rep < REP_GEMM; ++rep) { gemm_bf16out(ldsp, Hg, wb + W_IN / 2, (u16*)(ws + WS_P), TG, NINP, D); __syncthreads(); } }
                if (gl > 0) {
                    const int lead = 800 - 3 * G, wg0 = (lead > 0 && lead < G) ? lead : 0;
                    ln_phase(p, (gl - 1) / 3, 1, (gl - 1) % 3, wg0, G - wg0);
                }
            }
            else if (s == 1) { for (int rep = 0; rep < REP_SCAN; ++rep) { if (l == 0) ssd_scan_mfma(p, g, lds_raw); else gdn_scan_mfma(p, g, lds_raw); __syncthreads(); } }
            else if (s == 2) { if (l == 0) ssd_combine_phase(p); else gdn_combine_phase(p); }
            else if (s == 3) { for (int rep = 0; rep < REP_GEMM; ++rep) { gemm_f32out(ldsp, (const u16*)(ws + WS_G), wb + W_OUT / 2, (float*)(ws + WS_P), TG, D, DI); __syncthreads(); } }
            else if (s == 4) ln_phase(p, l, 0, g, 0, G);
            else if (s == 5) { for (int rep = 0; rep < REP_GEMM; ++rep) { gemm_bf16out(ldsp, Hg, wb + W_UP / 2, (u16*)(ws + WS_P), TG, FF2, D); __syncthreads(); } }
            else if (s == 6) { for (int rep = 0; rep < REP_EW; ++rep) convgate_phase(p, l, g); }
            else { for (int rep = 0; rep < REP_GEMM; ++rep) { gemm_f32out(ldsp, (const u16*)(ws + WS_G), wb + W_DN / 2, (float*)(ws + WS_YB), TG, D, FF); __syncthreads(); } }
        }
        if (ph + 1 < p.ph_hi) {
            if (p.ph_lo < 0) grid.sync();
            for (int rep = 0; rep < REP_SYNC; ++rep) xcd_barrier(xbar);
        }
    }
}

extern "C" void kernel_launch(void* const* d_in, const int* in_sizes, int n_in, void* d_out, int out_size, void* d_ws, size_t ws_size, hipStream_t stream) {
    static int grid = 0;
    if (grid == 0) {
        if (n_in != 30 || ws_size < WS_END) { fprintf(stderr, "kernel_launch: unexpected n_in %d or ws_size %zu (need %zu)\n", n_in, ws_size, (size_t)WS_END); grid = -1; return; }
        int dev = 0, cus = 0, per_cu = 0;
        hipGetDevice(&dev); hipDeviceGetAttribute(&cus, hipDeviceAttributeMultiprocessorCount, dev);
        if (hipFuncSetAttribute((const void*)mega_fwd, hipFuncAttributeMaxDynamicSharedMemorySize, LDS_BYTES) != hipSuccess) { fprintf(stderr, "kernel_launch: hipFuncSetAttribute failed\n"); grid = -1; return; }
        if (hipOccupancyMaxActiveBlocksPerMultiprocessor(&per_cu, (const void*)mega_fwd, NTHREADS, LDS_BYTES) != hipSuccess || per_cu < 1) per_cu = 1;
        (void)hipGetLastError();
        grid = cus * 1;
        if (grid <= 0) grid = 256;
    }
    if (grid < 0) return;
    Params p; memset(&p, 0, sizeof(p));
    const float** pp = (const float**)&p;
    for (int i = 0; i < 30; ++i) pp[i] = (const float*)d_in[i];
    p.out = (float*)d_out; p.ws = (unsigned char*)d_ws; p.ph_lo = 0; p.ph_hi = NPHASES;
    (void)hipMemsetAsync((char*)d_ws + WS_BAR, 0, XCD_BAR_WORDS * 4, stream);
    void* args[] = {&p};
    hipError_t e = hipLaunchCooperativeKernel((const void*)mega_fwd, dim3(grid), dim3(NTHREADS), args, LDS_BYTES, stream);
    if (e != hipSuccess) fprintf(stderr, "cooperative launch failed: %s (grid %d)\n", hipGetErrorString(e), grid);
}
```

```cpp
#include <hip/hip_runtime.h>
#include <hip/hip_cooperative_groups.h>
#include <cstdio>
#include <cstring>
namespace cg = cooperative_groups;
namespace pg8 {
#define PG8_LAS __attribute__((address_space(3)))
typedef unsigned short bf16_t;
typedef short bf16x8 __attribute__((ext_vector_type(8)));
typedef float f32x4 __attribute__((ext_vector_type(4)));
typedef unsigned u32x4 __attribute__((ext_vector_type(4)));
constexpr int BM = 256, BK = 64, HALF = 128, HTB = HALF * BK * 2  , STAGE_BYTES = 8 * HTB, NXCD = 8, WGM = 8;

__host__ __device__ __forceinline__ int lds_byte(int r, int c) { const int st = (r >> 4) * 2 + (c >> 5), rr = r & 15, cc = c & 31, ob = rr * 64 + cc * 2; return st * 1024 + (ob ^ (((ob >> 9) & 1) << 5)); }
__host__ __device__ __forceinline__ void stage_rc(int b, int& R, int& C) { const int st = b / 1024, sb = b % 1024, swz = sb ^ (((sb >> 9) & 1) << 5); R = (st >> 1) * 16 + swz / 64; C = (st & 1) * 32 + (swz % 64) / 2; }
__host__ __device__ __forceinline__ int perm32(int rho) { const int n = rho >> 4, i = rho & 15; return 8 * (i >> 2) + 4 * n + (i & 3); }

struct Unit { int pm, pn; };
struct Gemm { const bf16_t* A; const bf16_t* Bt; int M, N, K, ld, npn; };

struct StaticOrder {
    int nM, nN, nwg, G, c;
    __host__ __device__ void init(int M, int N, int G_, int c_) { nM = M / BM; nN = N / BM; nwg = nM * nN; G = G_; c = c_; }
    __host__ __device__ bool next(int i, Unit& u) const {
        const long L = (long)i * G + c; if (L >= nwg) return false;
        int wgid = (int)L; { const int q = nwg / NXCD, r = nwg % NXCD, xcd = wgid % NXCD, off = wgid / NXCD; wgid = (xcd < r ? xcd * (q + 1) : r * (q + 1) + (xcd - r) * q) + off; }
        const int nig = WGM * nN, gid = wgid / nig, fm = gid * WGM, gsz = (nM - fm) < WGM ? (nM - fm) : WGM;
        u.pm = fm + ((wgid % nig) % gsz); u.pn = (wgid % nig) / gsz; return true;
    }
    __device__ __forceinline__ void a_ready(const Unit&) const {}
    __device__ __forceinline__ void done(const Unit&) const {}
};
typedef __bf16 bf16x2_t __attribute__((ext_vector_type(2)));
typedef float f32x2_t __attribute__((ext_vector_type(2)));
__device__ __forceinline__ unsigned cvt_pk_bf16(float lo, float hi) { const f32x2_t f = {lo, hi}; const bf16x2_t v = __builtin_convertvector(f, bf16x2_t); return __builtin_bit_cast(unsigned, v); }
typedef unsigned u32x4 __attribute__((ext_vector_type(4)));
struct EpiF32 {
    static constexpr bool PERM = false, AFTER_DRAIN = false;
    float* C; int ldc; int npn; size_t split_stride;
    __device__ __forceinline__ void operator()(const f32x4 (&acc)[2][2][4][2], const Unit& u, int wr, int wc, int fr, int fq) const {
        const int row0 = u.pm * BM + wr * 64 + fr, col0 = (u.pn % npn) * BM + wc * 32 + 4 * fq;
        float* Cs = C + (size_t)(u.pn / npn) * split_stride;
#pragma unroll
        for (int ai = 0; ai < 2; ++ai)
#pragma unroll
            for (int m = 0; m < 4; ++m) { float* rowp = Cs + (size_t)(row0 + ai * HALF + m * 16) * ldc + col0;
#pragma unroll
                for (int bj = 0; bj < 2; ++bj)
#pragma unroll
                    for (int n = 0; n < 2; ++n) *(f32x4*)(rowp + bj * HALF + n * 16) = acc[ai][bj][m][n]; }
    }
};
struct EpiBf16 {
    static constexpr bool PERM = true, AFTER_DRAIN = false;
    bf16_t* O; int ldc; int npn; size_t split_stride;
    __device__ __forceinline__ void operator()(const f32x4 (&acc)[2][2][4][2], const Unit& u, int wr, int wc, int fr, int fq) const {
        const int row0 = u.pm * BM + wr * 64 + fr, col0 = (u.pn % npn) * BM + wc * 32 + 8 * fq;
        bf16_t* Os = O + (size_t)(u.pn / npn) * split_stride;
#pragma unroll
        for (int ai = 0; ai < 2; ++ai)
#pragma unroll
            for (int m = 0; m < 4; ++m) { bf16_t* rowp = Os + (size_t)(row0 + ai * HALF + m * 16) * ldc + col0;
#pragma unroll
                for (int bj = 0; bj < 2; ++bj) { const f32x4 v0 = acc[ai][bj][m][0], v1 = acc[ai][bj][m][1];
                    u32x4 w; w.x = cvt_pk_bf16(v0[0], v0[1]); w.y = cvt_pk_bf16(v0[2], v0[3]); w.z = cvt_pk_bf16(v1[0], v1[1]); w.w = cvt_pk_bf16(v1[2], v1[3]);
                    *(u32x4*)(rowp + bj * HALF) = w; } }
    }
};
template <class Epi, class Sched, bool STAMP = false>
__device__ __forceinline__ void gemm_phase(PG8_LAS unsigned char* lds, const Gemm g, const Sched& S, const Epi& E, unsigned long long* stamps) {
    int tid_ = threadIdx.x; asm volatile("" : "+v"(tid_)); const int tid = tid_, wid = __builtin_amdgcn_readfirstlane(tid >> 6), lane = tid & 63, wr = wid >> 2, wc = wid & 3, fr = lane & 15, fq = lane >> 4;
    const int K = g.K, nt = K / BK;
    int ts_lo = 0, ts_hi = 0, nts = 0; const unsigned long long rt_entry = STAMP ? (unsigned long long)wall_clock64() : 0ull;
#define PG8_STAMP() do { if (STAMP && wid == 0 && nts < 64) { const unsigned long long _c = (unsigned long long)clock64(); \
        ts_lo = (lane == nts) ? (int)(unsigned)_c : ts_lo; ts_hi = (lane == nts) ? (int)(unsigned)(_c >> 32) : ts_hi; ++nts; } } while (0)
    PG8_STAMP();
    unsigned voffA[2], voffB[2];
#pragma unroll
    for (int i = 0; i < 2; ++i) { int R, C; stage_rc(tid * 16 + i * 8192, R, C); const int Rb = Epi::PERM ? ((R & ~31) + perm32(R & 31)) : R;
        voffA[i] = (unsigned)(R * g.ld + C) * 2u; voffB[i] = (unsigned)(Rb * g.ld + C) * 2u; }
    const size_t kstep = (size_t)(BK * 2);
    const size_t hstep = (size_t)HALF * g.ld * 2;
    const size_t tstep = 2 * hstep;
    const unsigned ldsw = (unsigned)wid * 1024u;
    const int aoff = lds_byte(wr * 64 + fr, fq * 8), boff = lds_byte(wc * 32 + fr, fq * 8);
#define PG8_SA(b, h) (((b) * 2 + (h)) * HTB)
#define PG8_SB(b, h) ((4 + (b) * 2 + (h)) * HTB)
#define PG8_STAGE(bufoff, gbase, voff) do { _Pragma("unroll") for (int _i = 0; _i < 2; ++_i) \
        __builtin_amdgcn_global_load_lds((const unsigned*)((const char*)(gbase) + (voff)[_i]), (PG8_LAS unsigned*)(lds + (bufoff) + ldsw + _i * 8192), 16, 0, 0); } while (0)
#define PG8_LDA(dst, b, h) do { _Pragma("unroll") for (int m = 0; m < 4; ++m) _Pragma("unroll") for (int k = 0; k < 2; ++k) dst[m][k] = *(const PG8_LAS bf16x8*)(lds + PG8_SA(b, h) + aoff + m * 2048 + k * 1024); } while (0)
#define PG8_LDB(dst, b, h) do { _Pragma("unroll") for (int n = 0; n < 2; ++n) _Pragma("unroll") for (int k = 0; k < 2; ++k) dst[n][k] = *(const PG8_LAS bf16x8*)(lds + PG8_SB(b, h) + boff + n * 2048 + k * 1024); } while (0)
#define PG8_MMA(ai, bj, At, Bt) do { __builtin_amdgcn_s_setprio(1); _Pragma("unroll") for (int m = 0; m < 4; ++m) _Pragma("unroll") for (int n = 0; n < 2; ++n) _Pragma("unroll") for (int k = 0; k < 2; ++k) \
        acc[ai][bj][m][n] = __builtin_amdgcn_mfma_f32_16x16x32_bf16(Bt[n][k], At[m][k], acc[ai][bj][m][n], 0, 0, 0); __builtin_amdgcn_s_setprio(0); } while (0)
#define PG8_WAIT_V(n) asm volatile("s_waitcnt vmcnt(" #n ")" ::: "memory")
#define PG8_WAIT_L(n) asm volatile("s_waitcnt lgkmcnt(" #n ")" ::: "memory")
#define PG8_BAR __builtin_amdgcn_s_barrier()
#define PG8_SCHED __builtin_amdgcn_sched_barrier(0)
    Unit cur, nxt; int ui = 0;
    if (!S.next(0, cur)) return;
    f32x4 acc[2][2][4][2];
#pragma unroll
    for (int a = 0; a < 2; ++a)
#pragma unroll
        for (int b = 0; b < 2; ++b)
#pragma unroll
            for (int m = 0; m < 4; ++m)
#pragma unroll
                for (int n = 0; n < 2; ++n) acc[a][b][m][n] = (f32x4){0.f, 0.f, 0.f, 0.f};
    bf16x8 At[4][2], B0[2][2], B1[2][2];
    const size_t ksb = (size_t)K * 2;
    const char* cA = (const char*)g.A + (size_t)cur.pm * tstep + (size_t)(cur.pn / g.npn) * ksb; const char* cB = (const char*)g.Bt + (size_t)(cur.pn % g.npn) * tstep + (size_t)(cur.pn / g.npn) * ksb;
    S.a_ready(cur);
    PG8_STAGE(PG8_SB(0, 0), cB, voffB); PG8_STAGE(PG8_SA(0, 0), cA, voffA); PG8_STAGE(PG8_SB(0, 1), cB + hstep, voffB); PG8_STAGE(PG8_SA(0, 1), cA + hstep, voffA);
    if (wr == 1) PG8_BAR;
    PG8_WAIT_V(4); PG8_BAR;
    PG8_STAGE(PG8_SB(1, 0), cB + kstep, voffB); PG8_STAGE(PG8_SA(1, 0), cA + kstep, voffA); PG8_STAGE(PG8_SB(1, 1), cB + hstep + kstep, voffB);
    PG8_WAIT_V(6); PG8_BAR;
    PG8_STAMP();
    for (;;) {
        const bool has_next = S.next(ui + 1, nxt);
        const char* nA = has_next ? (const char*)g.A + (size_t)nxt.pm * tstep + (size_t)(nxt.pn / g.npn) * ksb : cA; const char* nB = has_next ? (const char*)g.Bt + (size_t)(nxt.pn % g.npn) * tstep + (size_t)(nxt.pn / g.npn) * ksb : cB;
        for (int t = 0; t < nt; t += 2) {
            const bool last = (t == nt - 2);
            const char* a1 = cA + (size_t)(t + 1) * kstep;
            const char* a2 = last ? nA : cA + (size_t)(t + 2) * kstep; const char* b2 = last ? nB : cB + (size_t)(t + 2) * kstep;
            const char* a3 = a2 + kstep; const char* b3 = b2 + kstep;
            if (last && has_next) S.a_ready(nxt);
            PG8_LDB(B0, 0, 0); PG8_SCHED; PG8_LDA(At, 0, 0); PG8_STAGE(PG8_SA(1, 1), a1 + hstep, voffA);
            PG8_WAIT_L(8); PG8_BAR; PG8_WAIT_L(0); PG8_MMA(0, 0, At, B0); PG8_BAR; PG8_SCHED;
            PG8_LDB(B1, 0, 1); PG8_STAGE(PG8_SB(0, 0), b2, voffB);
            PG8_BAR; PG8_WAIT_L(0); PG8_MMA(0, 1, At, B1); PG8_BAR;
            PG8_LDA(At, 0, 1); PG8_STAGE(PG8_SA(0, 0), a2, voffA);
            PG8_BAR; PG8_WAIT_L(0); PG8_MMA(1, 0, At, B0); PG8_BAR; PG8_SCHED;
            PG8_STAGE(PG8_SB(0, 1), b2 + hstep, voffB);
            PG8_WAIT_V(6); PG8_BAR; PG8_MMA(1, 1, At, B1); PG8_BAR;
            PG8_LDB(B0, 1, 0); PG8_SCHED; PG8_LDA(At, 1, 0); PG8_STAGE(PG8_SA(0, 1), a2 + hstep, voffA);
            PG8_WAIT_L(8); PG8_BAR; PG8_WAIT_L(0); PG8_MMA(0, 0, At, B0); PG8_BAR; PG8_SCHED;
            PG8_LDB(B1, 1, 1); PG8_STAGE(PG8_SB(1, 0), b3, voffB);
            PG8_BAR; PG8_WAIT_L(0); PG8_MMA(0, 1, At, B1); PG8_BAR;
            PG8_LDA(At, 1, 1); PG8_STAGE(PG8_SA(1, 0), a3, voffA);
            PG8_BAR; PG8_WAIT_L(0); PG8_MMA(1, 0, At, B0); PG8_BAR; PG8_SCHED;
            PG8_STAGE(PG8_SB(1, 1), b3 + hstep, voffB);
            PG8_WAIT_V(6); PG8_BAR; PG8_MMA(1, 1, At, B1); PG8_BAR;
        }
        PG8_STAMP();
        if constexpr (!Epi::AFTER_DRAIN) { E(acc, cur, wr, wc, fr, fq); S.done(cur); }
        PG8_STAMP();
        if (!has_next) break;
#pragma unroll
        for (int a = 0; a < 2; ++a)
#pragma unroll
            for (int b = 0; b < 2; ++b)
#pragma unroll
                for (int m = 0; m < 4; ++m)
#pragma unroll
                    for (int n = 0; n < 2; ++n) acc[a][b][m][n] = (f32x4){0.f, 0.f, 0.f, 0.f};
        cur = nxt; cA = nA; cB = nB; ++ui;
    }
    PG8_WAIT_V(0);
    if (wr == 0) PG8_BAR;
    PG8_BAR;
    if constexpr (Epi::AFTER_DRAIN) { E.fused(acc, cur, wr, wc, fr, fq, lds, wid, lane); S.done(cur); }
    PG8_STAMP();
    if (STAMP && wid == 0) { stamps[lane] = lane < nts ? (((unsigned long long)(unsigned)ts_hi << 32) | (unsigned)ts_lo) : 0ull;
        if (lane == 62) stamps[62] = rt_entry; if (lane == 63) stamps[63] = (unsigned long long)wall_clock64(); }
#undef PG8_STAMP
#undef PG8_SA
#undef PG8_SB
#undef PG8_STAGE
#undef PG8_LDA
#undef PG8_LDB
#undef PG8_MMA
#undef PG8_WAIT_V
#undef PG8_WAIT_L
#undef PG8_BAR
#undef PG8_SCHED
}
}

typedef unsigned short u16;
constexpr int D = 1024, T_ALL = 24576, TG = 8192, NGRP = 3;
constexpr int NINP = 6400, DI = 2048, FF = 2816, FF2 = 5632;
constexpr int NTHREADS = 512, LDS_BYTES = 143360;
constexpr float ALPHA = 1.4142135623730951f;
constexpr size_t WS_ADA = 0;
constexpr size_t WS_BAR = 499712;
constexpr size_t WS_W = 524288;
constexpr size_t W_IN = 0, W_OUT = W_IN + (size_t)NINP * D * 2, W_UP = W_OUT + (size_t)D * DI * 2, W_DN = W_UP + (size_t)FF2 * D * 2, W_LAYER = W_DN + (size_t)D * FF * 2;
constexpr size_t WS_H = WS_W + 2 * W_LAYER;
constexpr size_t WS_P = WS_H + (size_t)T_ALL * D * 2;
constexpr size_t WS_G = WS_P + (size_t)TG * NINP * 2;
constexpr size_t WS_YB = WS_G + (size_t)TG * FF * 2;
constexpr size_t WS_END = WS_YB + (size_t)TG * DI * 2;
constexpr size_t OUT_SSD_F = (size_t)T_ALL * D, OUT_SSD_B = OUT_SSD_F + 8388608, OUT_GDN_F = OUT_SSD_B + 8388608, OUT_GDN_B = OUT_GDN_F + 8388608;
#ifndef REP_SCAN
#define REP_SCAN 1
#endif
#ifndef REP_EW
#define REP_EW 1
#endif
#ifndef REP_SYNC
#define REP_SYNC 1
#endif
#ifndef REP_GEMM
#define REP_GEMM 1
#endif
constexpr int NPHASES = 2 + 2 * NGRP * 8 + 1;

struct Params {
    const float *x_prompt, *x_sample, *st_ssd_f, *st_ssd_b, *st_gdn_f, *st_gdn_b, *c, *c_ctx, *w_ada, *b_ada, *ln_g, *ln_b,
        *ssd_w_in, *ssd_conv_w, *ssd_conv_b, *ssd_dt_bias, *ssd_a_log, *ssd_d, *ssd_norm_w, *ssd_w_out,
        *gdn_w_in, *gdn_conv_w, *gdn_dt_bias, *gdn_a_log, *gdn_norm_w, *gdn_w_out,
        *ffn_w_up, *ffn_conv_w, *ffn_conv_b, *ffn_w_down;
    float* out; unsigned char* ws; int ph_lo, ph_hi;
};

__device__ __forceinline__ int otid() { int t = threadIdx.x; asm volatile("" : "+v"(t)); return t; }
__device__ __forceinline__ float bf2f(u16 b) { return __uint_as_float(((unsigned)b) << 16); }
__device__ __forceinline__ unsigned pk2(float lo, float hi) { return pg8::cvt_pk_bf16(lo, hi); }
__device__ __forceinline__ float siluf(float x) { return x * __builtin_amdgcn_rcpf(1.f + __expf(-x)); }
__device__ __forceinline__ float softplusf(float x) { return x > 15.f ? x : __logf(1.f + __expf(x)); }
__device__ __forceinline__ void unpack8(const uint4 v, float* f) {
    f[0] = __uint_as_float(v.x << 16); f[1] = __uint_as_float(v.x & 0xffff0000u); f[2] = __uint_as_float(v.y << 16); f[3] = __uint_as_float(v.y & 0xffff0000u);
    f[4] = __uint_as_float(v.z << 16); f[5] = __uint_as_float(v.z & 0xffff0000u); f[6] = __uint_as_float(v.w << 16); f[7] = __uint_as_float(v.w & 0xffff0000u);
}
__device__ __forceinline__ void unpack4(const uint2 v, float* f) {
    f[0] = __uint_as_float(v.x << 16); f[1] = __uint_as_float(v.x & 0xffff0000u); f[2] = __uint_as_float(v.y << 16); f[3] = __uint_as_float(v.y & 0xffff0000u);
}
__device__ __forceinline__ uint4 pack8(const float* f) { uint4 r; r.x = pk2(f[0], f[1]); r.y = pk2(f[2], f[3]); r.z = pk2(f[4], f[5]); r.w = pk2(f[6], f[7]); return r; }
typedef unsigned ntl_u32x4 __attribute__((ext_vector_type(4)));
typedef unsigned ntl_u32x2 __attribute__((ext_vector_type(2)));
typedef float ntl_f32x4 __attribute__((ext_vector_type(4)));
__device__ __forceinline__ uint4 ldnt16(const void* p) { const ntl_u32x4 v = __builtin_nontemporal_load((const ntl_u32x4*)p); return make_uint4(v.x, v.y, v.z, v.w); }
__device__ __forceinline__ uint2 ldnt8(const void* p) { const ntl_u32x2 v = __builtin_nontemporal_load((const ntl_u32x2*)p); return make_uint2(v.x, v.y); }
__device__ __forceinline__ float4 ldnt16f(const float* p) { const ntl_f32x4 v = __builtin_nontemporal_load((const ntl_f32x4*)p); return make_float4(v.x, v.y, v.z, v.w); }
__device__ __forceinline__ int cond_of(int t) { return t < 8192 ? 0 : 1 + ((t - 8192) >> 11); }
__device__ __forceinline__ const float* xin_row(const Params& p, int t) { return t < 8192 ? p.x_prompt + (size_t)t * D : p.x_sample + (size_t)(t - 8192) * D; }
__device__ __forceinline__ float wave_sum(float v) {
    v += __shfl_xor(v, 1); v += __shfl_xor(v, 2); v += __shfl_xor(v, 4); v += __shfl_xor(v, 8); v += __shfl_xor(v, 16); v += __shfl_xor(v, 32); return v;
}


#define DPP_STEP(v, ctrl, rmask, bctl) (v) += __int_as_float(__builtin_amdgcn_update_dpp(0, __float_as_int(v), (ctrl), (rmask), 0xF, (bctl)))
__device__ __forceinline__ float wave_prefix_sum(float v) {
    DPP_STEP(v, 0x111, 0xF, true); DPP_STEP(v, 0x112, 0xF, true); DPP_STEP(v, 0x114, 0xF, true); DPP_STEP(v, 0x118, 0xF, true);
    DPP_STEP(v, 0x142, 0xA, false);
    DPP_STEP(v, 0x143, 0xC, false);
    return v;
}
__device__ __forceinline__ float wave_last(float v) { return __int_as_float(__builtin_amdgcn_readlane(__float_as_int(v), 63)); }
__device__ __forceinline__ void wprep(const float* __restrict__ src, u16* __restrict__ dst, int K, int N, int Npad, float* tile) {
    const int tid = otid(); const int nkt = K >> 6, nnt = Npad >> 6;
    for (int t = blockIdx.x; t < nkt * nnt; t += gridDim.x) {
        const int kt = t % nkt, nt = t / nkt; const int k0 = kt * 64, n0 = nt * 64;
#pragma unroll
        for (int e = 0; e < 8; ++e) { const int idx = e * 512 + tid; const int kk = idx >> 6, nn = idx & 63; float v = 0.f;
            if (n0 + nn < N) v = src[(size_t)(k0 + kk) * N + n0 + nn];
            tile[kk * 65 + nn] = v; }
        __syncthreads();
#pragma unroll
        for (int e = 0; e < 4; ++e) { const int idx = e * 512 + tid; const int nn = idx >> 5, kp = idx & 31;
            const unsigned w = pk2(tile[(2 * kp) * 65 + nn], tile[(2 * kp + 1) * 65 + nn]);
            *(unsigned*)(dst + (size_t)(n0 + nn) * K + k0 + 2 * kp) = w; }
        __syncthreads();
    }
}
__device__ __forceinline__ void adaln_phase(const Params& p, float* lds) {
    float* s = lds; float* red = lds + 9 * 1024;
    const int tid = otid(), wave = tid >> 6, lane = tid & 63;
    if ((int)blockIdx.x >= 192) return;
    for (int i = tid; i < 9 * 1024; i += NTHREADS) { const int c = i >> 10, k = i & 1023; const float v = c == 0 ? p.c_ctx[k] : p.c[(c - 1) * 1024 + k]; s[i] = siluf(v); }
    __syncthreads();
    float* ada = (float*)(p.ws + WS_ADA);
    for (int ch = blockIdx.x; ch < 192; ch += gridDim.x) {
        const int l = ch / 96, col0 = (ch % 96) * 64;
        const float* w = p.w_ada + (size_t)l * 1024 * 6144 + col0 + lane;
        float acc[9];
#pragma unroll
        for (int c = 0; c < 9; ++c) acc[c] = 0.f;
#pragma unroll 8
        for (int k = wave * 128; k < wave * 128 + 128; ++k) { const float wv = w[(size_t)k * 6144];
#pragma unroll
            for (int c = 0; c < 9; ++c) acc[c] += s[c * 1024 + k] * wv; }
#pragma unroll
        for (int c = 0; c < 9; ++c) red[(wave * 9 + c) * 64 + lane] = acc[c];
        __syncthreads();
        for (int i = tid; i < 576; i += NTHREADS) { const int c = i >> 6, col = i & 63; float v = p.b_ada[l * 6144 + col0 + col];
#pragma unroll
            for (int w8 = 0; w8 < 8; ++w8) v += red[(w8 * 9 + c) * 64 + col];
            ada[(size_t)(l * 9 + c) * 6144 + col0 + col] = v; }
        __syncthreads();
    }
}
__device__ __forceinline__ void prep_phase(const Params& p, float* lds) {
    adaln_phase(p, lds);
    __syncthreads();
    for (int l = 0; l < 2; ++l) {
        u16* wb = (u16*)(p.ws + WS_W + (size_t)l * W_LAYER);
        wprep(l == 0 ? p.ssd_w_in : p.gdn_w_in, wb + W_IN / 2, 1024, 6208, NINP, lds);
        wprep(l == 0 ? p.ssd_w_out : p.gdn_w_out, wb + W_OUT / 2, 2048, 1024, 1024, lds);
        wprep(p.ffn_w_up + (size_t)l * 1024 * FF2, wb + W_UP / 2, 1024, FF2, FF2, lds);
        wprep(p.ffn_w_down + (size_t)l * FF * 1024, wb + W_DN / 2, FF, 1024, 1024, lds);
    }
}
__device__ __forceinline__ void mod0_phase(const Params& p) {
    const float* ada = (const float*)(p.ws + WS_ADA); u16* H = (u16*)(p.ws + WS_H);
    for (size_t i = (size_t)blockIdx.x * NTHREADS + otid(); i < (size_t)T_ALL * 256; i += (size_t)gridDim.x * NTHREADS) {
        const int t = (int)(i >> 8), c = (int)(i & 255) * 4;
        const float4 x = *(const float4*)(xin_row(p, t) + c);
        const float* a = ada + (size_t)cond_of(t) * 6144;
        const float4 sh = *(const float4*)(a + c), sc = *(const float4*)(a + 1024 + c);
        uint2 w; w.x = pk2(x.x * (1.f + sc.x) + sh.x, x.y * (1.f + sc.y) + sh.y); w.y = pk2(x.z * (1.f + sc.z) + sh.z, x.w * (1.f + sc.w) + sh.w);
        *(uint2*)(H + (size_t)t * D + c) = w;
    }
}
__device__ __forceinline__ void conv8(const u16* r1, int rs, bool hm, bool hp, const float* w, int wstride, float* o) {
    const uint4 z = {0u, 0u, 0u, 0u};
    const uint4 v0 = hm ? *(const uint4*)(r1 - rs) : z, v1 = *(const uint4*)r1, v2 = hp ? *(const uint4*)(r1 + rs) : z;
    float a0[8], a1[8], a2[8]; unpack8(v0, a0); unpack8(v1, a1); unpack8(v2, a2);
    float w0[8], w1[8], w2[8];
    *(float4*)w0 = *(const float4*)w; *(float4*)(w0 + 4) = *(const float4*)(w + 4);
    *(float4*)w1 = *(const float4*)(w + wstride); *(float4*)(w1 + 4) = *(const float4*)(w + wstride + 4);
    *(float4*)w2 = *(const float4*)(w + 2 * wstride); *(float4*)(w2 + 4) = *(const float4*)(w + 2 * wstride + 4);
#pragma unroll
    for (int j = 0; j < 8; ++j) o[j] = w0[j] * a0[j] + w1[j] * a1[j] + w2[j] * a2[j];
}
__device__ __forceinline__ void conv4(const u16* r1, int rs, bool hm, bool hp, const float* w, int wstride, float* o) {
    const uint2 z = {0u, 0u};
    const uint2 v0 = hm ? *(const uint2*)(r1 - rs) : z, v1 = *(const uint2*)r1, v2 = hp ? *(const uint2*)(r1 + rs) : z;
    float a0[4], a1[4], a2[4]; unpack4(v0, a0); unpack4(v1, a1); unpack4(v2, a2);
    const float4 w0 = *(const float4*)w, w1 = *(const float4*)(w + wstride), w2 = *(const float4*)(w + 2 * wstride);
    o[0] = w0.x * a0[0] + w1.x * a1[0] + w2.x * a2[0]; o[1] = w0.y * a0[1] + w1.y * a1[1] + w2.y * a2[1];
    o[2] = w0.z * a0[2] + w1.z * a1[2] + w2.z * a2[2]; o[3] = w0.w * a0[3] + w1.w * a1[3] + w2.w * a2[3];
}
__device__ __forceinline__ void ssd_scan_phase(const Params& p, int g, float* lds) {
    const int tid = otid(), wave = tid >> 6, lane = tid & 63;
    const int L = g == 0 ? 256 : 2048, nseq = g == 0 ? 32 : 4, nitems = nseq * 64;
    float* Bs = lds; float* Cs = lds + 4096; float* xs = lds + 8192; float* ybuf = lds + 10240; float* dts = lds + 12288; float* dAs = lds + 12320;
    const u16* P = (const u16*)(p.ws + WS_P);
    const int tok = tid >> 4, cgi = tid & 15;
    const int pl = lane >> 3, ng = lane & 7, pp = wave * 8 + pl;
    for (int item = blockIdx.x; item < nitems; item += gridDim.x) {
        const int d = item & 1, h = (item >> 1) & 31, seq = item >> 6, grp = h >> 2;
        const int row0 = seq * L;
        const float a_neg = -__expf(p.ssd_a_log[d * 32 + h]), dtb = p.ssd_dt_bias[d * 32 + h], dskip = d == 0 ? p.ssd_d[h] : 0.f;
        float S[16];
        if (g == 0) {
#pragma unroll
            for (int i = 0; i < 16; ++i) S[i] = 0.f;
        } else {
            const float* s0 = (d ? p.st_ssd_b : p.st_ssd_f) + ((size_t)(((g - 1) * 4 + seq) * 32 + h) * 64 + pp) * 128;
#pragma unroll
            for (int i = 0; i < 4; ++i) { const float4 v = *(const float4*)(s0 + 32 * i + 4 * ng); S[4 * i] = v.x; S[4 * i + 1] = v.y; S[4 * i + 2] = v.z; S[4 * i + 3] = v.w; }
        }
        const int chx = h * 64 + cgi * 4, chb = 2048 + grp * 128 + cgi * 8, chc = 3072 + grp * 128 + cgi * 8;
        u16* ydst = (u16*)(p.ws + (d ? WS_YB : WS_G));
        for (int tile = 0; tile < L / 32; ++tile) {
            const int sidx = tile * 32 + tok; const int tp = d ? L - 1 - sidx : sidx;
            {
                const u16* r1 = P + (size_t)(row0 + tp) * NINP + 2048;
                const bool hm = tp > 0, hp = tp < L - 1;
                float o4[4]; conv4(r1 + chx, NINP, hm, hp, p.ssd_conv_w + chx, 4096, o4);
                const float4 bx = *(const float4*)(p.ssd_conv_b + chx);
                float4 xo; xo.x = siluf(o4[0] + bx.x); xo.y = siluf(o4[1] + bx.y); xo.z = siluf(o4[2] + bx.z); xo.w = siluf(o4[3] + bx.w);
                *(float4*)(xs + tok * 64 + cgi * 4) = xo;
                float o8[8], bb[8];
                conv8(r1 + chb, NINP, hm, hp, p.ssd_conv_w + chb, 4096, o8);
                *(float4*)bb = *(const float4*)(p.ssd_conv_b + chb); *(float4*)(bb + 4) = *(const float4*)(p.ssd_conv_b + chb + 4);
#pragma unroll
                for (int j = 0; j < 8; ++j) o8[j] = siluf(o8[j] + bb[j]);
                *(float4*)(Bs + tok * 128 + cgi * 8) = *(float4*)o8; *(float4*)(Bs + tok * 128 + cgi * 8 + 4) = *(float4*)(o8 + 4);
                conv8(r1 + chc, NINP, hm, hp, p.ssd_conv_w + chc, 4096, o8);
                *(float4*)bb = *(const float4*)(p.ssd_conv_b + chc); *(float4*)(bb + 4) = *(const float4*)(p.ssd_conv_b + chc + 4);
#pragma unroll
                for (int j = 0; j < 8; ++j) o8[j] = siluf(o8[j] + bb[j]);
                *(float4*)(Cs + tok * 128 + cgi * 8) = *(float4*)o8; *(float4*)(Cs + tok * 128 + cgi * 8 + 4) = *(float4*)(o8 + 4);
                if (cgi == 0) { const float raw = bf2f(P[(size_t)(row0 + tp) * NINP + 6144 + d * 32 + h]); const float dt = softplusf(raw + dtb); dts[tok] = dt; dAs[tok] = __expf(dt * a_neg); }
            }
            __syncthreads();
            for (int tt = 0; tt < 32; ++tt) {
                const float dA = dAs[tt], x = xs[tt * 64 + pp]; const float xdt = x * dts[tt];
                float acc = 0.f;
#pragma unroll
                for (int i = 0; i < 4; ++i) {
                    const float4 b = *(const float4*)(Bs + tt * 128 + 32 * i + 4 * ng), c = *(const float4*)(Cs + tt * 128 + 32 * i + 4 * ng);
                    S[4 * i] = S[4 * i] * dA + xdt * b.x; S[4 * i + 1] = S[4 * i + 1] * dA + xdt * b.y; S[4 * i + 2] = S[4 * i + 2] * dA + xdt * b.z; S[4 * i + 3] = S[4 * i + 3] * dA + xdt * b.w;
                    acc += S[4 * i] * c.x + S[4 * i + 1] * c.y + S[4 * i + 2] * c.z + S[4 * i + 3] * c.w;
                }
                acc += __shfl_xor(acc, 1); acc += __shfl_xor(acc, 2); acc += __shfl_xor(acc, 4);
                if (ng == 0) ybuf[tt * 64 + pp] = acc + dskip * x;
            }
            __syncthreads();
            {   const float4 y = *(const float4*)(ybuf + tok * 64 + cgi * 4); uint2 w; w.x = pk2(y.x, y.y); w.y = pk2(y.z, y.w);
                *(uint2*)(ydst + (size_t)(row0 + tp) * DI + h * 64 + cgi * 4) = w; }
        }
        if (g == 0) {
            float* so = p.out + (d ? OUT_SSD_B : OUT_SSD_F) + ((size_t)(seq * 32 + h) * 64 + pp) * 128;
#pragma unroll
            for (int i = 0; i < 4; ++i) { float4 v; v.x = S[4 * i]; v.y = S[4 * i + 1]; v.z = S[4 * i + 2]; v.w = S[4 * i + 3]; *(float4*)(so + 32 * i + 4 * ng) = v; }
        }
        __syncthreads();
    }
}

typedef pg8::bf16x8 bfx8; typedef pg8::f32x4 fx4;
__device__ __forceinline__ fx4 mma16(bfx8 a, bfx8 b, fx4 c) { return __builtin_amdgcn_mfma_f32_16x16x32_bf16(a, b, c, 0, 0, 0); }
__device__ __forceinline__ uint2 pack4v(fx4 v) { uint2 r; r.x = pk2(v[0], v[1]); r.y = pk2(v[2], v[3]); return r; }
__device__ __forceinline__ void ssd_scan_mfma(const Params& p, int g, unsigned char* lds) {
    const int tid = otid(), wave = tid >> 6, lane = tid & 63, fr = lane & 15, fq = lane >> 4;
    const int L = g == 0 ? 256 : 2048, nseq = g == 0 ? 32 : 4, nitems = nseq * 64, nchunk = L / 64;
    u16* Cs = (u16*)lds; u16* Bs = Cs + 64 * 144; u16* BT = Bs + 64 * 144; u16* XT = BT + 128 * 80; u16* XwT = XT + 64 * 80; u16* Ms = XwT + 64 * 80; u16* Sb = Ms + 64 * 80;
    float* cum = (float*)(Sb + 64 * 144); float* dtv = cum + 64; float* wgt = cum + 128; float* ecum = cum + 192; float* misc = cum + 256;
    const u16* P = (const u16*)(p.ws + WS_P);
    for (int item0 = ((gridDim.x & 7) == 0 ? (int)((blockIdx.x & 7) * (gridDim.x >> 3) + (blockIdx.x >> 3)) : (int)blockIdx.x); item0 < nitems; item0 += gridDim.x) {
        const int item = item0;
        const int d = item & 1, h = (item >> 1) & 31, seq = item >> 6, grp = h >> 2;
        const int row0 = seq * L;
        const float a_neg = -__expf(p.ssd_a_log[d * 32 + h]), dtb = p.ssd_dt_bias[d * 32 + h], dskip = p.ssd_d[h];
        fx4 st[4];
        const int n0 = wave * 16 + 4 * fq;
#pragma unroll
        for (int pt = 0; pt < 4; ++pt) {
            if (g == 0) st[pt] = (fx4){0.f, 0.f, 0.f, 0.f};
            else st[pt] = *(const fx4*)((d ? p.st_ssd_b : p.st_ssd_f) + ((size_t)(((g - 1) * 4 + seq) * 32 + h) * 64 + pt * 16 + fr) * 128 + n0);
            *(uint2*)(Sb + (pt * 16 + fr) * 144 + n0) = pack4v(st[pt]);
        }
        const int oc = tid & 31, tq = tid >> 5; const int cha = (oc < 16 ? 2048 + grp * 128 + oc * 8 : 3072 + grp * 128 + (oc - 16) * 8);
        float wa0[8], wa1[8], wa2[8], ba[8];
        *(float4*)wa0 = *(const float4*)(p.ssd_conv_w + cha); *(float4*)(wa0 + 4) = *(const float4*)(p.ssd_conv_w + cha + 4);
        *(float4*)wa1 = *(const float4*)(p.ssd_conv_w + 4096 + cha); *(float4*)(wa1 + 4) = *(const float4*)(p.ssd_conv_w + 4096 + cha + 4);
        *(float4*)wa2 = *(const float4*)(p.ssd_conv_w + 8192 + cha); *(float4*)(wa2 + 4) = *(const float4*)(p.ssd_conv_w + 8192 + cha + 4);
        *(float4*)ba = *(const float4*)(p.ssd_conv_b + cha); *(float4*)(ba + 4) = *(const float4*)(p.ssd_conv_b + cha + 4);
        const int cx = h * 64 + (tid & 63);
        const float wx0 = p.ssd_conv_w[cx], wx1 = p.ssd_conv_w[4096 + cx], wx2 = p.ssd_conv_w[8192 + cx], bx = p.ssd_conv_b[cx];
        u16* ydst = (u16*)(p.ws + (d ? WS_YB : WS_G));
        uint4 pa[6]; unsigned px[10]; unsigned pdt = 0;
#define SSD_PREFETCH(T0) do { const int _t0 = (T0); \
            _Pragma("unroll") for (int k = 0; k < 6; ++k) { const int tp = _t0 + tq * 4 - 1 + k; \
                pa[k] = (tp >= 0 && tp < L) ? *(const uint4*)(P + (size_t)(row0 + tp) * NINP + 2048 + cha) : make_uint4(0u, 0u, 0u, 0u); } \
            _Pragma("unroll") for (int k = 0; k < 10; ++k) { const int tp = _t0 + (tid >> 6) * 8 - 1 + k; \
                px[k] = (tp >= 0 && tp < L) ? (unsigned)P[(size_t)(row0 + tp) * NINP + 2048 + cx] : 0u; } \
            if (wave == 0) pdt = (unsigned)P[(size_t)(row0 + _t0 + lane) * NINP + 6144 + d * 32 + h]; } while (0)
        SSD_PREFETCH((d ? nchunk - 1 : 0) * 64);
        for (int ci = 0; ci < nchunk; ++ci) {
            const int t0 = (d ? nchunk - 1 - ci : ci) * 64;
            if (wave == 0) {
                const float raw = bf2f((u16)pdt);
                const float dt = softplusf(raw + dtb), la = dt * a_neg;
                const float c = wave_prefix_sum(la);
                const float tot = wave_last(c);
                const float cm = d ? (tot - c + la) : c;
                cum[lane] = cm; dtv[lane] = dt; ecum[lane] = __expf(cm); wgt[lane] = dt * __expf(tot - cm);
                if (lane == 0) misc[0] = __expf(tot);
            }
            __syncthreads();
            {
                float rw[6][8];
#pragma unroll
                for (int k = 0; k < 6; ++k) unpack8(pa[k], rw[k]);
#pragma unroll
                for (int m = 0; m < 4; ++m) { float o[8];
#pragma unroll
                    for (int k = 0; k < 8; ++k) o[k] = siluf(wa0[k] * rw[m][k] + wa1[k] * rw[m + 1][k] + wa2[k] * rw[m + 2][k] + ba[k]);
                    *(uint4*)((oc < 16 ? Bs : Cs) + (tq * 4 + m) * 144 + (oc & 15) * 8) = pack8(o); }
            }
            {
                const int c = tid & 63, j0 = (tid >> 6) * 8;
                float o[8], ow[8];
#pragma unroll
                for (int k = 0; k < 8; ++k) { o[k] = siluf(wx0 * bf2f((u16)px[k]) + wx1 * bf2f((u16)px[k + 1]) + wx2 * bf2f((u16)px[k + 2]) + bx); ow[k] = o[k] * wgt[j0 + k]; }
                *(uint4*)(XT + c * 80 + j0) = pack8(o); *(uint4*)(XwT + c * 80 + j0) = pack8(ow);
            }
            __syncthreads();
            if (ci + 1 < nchunk) SSD_PREFETCH((d ? nchunk - 2 - ci : ci + 1) * 64);
#pragma unroll
            for (int it = 0; it < 2; ++it) {
                const int n = tid & 127, j0 = ((tid >> 7) + 4 * it) * 8;
                uint4 w; unsigned e[8];
#pragma unroll
                for (int k = 0; k < 8; ++k) e[k] = Bs[(j0 + k) * 144 + n];
                w.x = e[0] | (e[1] << 16); w.y = e[2] | (e[3] << 16); w.z = e[4] | (e[5] << 16); w.w = e[6] | (e[7] << 16);
                *(uint4*)(BT + n * 80 + j0) = w;
            }
#pragma unroll
            for (int tt = 0; tt < 2; ++tt) {
                const int id = wave * 2 + tt, jt = id >> 2, it = id & 3;
                fx4 acc = {0.f, 0.f, 0.f, 0.f};
#pragma unroll
                for (int ks = 0; ks < 4; ++ks) acc = mma16(*(const bfx8*)(Bs + (jt * 16 + fr) * 144 + ks * 32 + fq * 8), *(const bfx8*)(Cs + (it * 16 + fr) * 144 + ks * 32 + fq * 8), acc);
                asm volatile("s_nop 15" : "+v"(acc));
                const int i = it * 16 + fr; const float cmi = cum[i];
                const fx4 cj = *(const fx4*)(cum + jt * 16 + 4 * fq), dj = *(const fx4*)(dtv + jt * 16 + 4 * fq);
                fx4 m;
#pragma unroll
                for (int r = 0; r < 4; ++r) { const int j = jt * 16 + 4 * fq + r; const bool valid = d ? (j >= i) : (j <= i);
                    const float e = __expf(valid ? cmi - cj[r] : 0.f) * dj[r]; m[r] = valid ? acc[r] * e : 0.f; }
                *(uint2*)(Ms + i * 80 + jt * 16 + 4 * fq) = pack4v(m);
            }
            __syncthreads();
#pragma unroll
            for (int tt = 0; tt < 2; ++tt) {
                const int id = wave * 2 + tt, pt = id >> 2, it = id & 3;
                fx4 acc = {0.f, 0.f, 0.f, 0.f};
#pragma unroll
                for (int ks = 0; ks < 4; ++ks) acc = mma16(*(const bfx8*)(Sb + (pt * 16 + fr) * 144 + ks * 32 + fq * 8), *(const bfx8*)(Cs + (it * 16 + fr) * 144 + ks * 32 + fq * 8), acc);
                asm volatile("s_nop 15" : "+v"(acc));
                const int i = it * 16 + fr; const float e = ecum[i];
                acc *= e;
#pragma unroll
                for (int ks = 0; ks < 2; ++ks) acc = mma16(*(const bfx8*)(XT + (pt * 16 + fr) * 80 + ks * 32 + fq * 8), *(const bfx8*)(Ms + (it * 16 + fr) * 80 + ks * 32 + fq * 8), acc);
                asm volatile("s_nop 15" : "+v"(acc));
                if (d == 0) {
#pragma unroll
                    for (int r = 0; r < 4; ++r) acc[r] += dskip * bf2f(XT[(pt * 16 + 4 * fq + r) * 80 + i]);
                }
                *(uint2*)(ydst + (size_t)(row0 + t0 + i) * DI + h * 64 + pt * 16 + 4 * fq) = pack4v(acc);
            }
            {
                const float cd = misc[0];
#pragma unroll
                for (int pt = 0; pt < 4; ++pt) {
                    st[pt] *= cd;
#pragma unroll
                    for (int ks = 0; ks < 2; ++ks) st[pt] = mma16(*(const bfx8*)(BT + (wave * 16 + fr) * 80 + ks * 32 + fq * 8), *(const bfx8*)(XwT + (pt * 16 + fr) * 80 + ks * 32 + fq * 8), st[pt]);
                    asm volatile("s_nop 15" : "+v"(st[pt]));
                }
            }
            __syncthreads();
#pragma unroll
            for (int pt = 0; pt < 4; ++pt) *(uint2*)(Sb + (pt * 16 + fr) * 144 + n0) = pack4v(st[pt]);
        }
        if (g == 0) {
#pragma unroll
            for (int pt = 0; pt < 4; ++pt) *(fx4*)(p.out + (d ? OUT_SSD_B : OUT_SSD_F) + ((size_t)(seq * 32 + h) * 64 + pt * 16 + fr) * 128 + n0) = st[pt];
        }
        __syncthreads();
    }
}
__device__ __forceinline__ void ssd_combine_phase(const Params& p) {
    const int tid = otid(), wave = tid >> 6, lane = tid & 63;
    u16* YF = (u16*)(p.ws + WS_G); const u16* YB = (const u16*)(p.ws + WS_YB); const u16* P = (const u16*)(p.ws + WS_P);
    for (int row = blockIdx.x * 8 + wave; row < TG; row += gridDim.x * 8) {
        float gv[32]; float ss = 0.f;
#pragma unroll
        for (int i = 0; i < 4; ++i) { const int c = i * 512 + lane * 8;
            float a[8], b[8], z[8]; unpack8(ldnt16(YF + (size_t)row * DI + c), a); unpack8(ldnt16(YB + (size_t)row * DI + c), b); unpack8(ldnt16(P + (size_t)row * NINP + c), z);
#pragma unroll
            for (int j = 0; j < 8; ++j) { const float v = (a[j] + b[j]) * siluf(z[j]); gv[i * 8 + j] = v; ss += v * v; } }
        ss = wave_sum(ss);
        const float r = rsqrtf(ss * (1.f / 2048.f) + 1e-6f);
#pragma unroll
        for (int i = 0; i < 4; ++i) { const int c = i * 512 + lane * 8; float nw[8], o[8];
            *(float4*)nw = *(const float4*)(p.ssd_norm_w + c); *(float4*)(nw + 4) = *(const float4*)(p.ssd_norm_w + c + 4);
#pragma unroll
            for (int j = 0; j < 8; ++j) o[j] = gv[i * 8 + j] * r * nw[j];
            *(uint4*)(YF + (size_t)row * DI + c) = pack8(o); }
    }
}
__device__ __forceinline__ void gdn_scan_phase(const Params& p, int g, float* lds) {
    const int tid = otid(), wave = tid >> 6, lane = tid & 63;
    const int L = g == 0 ? 256 : 2048, nseq = g == 0 ? 32 : 4, nitems = nseq * 64;
    float* qs = lds; float* ks = lds + 4096; float* vs = lds + 8192; float* obuf = lds + 10240; float* egs = lds + 12288; float* betas = lds + 12320; float* kqs = lds + 12352;
    const u16* P = (const u16*)(p.ws + WS_P);
    const int tok = tid >> 4, cgi = tid & 15;
    const int dvl = lane >> 3, dkg = lane & 7, dv = wave * 8 + dvl;
    for (int item = blockIdx.x; item < nitems; item += gridDim.x) {
        const int e = item & 1, d = (item >> 1) & 1, hv = (item >> 2) & 15, seq = item >> 6, kh = hv >> 1;
        const int row0 = seq * L;
        const float a_neg = -__expf(p.gdn_a_log[d * 16 + hv]), dtb = p.gdn_dt_bias[d * 16 + hv];
        float S[16];
        if (g == 0) {
#pragma unroll
            for (int i = 0; i < 16; ++i) S[i] = 0.f;
        } else {
            const float* s0 = (d ? p.st_gdn_b : p.st_gdn_f) + (size_t)(((g - 1) * 4 + seq) * 16 + hv) * 16384 + e * 64 + dv;
#pragma unroll
            for (int i = 0; i < 4; ++i)
#pragma unroll
                for (int j = 0; j < 4; ++j) S[4 * i + j] = s0[(size_t)(32 * i + 4 * dkg + j) * 128];
        }
        const int chq = kh * 128 + cgi * 8, chk = 1024 + kh * 128 + cgi * 8, chv = 2048 + hv * 128 + e * 64 + cgi * 4;
        u16* odst = (u16*)(p.ws + (d ? WS_YB : WS_G));
        for (int tile = 0; tile < L / 32; ++tile) {
            const int sidx = tile * 32 + tok; const int tp = d ? L - 1 - sidx : sidx;
            {
                const u16* r1 = P + (size_t)(row0 + tp) * NINP;
                const bool hm = tp > 0, hp = tp < L - 1;
                float q8[8], k8[8], v4[4];
                conv8(r1 + chq, NINP, hm, hp, p.gdn_conv_w + chq, 4096, q8);
                conv8(r1 + chk, NINP, hm, hp, p.gdn_conv_w + chk, 4096, k8);
                conv4(r1 + chv, NINP, hm, hp, p.gdn_conv_w + chv, 4096, v4);
                float sq = 0.f, sk = 0.f;
#pragma unroll
                for (int j = 0; j < 8; ++j) { q8[j] = siluf(q8[j]); k8[j] = siluf(k8[j]); sq += q8[j] * q8[j]; sk += k8[j] * k8[j]; }
                sq += __shfl_xor(sq, 1); sq += __shfl_xor(sq, 2); sq += __shfl_xor(sq, 4); sq += __shfl_xor(sq, 8);
                sk += __shfl_xor(sk, 1); sk += __shfl_xor(sk, 2); sk += __shfl_xor(sk, 4); sk += __shfl_xor(sk, 8);
                const float rq = rsqrtf(sq + 1e-6f) * 0.08838834764831845f, rk = rsqrtf(sk + 1e-6f);
                float kq = 0.f;
#pragma unroll
                for (int j = 0; j < 8; ++j) { q8[j] *= rq; k8[j] *= rk; kq += q8[j] * k8[j]; }
                kq += __shfl_xor(kq, 1); kq += __shfl_xor(kq, 2); kq += __shfl_xor(kq, 4); kq += __shfl_xor(kq, 8);
                *(float4*)(qs + tok * 128 + cgi * 8) = *(float4*)q8; *(float4*)(qs + tok * 128 + cgi * 8 + 4) = *(float4*)(q8 + 4);
                *(float4*)(ks + tok * 128 + cgi * 8) = *(float4*)k8; *(float4*)(ks + tok * 128 + cgi * 8 + 4) = *(float4*)(k8 + 4);
                float4 vo; vo.x = siluf(v4[0]); vo.y = siluf(v4[1]); vo.z = siluf(v4[2]); vo.w = siluf(v4[3]);
                *(float4*)(vs + tok * 64 + cgi * 4) = vo;
                if (cgi == 0) {
                    const float a_raw = bf2f(r1[6144 + d * 16 + hv]), b_raw = bf2f(r1[6176 + d * 16 + hv]);
                    egs[tok] = __expf(a_neg * softplusf(a_raw + dtb)); betas[tok] = 1.f / (1.f + __expf(-b_raw)); kqs[tok] = kq;
                }
            }
            __syncthreads();
            for (int tt = 0; tt < 32; ++tt) {
                const float eg = egs[tt], be = betas[tt], kq = kqs[tt], v = vs[tt * 64 + dv];
                float kk[16]; float u = 0.f, w = 0.f;
#pragma unroll
                for (int i = 0; i < 4; ++i) {
                    const float4 k4 = *(const float4*)(ks + tt * 128 + 32 * i + 4 * dkg), q4 = *(const float4*)(qs + tt * 128 + 32 * i + 4 * dkg);
                    kk[4 * i] = k4.x; kk[4 * i + 1] = k4.y; kk[4 * i + 2] = k4.z; kk[4 * i + 3] = k4.w;
                    u += S[4 * i] * k4.x + S[4 * i + 1] * k4.y + S[4 * i + 2] * k4.z + S[4 * i + 3] * k4.w;
                    w += S[4 * i] * q4.x + S[4 * i + 1] * q4.y + S[4 * i + 2] * q4.z + S[4 * i + 3] * q4.w;
                }
                u += __shfl_xor(u, 1); w += __shfl_xor(w, 1); u += __shfl_xor(u, 2); w += __shfl_xor(w, 2); u += __shfl_xor(u, 4); w += __shfl_xor(w, 4);
                const float delta = be * (v - eg * u);
#pragma unroll
                for (int i = 0; i < 16; ++i) S[i] = S[i] * eg + kk[i] * delta;
                if (dkg == 0) obuf[tt * 64 + dv] = eg * w + delta * kq;
            }
            __syncthreads();
            {   const float4 y = *(const float4*)(obuf + tok * 64 + cgi * 4); uint2 w; w.x = pk2(y.x, y.y); w.y = pk2(y.z, y.w);
                *(uint2*)(odst + (size_t)(row0 + tp) * DI + hv * 128 + e * 64 + cgi * 4) = w; }
        }
        if (g == 0) {
            float* so = p.out + (d ? OUT_GDN_B : OUT_GDN_F) + (size_t)(seq * 16 + hv) * 16384 + e * 64 + dv;
#pragma unroll
            for (int i = 0; i < 4; ++i)
#pragma unroll
                for (int j = 0; j < 4; ++j) so[(size_t)(32 * i + 4 * dkg + j) * 128] = S[4 * i + j];
        }
        __syncthreads();
    }
}

__device__ __forceinline__ void gdn_scan_mfma(const Params& p, int g, unsigned char* lds) {
    const int tid = otid(), wave = tid >> 6, lane = tid & 63, fr = lane & 15, fq = lane >> 4;
    const int L = g == 0 ? 256 : 2048, nseq = g == 0 ? 32 : 4, nitems = nseq * 64, nchunk = L / 64;
    float* R32 = (float*)lds; float* Adg = R32 + 64 * 64; u16* VnT = (u16*)(Adg + 64 * 20); u16* QKm = VnT + 64 * 80; u16* Abf = QKm + 64 * 80; u16* TB = Abf + 64 * 80; u16* RT = TB + 64 * 40;
    float* cum = (float*)(RT + 64 * 40); float* ecum = cum + 64; float* beta = cum + 128; float* edec = cum + 192; float* misc = cum + 256;
    u16* Kn = (u16*)(cum + 320); u16* Qn = Kn + 64 * 144; u16* KdT = Qn + 64 * 144; u16* ST = KdT + 128 * 80;
    const u16* P = (const u16*)(p.ws + WS_P);
    const int tok = tid >> 4, cgi = tid & 15;
    for (int item0 = ((gridDim.x & 7) == 0 ? (int)((blockIdx.x & 7) * (gridDim.x >> 3) + (blockIdx.x >> 3)) : (int)blockIdx.x); item0 < nitems; item0 += gridDim.x) {
        const int item = item0;
        const int e = item & 1, d = (item >> 1) & 1, hv = (item >> 2) & 15, seq = item >> 6, kh = hv >> 1;
        const int row0 = seq * L;
        const float a_neg = -__expf(p.gdn_a_log[d * 16 + hv]), dtb = p.gdn_dt_bias[d * 16 + hv];
        fx4 st[4];
        const int dk0 = wave * 16 + 4 * fq;
#pragma unroll
        for (int pt = 0; pt < 4; ++pt) {
            if (g == 0) st[pt] = (fx4){0.f, 0.f, 0.f, 0.f};
            else { const float* s0 = (d ? p.st_gdn_b : p.st_gdn_f) + (size_t)(((g - 1) * 4 + seq) * 16 + hv) * 16384 + e * 64 + pt * 16 + fr;
#pragma unroll
                for (int r = 0; r < 4; ++r) st[pt][r] = s0[(size_t)(dk0 + r) * 128]; }
            *(uint2*)(ST + (pt * 16 + fr) * 144 + dk0) = pack4v(st[pt]);
        }
        for (int z = tid; z < 640; z += NTHREADS) ((uint4*)TB)[z] = make_uint4(0u, 0u, 0u, 0u);
        u16* odst = (u16*)(p.ws + (d ? WS_YB : WS_G));
        uint4 pq[4], pk[4]; uint2 pv[4]; unsigned pa_raw = 0, pb_raw = 0;
#define GDN_PREFETCH(T0) do { const int _t0 = (T0); const int _tok = tid >> 4, _cg = tid & 15; \
            const int _tpl = d ? _t0 + 62 - 2 * _tok : _t0 + 2 * _tok; \
            _Pragma("unroll") for (int k = 0; k < 4; ++k) { const int tp = _tpl - 1 + k; const bool ok = tp >= 0 && tp < L; const u16* r1 = P + (size_t)(row0 + tp) * NINP; \
                pq[k] = ok ? *(const uint4*)(r1 + kh * 128 + _cg * 8) : make_uint4(0u, 0u, 0u, 0u); \
                pk[k] = ok ? *(const uint4*)(r1 + 1024 + kh * 128 + _cg * 8) : make_uint4(0u, 0u, 0u, 0u); \
                pv[k] = ok ? *(const uint2*)(r1 + 2048 + hv * 128 + e * 64 + _cg * 4) : make_uint2(0u, 0u); } \
            if ((tid >> 6) == 0) { const int tp = d ? _t0 + 63 - (tid & 63) : _t0 + (tid & 63); const u16* r1 = P + (size_t)(row0 + tp) * NINP; \
                pa_raw = (unsigned)r1[6144 + d * 16 + hv]; pb_raw = (unsigned)r1[6176 + d * 16 + hv]; } } while (0)
        GDN_PREFETCH((d ? nchunk - 1 : 0) * 64);
        float wq[3][8], wk[3][8], wv[3][4];
        { const int _cg = tid & 15; const int chq = kh * 128 + _cg * 8, chk = 1024 + kh * 128 + _cg * 8, chv = 2048 + hv * 128 + e * 64 + _cg * 4;
#pragma unroll
          for (int t = 0; t < 3; ++t) {
            *(float4*)wq[t] = *(const float4*)(p.gdn_conv_w + t * 4096 + chq); *(float4*)(wq[t] + 4) = *(const float4*)(p.gdn_conv_w + t * 4096 + chq + 4);
            *(float4*)wk[t] = *(const float4*)(p.gdn_conv_w + t * 4096 + chk); *(float4*)(wk[t] + 4) = *(const float4*)(p.gdn_conv_w + t * 4096 + chk + 4);
            *(float4*)wv[t] = *(const float4*)(p.gdn_conv_w + t * 4096 + chv); } }
        for (int ci = 0; ci < nchunk; ++ci) {
            const int t0 = (d ? nchunk - 1 - ci : ci) * 64;
            const int tid = otid(), wave = tid >> 6, lane = tid & 63, fr = lane & 15, fq = lane >> 4, tok = tid >> 4, cgi = tid & 15, dk0 = wave * 16 + 4 * fq;
            int lz = 0; asm volatile("" : "+v"(lz));
            unsigned char* lb = lds + lz;
            float* R32 = (float*)lb; float* Adg = R32 + 64 * 64; u16* VnT = (u16*)(Adg + 64 * 20); u16* QKm = VnT + 64 * 80; u16* Abf = QKm + 64 * 80; u16* TB = Abf + 64 * 80; u16* RT = TB + 64 * 40;
            float* cum = (float*)(RT + 64 * 40); float* ecum = cum + 64; float* beta = cum + 128; float* edec = cum + 192; float* misc = cum + 256;
            u16* Kn = (u16*)(cum + 320); u16* Qn = Kn + 64 * 144; u16* KdT = Qn + 64 * 144; u16* ST = KdT + 128 * 80;
            const int chq = kh * 128 + cgi * 8, chk = 1024 + kh * 128 + cgi * 8, chv = 2048 + hv * 128 + e * 64 + cgi * 4;
            if (wave == 0) {
                const float a_raw = bf2f((u16)pa_raw), b_raw = bf2f((u16)pb_raw);
                const float c = wave_prefix_sum(a_neg * softplusf(a_raw + dtb));
                const float tot = wave_last(c);
                cum[lane] = c; ecum[lane] = __expf(c); beta[lane] = __builtin_amdgcn_rcpf(1.f + __expf(-b_raw)); edec[lane] = __expf(tot - c);
                if (lane == 0) misc[0] = __expf(tot);
            }
            __syncthreads();
            for (int z = tid; z < 640; z += NTHREADS) ((uint4*)VnT)[z] = make_uint4(0u, 0u, 0u, 0u);
            {
                float rq[4][8], rk[4][8], rv[4][4];
#pragma unroll
                for (int k = 0; k < 4; ++k) { unpack8(pq[k], rq[k]); unpack8(pk[k], rk[k]); unpack4(pv[k], rv[k]); }
#pragma unroll
                for (int m = 0; m < 2; ++m) {
                    const int i = (m == 0) ? (d ? 2 * tok + 1 : 2 * tok) : (d ? 2 * tok : 2 * tok + 1);
                    float q8[8], k8[8], v4[4]; float sq = 0.f, sk = 0.f;
#pragma unroll
                    for (int k = 0; k < 8; ++k) { q8[k] = siluf(wq[0][k] * rq[m][k] + wq[1][k] * rq[m + 1][k] + wq[2][k] * rq[m + 2][k]); sq += q8[k] * q8[k];
                        k8[k] = siluf(wk[0][k] * rk[m][k] + wk[1][k] * rk[m + 1][k] + wk[2][k] * rk[m + 2][k]); sk += k8[k] * k8[k]; }
#pragma unroll
                    for (int k = 0; k < 4; ++k) v4[k] = siluf(wv[0][k] * rv[m][k] + wv[1][k] * rv[m + 1][k] + wv[2][k] * rv[m + 2][k]);
                    sq += __shfl_xor(sq, 1); sq += __shfl_xor(sq, 2); sq += __shfl_xor(sq, 4); sq += __shfl_xor(sq, 8);
                    sk += __shfl_xor(sk, 1); sk += __shfl_xor(sk, 2); sk += __shfl_xor(sk, 4); sk += __shfl_xor(sk, 8);
                    const float rqn = rsqrtf(sq + 1e-6f) * 0.08838834764831845f, rkn = rsqrtf(sk + 1e-6f);
#pragma unroll
                    for (int k = 0; k < 8; ++k) { q8[k] *= rqn; k8[k] *= rkn; }
                    *(uint4*)(Qn + i * 144 + cgi * 8) = pack8(q8); *(uint4*)(Kn + i * 144 + cgi * 8) = pack8(k8);
                    const float bi = beta[i];
                    float4 rvv; rvv.x = bi * v4[0]; rvv.y = bi * v4[1]; rvv.z = bi * v4[2]; rvv.w = bi * v4[3];
                    *(float4*)(R32 + i * 64 + cgi * 4) = rvv;
                }
            }
            __syncthreads();
            if (ci + 1 < nchunk) GDN_PREFETCH((d ? nchunk - 2 - ci : ci + 1) * 64);
#pragma unroll
            for (int tt = 0; tt < 2; ++tt) {
                const int id = wave * 2 + tt, jt = id >> 2, it = id & 3;
                fx4 accA = {0.f, 0.f, 0.f, 0.f}, accQ = {0.f, 0.f, 0.f, 0.f};
#pragma unroll
                for (int ks = 0; ks < 4; ++ks) { const bfx8 a = *(const bfx8*)(Kn + (jt * 16 + fr) * 144 + ks * 32 + fq * 8);
                    accA = mma16(a, *(const bfx8*)(Kn + (it * 16 + fr) * 144 + ks * 32 + fq * 8), accA);
                    accQ = mma16(a, *(const bfx8*)(Qn + (it * 16 + fr) * 144 + ks * 32 + fq * 8), accQ); }
                asm volatile("s_nop 15" : "+v"(accA), "+v"(accQ));
                const int i = it * 16 + fr; const float cmi = cum[i], bi = beta[i];
                const fx4 cj = *(const fx4*)(cum + jt * 16 + 4 * fq);
                fx4 mA, mQ;
#pragma unroll
                for (int r = 0; r < 4; ++r) { const int j = jt * 16 + 4 * fq + r;
                    const float dec = __expf(j <= i ? cmi - cj[r] : 0.f);
                    mA[r] = j < i ? bi * accA[r] * dec : 0.f; mQ[r] = j <= i ? accQ[r] * dec : 0.f; }
                *(uint2*)(Abf + i * 80 + jt * 16 + 4 * fq) = pack4v(mA);
                if (jt == it) *(fx4*)(Adg + i * 20 + 4 * fq) = mA;
                *(uint2*)(QKm + i * 80 + jt * 16 + 4 * fq) = pack4v(mQ);
            }
            __syncthreads();
            if (wave == 4) {
                const int tb = lane >> 4, tc = lane & 15;
                float t[16]; float4 nx[4];
#pragma unroll
                for (int j4 = 0; j4 < 1; ++j4) nx[j4] = *(const float4*)(Adg + (tb * 16 + 1) * 20 + j4 * 4);
#pragma unroll
                for (int i = 0; i < 16; ++i) {
                    float4 cu[4];
#pragma unroll
                    for (int j4 = 0; j4 < 4; ++j4) cu[j4] = nx[j4];
                    if (i >= 1 && i < 15) {
#pragma unroll
                        for (int j4 = 0; j4 < (i + 4) / 4; ++j4) nx[j4] = *(const float4*)(Adg + (tb * 16 + i + 1) * 20 + j4 * 4);
                    }
                    float acc = (i == tc) ? 1.f : 0.f;
#pragma unroll
                    for (int j4 = 0; j4 < (i + 3) / 4; ++j4) {
                        const float4 a = cu[j4];
                        if (j4 * 4 + 0 < i) acc -= a.x * t[j4 * 4 + 0];
                        if (j4 * 4 + 1 < i) acc -= a.y * t[j4 * 4 + 1];
                        if (j4 * 4 + 2 < i) acc -= a.z * t[j4 * 4 + 2];
                        if (j4 * 4 + 3 < i) acc -= a.w * t[j4 * 4 + 3];
                    }
                    t[i] = acc;
                    __builtin_amdgcn_sched_barrier(0);
                }
#pragma unroll
                for (int i = 0; i < 16; ++i) TB[(tb * 16 + i) * 40 + tc] = (u16)(pk2(t[i], 0.f) & 0xffffu);
            }
            fx4 oacc[2];
#pragma unroll
            for (int tt = 0; tt < 2; ++tt) {
                const int id = wave * 2 + tt, pt = id >> 2, it = id & 3;
                fx4 accK = {0.f, 0.f, 0.f, 0.f}, accQ = {0.f, 0.f, 0.f, 0.f};
#pragma unroll
                for (int ks = 0; ks < 4; ++ks) { const bfx8 a = *(const bfx8*)(ST + (pt * 16 + fr) * 144 + ks * 32 + fq * 8);
                    accK = mma16(a, *(const bfx8*)(Kn + (it * 16 + fr) * 144 + ks * 32 + fq * 8), accK);
                    accQ = mma16(a, *(const bfx8*)(Qn + (it * 16 + fr) * 144 + ks * 32 + fq * 8), accQ); }
                asm volatile("s_nop 15" : "+v"(accK), "+v"(accQ));
                const int i = it * 16 + fr; const float ei = ecum[i], bei = beta[i] * ei;
                fx4 rr = *(const fx4*)(R32 + i * 64 + pt * 16 + 4 * fq);
                rr -= accK * bei;
                *(fx4*)(R32 + i * 64 + pt * 16 + 4 * fq) = rr;
                oacc[tt] = accQ * ei;
            }
            __syncthreads();
            if (wave >= 4) {
                const int t4 = tid - 256;
#pragma unroll
                for (int it2 = 0; it2 < 4; ++it2) {
                    const int dk = t4 & 127, j0 = ((t4 >> 7) + 2 * it2) * 8;
                    float o[8];
#pragma unroll
                    for (int k = 0; k < 8; ++k) o[k] = bf2f(Kn[(j0 + k) * 144 + dk]) * edec[j0 + k];
                    *(uint4*)(KdT + dk * 80 + j0) = pack8(o);
                }
            }
            if (wave < 4) {
#pragma unroll
                for (int b = 0; b < 4; ++b) {
                    fx4 u = {0.f, 0.f, 0.f, 0.f};
                    if (b > 0) {
#pragma unroll
                        for (int ks = 0; ks < 2; ++ks) u = mma16(*(const bfx8*)(VnT + (wave * 16 + fr) * 80 + ks * 32 + fq * 8), *(const bfx8*)(Abf + (b * 16 + fr) * 80 + ks * 32 + fq * 8), u);
                        asm volatile("s_nop 15" : "+v"(u));
                    }
                    fx4 rr = *(const fx4*)(R32 + (b * 16 + fr) * 64 + wave * 16 + 4 * fq);
                    rr -= u;
#pragma unroll
                    for (int r = 0; r < 4; ++r) RT[(wave * 16 + 4 * fq + r) * 40 + fr] = (u16)(pk2(rr[r], 0.f) & 0xffffu);
                    asm volatile("s_waitcnt lgkmcnt(0)" ::: "memory");
                    fx4 xb = {0.f, 0.f, 0.f, 0.f};
                    xb = mma16(*(const bfx8*)(RT + (wave * 16 + fr) * 40 + fq * 8), *(const bfx8*)(TB + (b * 16 + fr) * 40 + fq * 8), xb);
                    asm volatile("s_nop 15" : "+v"(xb));
#pragma unroll
                    for (int r = 0; r < 4; ++r) VnT[(wave * 16 + 4 * fq + r) * 80 + b * 16 + fr] = (u16)(pk2(xb[r], 0.f) & 0xffffu);
                    asm volatile("s_waitcnt lgkmcnt(0)" ::: "memory");
                }
            }
            __syncthreads();
#pragma unroll
            for (int tt = 0; tt < 2; ++tt) {
                const int id = wave * 2 + tt, pt = id >> 2, it = id & 3;
#pragma unroll
                for (int ks = 0; ks < 2; ++ks) oacc[tt] = mma16(*(const bfx8*)(VnT + (pt * 16 + fr) * 80 + ks * 32 + fq * 8), *(const bfx8*)(QKm + (it * 16 + fr) * 80 + ks * 32 + fq * 8), oacc[tt]);
                asm volatile("s_nop 15" : "+v"(oacc[tt]));
                const int i = it * 16 + fr, tp = d ? t0 + 63 - i : t0 + i;
                *(uint2*)(odst + (size_t)(row0 + tp) * DI + hv * 128 + e * 64 + pt * 16 + 4 * fq) = pack4v(oacc[tt]);
            }
            __syncthreads();
            {
                const float cd = misc[0];
#pragma unroll
                for (int pt = 0; pt < 4; ++pt) {
                    st[pt] *= cd;
#pragma unroll
                    for (int ks = 0; ks < 2; ++ks) st[pt] = mma16(*(const bfx8*)(KdT + (wave * 16 + fr) * 80 + ks * 32 + fq * 8), *(const bfx8*)(VnT + (pt * 16 + fr) * 80 + ks * 32 + fq * 8), st[pt]);
                    asm volatile("s_nop 15" : "+v"(st[pt]));
                }
            }
            __syncthreads();
#pragma unroll
            for (int pt = 0; pt < 4; ++pt) *(uint2*)(ST + (pt * 16 + fr) * 144 + dk0) = pack4v(st[pt]);
        }
        if (g == 0) {
            float* so = p.out + (d ? OUT_GDN_B : OUT_GDN_F) + (size_t)(seq * 16 + hv) * 16384 + e * 64;
#pragma unroll
            for (int pt = 0; pt < 4; ++pt)
#pragma unroll
                for (int r = 0; r < 4; ++r) so[(size_t)(dk0 + r) * 128 + pt * 16 + fr] = st[pt][r];
        }
        __syncthreads();
    }
}
__device__ __forceinline__ void gdn_combine_phase(const Params& p) {
    const int tid = otid(), wave = tid >> 6, lane = tid & 63;
    u16* YF = (u16*)(p.ws + WS_G); const u16* YB = (const u16*)(p.ws + WS_YB); const u16* P = (const u16*)(p.ws + WS_P);
    float nw[8];
    *(float4*)nw = *(const float4*)(p.gdn_norm_w + (lane & 15) * 8); *(float4*)(nw + 4) = *(const float4*)(p.gdn_norm_w + (lane & 15) * 8 + 4);
    for (int row = blockIdx.x * 8 + wave; row < TG; row += gridDim.x * 8) {
#pragma unroll
        for (int i = 0; i < 4; ++i) { const int c = i * 512 + lane * 8;
            float a[8], b[8], z[8], o[8]; unpack8(ldnt16(YF + (size_t)row * DI + c), a); unpack8(ldnt16(YB + (size_t)row * DI + c), b); unpack8(ldnt16(P + (size_t)row * NINP + 4096 + c), z);
            float ss = 0.f;
#pragma unroll
            for (int j = 0; j < 8; ++j) { a[j] += b[j]; ss += a[j] * a[j]; }
            ss += __shfl_xor(ss, 1); ss += __shfl_xor(ss, 2); ss += __shfl_xor(ss, 4); ss += __shfl_xor(ss, 8);
            const float r = rsqrtf(ss * (1.f / 128.f) + 1e-6f);
#pragma unroll
            for (int j = 0; j < 8; ++j) o[j] = a[j] * r * nw[j] * siluf(z[j]);
            *(uint4*)(YF + (size_t)row * DI + c) = pack8(o); }
    }
}
__device__ __forceinline__ void ln_phase(const Params& p, int l, int which, int g, int wg0, int nwg) {
    const int tid = otid(), wave = tid >> 6, lane = tid & 63;
    if ((int)blockIdx.x < wg0) return;
    const u16* O = (const u16*)(p.ws + (which ? WS_YB : WS_P));
    const float* adab = (const float*)(p.ws + WS_ADA); u16* H = (u16*)(p.ws + WS_H);
    const float* lg = p.ln_g + (l * 2 + which) * 1024; const float* lb = p.ln_b + (l * 2 + which) * 1024;
    const bool has_next = !(l == 1 && which == 1);
    for (int row = ((int)blockIdx.x - wg0) * 8 + wave; row < TG; row += nwg * 8) {
        const int t = g * TG + row, cond = cond_of(t);
        const float* xr = (l == 0 && which == 0) ? xin_row(p, t) : p.out + (size_t)t * D;
        const float* ada = adab + (size_t)(l * 9 + cond) * 6144;
        const float* gate = ada + (which ? 5120 : 2048);
        float v[16]; float s = 0.f;
#pragma unroll
        for (int i = 0; i < 4; ++i) { const int c = i * 256 + lane * 4;
            const float4 x = ldnt16f(xr + c), gt = *(const float4*)(gate + c);
            float o0[4], o1[4]; unpack4(ldnt8(O + (size_t)row * D + c), o0); unpack4(ldnt8(O + (size_t)TG * D + (size_t)row * D + c), o1);
            float4 o; o.x = o0[0] + o1[0]; o.y = o0[1] + o1[1]; o.z = o0[2] + o1[2]; o.w = o0[3] + o1[3];
            v[4 * i] = ALPHA * x.x + gt.x * o.x; v[4 * i + 1] = ALPHA * x.y + gt.y * o.y; v[4 * i + 2] = ALPHA * x.z + gt.z * o.z; v[4 * i + 3] = ALPHA * x.w + gt.w * o.w;
            s += v[4 * i] + v[4 * i + 1] + v[4 * i + 2] + v[4 * i + 3]; }
        const float mean = wave_sum(s) * (1.f / 1024.f);
        float q = 0.f;
#pragma unroll
        for (int i = 0; i < 16; ++i) { v[i] -= mean; q += v[i] * v[i]; }
        const float rstd = rsqrtf(wave_sum(q) * (1.f / 1024.f) + 1e-5f);
        const float* nsh = which == 0 ? ada + 3072 : adab + (size_t)((l + 1) * 9 + cond) * 6144;
        const float* nsc = nsh + 1024;
#pragma unroll
        for (int i = 0; i < 4; ++i) { const int c = i * 256 + lane * 4;
            const float4 gg = *(const float4*)(lg + c), bb = *(const float4*)(lb + c);
            float4 y; y.x = v[4 * i] * rstd * gg.x + bb.x; y.y = v[4 * i + 1] * rstd * gg.y + bb.y; y.z = v[4 * i + 2] * rstd * gg.z + bb.z; y.w = v[4 * i + 3] * rstd * gg.w + bb.w;
            *(float4*)(p.out + (size_t)t * D + c) = y;
            if (has_next) { const float4 sh = *(const float4*)(nsh + c), sc = *(const float4*)(nsc + c);
                uint2 w; w.x = pk2(y.x * (1.f + sc.x) + sh.x, y.y * (1.f + sc.y) + sh.y); w.y = pk2(y.z * (1.f + sc.z) + sh.z, y.w * (1.f + sc.w) + sh.w);
                *(uint2*)(H + (size_t)t * D + c) = w; } }
    }
}
__device__ __forceinline__ void convgate_phase(const Params& p, int l, int g) {
    const int tid = otid();
    const u16* U = (const u16*)(p.ws + WS_P); u16* G = (u16*)(p.ws + WS_G);
    const int rpb = (TG + gridDim.x - 1) / gridDim.x;
    const int r_lo = blockIdx.x * rpb, r_hi = min(TG, r_lo + rpb);
    if (tid >= 352) return;
    const int c = tid * 8;
    const float* cw = p.ffn_conv_w + (size_t)l * 9 * FF + c;
    float bias[8]; *(float4*)bias = *(const float4*)(p.ffn_conv_b + l * FF + c); *(float4*)(bias + 4) = *(const float4*)(p.ffn_conv_b + l * FF + c + 4);
    if (g == 0) {
        float w[3][8];
#pragma unroll
        for (int j = 0; j < 3; ++j) { *(float4*)w[j] = *(const float4*)(cw + (3 + j) * FF); *(float4*)(w[j] + 4) = *(const float4*)(cw + (3 + j) * FF + 4); }
        for (int row = r_lo; row < r_hi; ++row) {
            const int tp = row & 255;
            uint4 dv[3];
#pragma unroll
            for (int j = 0; j < 3; ++j) { const bool ok = (unsigned)(tp + j - 1) < 256u; dv[j] = *(const uint4*)(U + (size_t)(row + (ok ? j - 1 : 0)) * FF2 + c); }
            const uint4 vraw = *(const uint4*)(U + (size_t)row * FF2 + FF + c);
            float acc[8];
#pragma unroll
            for (int k = 0; k < 8; ++k) acc[k] = bias[k];
#pragma unroll
            for (int j = 0; j < 3; ++j) { const float m = (unsigned)(tp + j - 1) < 256u ? 1.f : 0.f; float a[8]; unpack8(dv[j], a);
#pragma unroll
                for (int k = 0; k < 8; ++k) acc[k] += (m * w[j][k]) * a[k]; }
            float vv[8], o[8]; unpack8(vraw, vv);
#pragma unroll
            for (int k = 0; k < 8; ++k) o[k] = siluf(acc[k]) * vv[k];
            *(uint4*)(G + (size_t)row * FF + c) = pack8(o);
        }
    } else {
        float w[9][8];
#pragma unroll
        for (int t = 0; t < 9; ++t) { *(float4*)w[t] = *(const float4*)(cw + t * FF); *(float4*)(w[t] + 4) = *(const float4*)(cw + t * FF + 4); }
        for (int row = r_lo; row < r_hi; ++row) {
            const int tp = row & 2047, gr = tp >> 6, gc = tp & 63;
            uint4 dv[9];
#pragma unroll
            for (int i = 0; i < 3; ++i)
#pragma unroll
                for (int j = 0; j < 3; ++j) { const bool ok = (unsigned)(gr + i - 1) < 32u && (unsigned)(gc + j - 1) < 64u;
                    dv[i * 3 + j] = *(const uint4*)(U + (size_t)(row + (ok ? (i - 1) * 64 + (j - 1) : 0)) * FF2 + c); }
            const uint4 vraw = *(const uint4*)(U + (size_t)row * FF2 + FF + c);
            float acc[8];
#pragma unroll
            for (int k = 0; k < 8; ++k) acc[k] = bias[k];
#pragma unroll
            for (int i = 0; i < 3; ++i)
#pragma unroll
                for (int j = 0; j < 3; ++j) { const float m = ((unsigned)(gr + i - 1) < 32u && (unsigned)(gc + j - 1) < 64u) ? 1.f : 0.f; float a[8]; unpack8(dv[i * 3 + j], a);
#pragma unroll
                    for (int k = 0; k < 8; ++k) acc[k] += (m * w[i * 3 + j][k]) * a[k]; }
            float vv[8], o[8]; unpack8(vraw, vv);
#pragma unroll
            for (int k = 0; k < 8; ++k) o[k] = siluf(acc[k]) * vv[k];
            *(uint4*)(G + (size_t)row * FF + c) = pack8(o);
        }
    }
}
__device__ __forceinline__ void gemm_bf16out(PG8_LAS unsigned char* lds, const u16* A, const u16* Bt, u16* O, int M, int N, int K) {
    pg8::Gemm gg{A, Bt, M, N, K, K, N / 256}; pg8::StaticOrder S; S.init(M, N, (int)gridDim.x, (int)blockIdx.x);
    pg8::EpiBf16 E{O, N, N / 256, 0};
    pg8::gemm_phase<pg8::EpiBf16, pg8::StaticOrder>(lds, gg, S, E, nullptr);
}
__device__ __forceinline__ void gemm_f32out(PG8_LAS unsigned char* lds, const u16* A, const u16* Bt, float* C, int M, int N, int K) {
    pg8::Gemm gg{A, Bt, M, 2 * N, K / 2, K, N / 256}; pg8::StaticOrder S; S.init(M, 2 * N, (int)gridDim.x, (int)blockIdx.x);
    pg8::EpiBf16 E{(u16*)C, N, N / 256, (size_t)M * N};
    pg8::gemm_phase<pg8::EpiBf16, pg8::StaticOrder>(lds, gg, S, E, nullptr);
}


__device__ __forceinline__ void grid_bar(unsigned* ctr, unsigned target) {
    asm volatile("s_waitcnt vmcnt(0)" ::: "memory");
    __syncthreads();
    if (threadIdx.x < 64) {
        if (threadIdx.x == 0) {
            __builtin_amdgcn_fence(__ATOMIC_RELEASE, "agent");
            asm volatile("s_waitcnt vmcnt(0)" ::: "memory");
            __hip_atomic_fetch_add(ctr, 1u, __ATOMIC_RELAXED, __HIP_MEMORY_SCOPE_AGENT);
            while (__hip_atomic_load(ctr, __ATOMIC_RELAXED, __HIP_MEMORY_SCOPE_AGENT) < target) __builtin_amdgcn_s_sleep(1);
        }
        __builtin_amdgcn_fence(__ATOMIC_ACQUIRE, "agent");
        asm volatile("s_waitcnt vmcnt(0)" ::: "memory");
    }
    __syncthreads();
}

#define XB_TMO      128
#define XB_XCNT(j)  (256  + 64 * (j))
#define XB_XSUB(j)  (1280 + 64 * (j))
#define XB_XGEN(j)  (2304 + 64 * (j))
#define XB_TOP      3328
#define XB_TOPGEN   3392
#define XCD_BAR_WORDS 3456
#define XB_SPIN_CAP (1u << 18)
#define LAS __attribute__((address_space(3)))

__device__ __forceinline__ unsigned xb_ld(unsigned* p)              { return __hip_atomic_load(p, __ATOMIC_RELAXED, __HIP_MEMORY_SCOPE_AGENT); }
__device__ __forceinline__ unsigned xb_add(unsigned* p, unsigned v) { return __hip_atomic_fetch_add(p, v, __ATOMIC_RELAXED, __HIP_MEMORY_SCOPE_AGENT); }
__device__ __forceinline__ unsigned xb_xcc_id() { return (unsigned)__builtin_amdgcn_s_getreg((3 << 11) | 20) & 0xFu; }
#define XB_SPIN(cond, bar) do { unsigned _sp = 0; while (cond) { __builtin_amdgcn_s_sleep(1); \
    if ((++_sp & 255u) == 0u) { if (xb_ld(&(bar)[XB_TMO])) break; if (_sp > XB_SPIN_CAP) { atomicAdd(&(bar)[XB_TMO], 1u); break; } } } } while (0)
struct XcdBarrier {
    unsigned* bar; unsigned x;
    volatile LAS unsigned* st;
};

__device__ __forceinline__ XcdBarrier xcd_barrier_post(unsigned* bar, volatile LAS unsigned* st) {
    XcdBarrier b; b.bar = bar; b.x = xb_xcc_id(); b.st = st;
    if (threadIdx.x == 0) (void)xb_add(&bar[XB_XCNT(b.x)], 1u);
    return b;
}
__device__ __forceinline__ void xcd_barrier_complete(unsigned* bar, unsigned x, unsigned& nloc, unsigned& nx) {
    const unsigned G = gridDim.x * gridDim.y * gridDim.z;
    unsigned sum, cnt, mine, sp = 0u;
    for (;;) {
        sum = 0u; cnt = 0u; mine = 0u;
#pragma unroll
        for (unsigned j = 0; j < 16; ++j) { const unsigned c = xb_ld(&bar[XB_XCNT(j)]); sum += c; cnt += (c > 0u) ? 1u : 0u; mine = (j == x) ? c : mine; }
        if (sum == G) break;
        __builtin_amdgcn_s_sleep(1);
        if ((++sp & 255u) == 0u) { if (xb_ld(&bar[XB_TMO])) break; if (sp > XB_SPIN_CAP) { atomicAdd(&bar[XB_TMO], 1u); break; } }
    }
    nloc = mine > 0u ? mine : 1u; nx = cnt > 0u ? cnt : 1u;
}

__device__ __forceinline__ void xcd_barrier(const XcdBarrier& b) {
    asm volatile("s_waitcnt vmcnt(0)" ::: "memory");
    __syncthreads();
    if (threadIdx.x == 0) {
        unsigned* bar = b.bar;
        __builtin_amdgcn_s_waitcnt(0);
        unsigned nloc = b.st[0], nx = b.st[1];
        if (nloc == 0u) { xcd_barrier_complete(bar, b.x, nloc, nx); b.st[0] = nloc; b.st[1] = nx; }
        const unsigned old = xb_add(&bar[XB_XSUB(b.x)], 1u);
        const unsigned gen = old / nloc;
        if (old + 1u == (gen + 1u) * nloc) {
            __builtin_amdgcn_fence(__ATOMIC_RELEASE, "agent");
            asm volatile("s_waitcnt vmcnt(0)" ::: "memory");
            const unsigned og = xb_add(&bar[XB_TOP], 1u);
            const unsigned tg = og / nx;
            if (og + 1u == (tg + 1u) * nx) xb_add(&bar[XB_TOPGEN], 1u);
            else XB_SPIN(xb_ld(&bar[XB_TOPGEN]) == tg, bar);
            __builtin_amdgcn_fence(__ATOMIC_ACQUIRE, "agent");
            xb_add(&bar[XB_XGEN(b.x)], 1u);
            asm volatile("s_waitcnt vmcnt(0)" ::: "memory");
        } else {
            XB_SPIN(xb_ld(&bar[XB_XGEN(b.x)]) == gen, bar);
            __builtin_amdgcn_fence(__ATOMIC_ACQUIRE, "agent");
            asm volatile("s_waitcnt vmcnt(0)" ::: "memory");
        }
    }
    __syncthreads();
}


__global__ void __launch_bounds__(NTHREADS, 2) mega_fwd(Params p) {
    extern __shared__ __attribute__((aligned(16))) unsigned char lds_raw[];
    cg::grid_group grid = cg::this_grid();
    PG8_LAS unsigned char* ldsp = (PG8_LAS unsigned char*)lds_raw;
    float* ldsf = (float*)lds_raw;
    unsigned char* ws = p.ws;
    volatile LAS unsigned* xst = (volatile LAS unsigned*)((PG8_LAS unsigned char*)lds_raw + (LDS_BYTES - 16));
    if (threadIdx.x == 0) { xst[0] = 0u; xst[1] = 0u; }
    __syncthreads();
    const XcdBarrier xbar = xcd_barrier_post((unsigned*)(ws + WS_BAR), xst);
    for (int ph = p.ph_lo; ph < p.ph_hi; ++ph) {
        if (ph == 0) { for (int rep = 0; rep < REP_EW; ++rep) { prep_phase(p, ldsf); __syncthreads(); } }
        else if (ph == 1) { for (int rep = 0; rep < REP_EW; ++rep) mod0_phase(p); }
        else {
            const int q = ph - 2, gl = q >> 3, s = q & 7;
            const int l = gl / 3, g = gl % 3;
            const u16* wb = (const u16*)(ws + WS_W + (size_t)l * W_LAYER);
            const u16* Hg = (const u16*)(ws + WS_H) + (size_t)g * TG * D;
            const int G = (int)gridDim.x;
            if (gl == 6) ln_phase(p, 1, 1, 2, 0, G);
            else if (s == 0) {
                { for (int rep = 0; rep < REP_GEMM; ++rep) { gemm_bf16out(ldsp, Hg, wb + W_IN / 2, (u16*)(ws + WS_P), TG, NINP, D); __syncthreads(); } }
                if (gl > 0) {
                    const int lead = 800 - 3 * G, wg0 = (lead > 0 && lead < G) ? lead : 0;
                    ln_phase(p, (gl - 1) / 3, 1, (gl - 1) % 3, wg0, G - wg0);
                }
            }
            else if (s == 1) { for (int rep = 0; rep < REP_SCAN; ++rep) { if (l == 0) ssd_scan_mfma(p, g, lds_raw); else gdn_scan_mfma(p, g, lds_raw); __syncthreads(); } }
            else if (s == 2) { if (l == 0) ssd_combine_phase(p); else gdn_combine_phase(p); }
            else if (s == 3) { for (int rep = 0; rep < REP_GEMM; ++rep) { gemm_f32out(ldsp, (const u16*)(ws + WS_G), wb + W_OUT / 2, (float*)(ws + WS_P), TG, D, DI); __syncthreads(); } }
            else if (s == 4) ln_phase(p, l, 0, g, 0, G);
            else if (s == 5) { for (int rep = 0; rep < REP_GEMM; ++rep) { gemm_bf16out(ldsp, Hg, wb + W_UP / 2, (u16*)(ws + WS_P), TG, FF2, D); __syncthreads(); } }
            else if (s == 6) { for (int rep = 0; rep < REP_EW; ++rep) convgate_phase(p, l, g); }
            else { for (int rep = 0; rep < REP_GEMM; ++rep) { gemm_f32out(ldsp, (const u16*)(ws + WS_G), wb + W_DN / 2, (float*)(ws + WS_YB), TG, D, FF); __syncthreads(); } }
        }
        if (ph + 1 < p.ph_hi) {
            if (p.ph_lo < 0) grid.sync();
            for (int rep = 0; rep < REP_SYNC; ++rep) xcd_barrier(xbar);
        }
    }
}

extern "C" void kernel_launch(void* const* d_in, const int* in_sizes, int n_in, void* d_out, int out_size, void* d_ws, size_t ws_size, hipStream_t stream) {
    static int grid = 0;
    if (grid == 0) {
        if (n_in != 30 || ws_size < WS_END) { fprintf(stderr, "kernel_launch: unexpected n_in %d or ws_size %zu (need %zu)\n", n_in, ws_size, (size_t)WS_END); grid = -1; return; }
        int dev = 0, cus = 0, per_cu = 0;
        hipGetDevice(&dev); hipDeviceGetAttribute(&cus, hipDeviceAttributeMultiprocessorCount, dev);
        if (hipFuncSetAttribute((const void*)mega_fwd, hipFuncAttributeMaxDynamicSharedMemorySize, LDS_BYTES) != hipSuccess) { fprintf(stderr, "kernel_launch: hipFuncSetAttribute failed\n"); grid = -1; return; }
        if (hipOccupancyMaxActiveBlocksPerMultiprocessor(&per_cu, (const void*)mega_fwd, NTHREADS, LDS_BYTES) != hipSuccess || per_cu < 1) per_cu = 1;
        (void)hipGetLastError();
        grid = cus * 1;
        if (grid <= 0) grid = 256;
    }
    if (grid < 0) return;
    Params p; memset(&p, 0, sizeof(p));
    const float** pp = (const float**)&p;
    for (int i = 0; i < 30; ++i) pp[i] = (const float*)d_in[i];
    p.out = (float*)d_out; p.ws = (unsigned char*)d_ws; p.ph_lo = 0; p.ph_hi = NPHASES;
    (void)hipMemsetAsync((char*)d_ws + WS_BAR, 0, XCD_BAR_WORDS * 4, stream);
    void* args[] = {&p};
    hipError_t e = hipLaunchCooperativeKernel((const void*)mega_fwd, dim3(grid), dim3(NTHREADS), args, LDS_BYTES, stream);
    if (e != hipSuccess) fprintf(stderr, "cooperative launch failed: %s (grid %d)\n", hipGetErrorString(e), grid);
}
```

```cpp
#include <hip/hip_runtime.h>
#include <hip/hip_cooperative_groups.h>
#include <cstdio>
#include <cstring>
namespace cg = cooperative_groups;
namespace pg8 {
#define PG8_LAS __attribute__((address_space(3)))
typedef unsigned short bf16_t;
typedef short bf16x8 __attribute__((ext_vector_type(8)));
typedef float f32x4 __attribute__((ext_vector_type(4)));
typedef unsigned u32x4 __attribute__((ext_vector_type(4)));
constexpr int BM = 256, BK = 64, HALF = 128, HTB = HALF * BK * 2  , STAGE_BYTES = 8 * HTB, NXCD = 8, WGM = 8;

__host__ __device__ __forceinline__ int lds_byte(int r, int c) { const int st = (r >> 4) * 2 + (c >> 5), rr = r & 15, cc = c & 31, ob = rr * 64 + cc * 2; return st * 1024 + (ob ^ (((ob >> 9) & 1) << 5)); }
__host__ __device__ __forceinline__ void stage_rc(int b, int& R, int& C) { const int st = b / 1024, sb = b % 1024, swz = sb ^ (((sb >> 9) & 1) << 5); R = (st >> 1) * 16 + swz / 64; C = (st & 1) * 32 + (swz % 64) / 2; }
__host__ __device__ __forceinline__ int perm32(int rho) { const int n = rho >> 4, i = rho & 15; return 8 * (i >> 2) + 4 * n + (i & 3); }

struct Unit { int pm, pn; };
struct Gemm { const bf16_t* A; const bf16_t* Bt; int M, N, K, ld, npn; };

struct StaticOrder {
    int nM, nN, nwg, G, c;
    __host__ __device__ void init(int M, int N, int G_, int c_) { nM = M / BM; nN = N / BM; nwg = nM * nN; G = G_; c = c_; }
    __host__ __device__ bool next(int i, Unit& u) const {
        const long L = (long)i * G + c; if (L >= nwg) return false;
        int wgid = (int)L; { const int q = nwg / NXCD, r = nwg % NXCD, xcd = wgid % NXCD, off = wgid / NXCD; wgid = (xcd < r ? xcd * (q + 1) : r * (q + 1) + (xcd - r) * q) + off; }
        const int nig = WGM * nN, gid = wgid / nig, fm = gid * WGM, gsz = (nM - fm) < WGM ? (nM - fm) : WGM;
        u.pm = fm + ((wgid % nig) % gsz); u.pn = (wgid % nig) / gsz; return true;
    }
    __device__ __forceinline__ void a_ready(const Unit&) const {}
    __device__ __forceinline__ void done(const Unit&) const {}
};
typedef __bf16 bf16x2_t __attribute__((ext_vector_type(2)));
typedef float f32x2_t __attribute__((ext_vector_type(2)));
__device__ __forceinline__ unsigned cvt_pk_bf16(float lo, float hi) { const f32x2_t f = {lo, hi}; const bf16x2_t v = __builtin_convertvector(f, bf16x2_t); return __builtin_bit_cast(unsigned, v); }
typedef unsigned u32x4 __attribute__((ext_vector_type(4)));
struct EpiF32 {
    static constexpr bool PERM = false, AFTER_DRAIN = false;
    float* C; int ldc; int npn; size_t split_stride;
    __device__ __forceinline__ void operator()(const f32x4 (&acc)[2][2][4][2], const Unit& u, int wr, int wc, int fr, int fq) const {
        const int row0 = u.pm * BM + wr * 64 + fr, col0 = (u.pn % npn) * BM + wc * 32 + 4 * fq;
        float* Cs = C + (size_t)(u.pn / npn) * split_stride;
#pragma unroll
        for (int ai = 0; ai < 2; ++ai)
#pragma unroll
            for (int m = 0; m < 4; ++m) { float* rowp = Cs + (size_t)(row0 + ai * HALF + m * 16) * ldc + col0;
#pragma unroll
                for (int bj = 0; bj < 2; ++bj)
#pragma unroll
                    for (int n = 0; n < 2; ++n) *(f32x4*)(rowp + bj * HALF + n * 16) = acc[ai][bj][m][n]; }
    }
};
struct EpiBf16 {
    static constexpr bool PERM = true, AFTER_DRAIN = false;
    bf16_t* O; int ldc; int npn; size_t split_stride;
    __device__ __forceinline__ void operator()(const f32x4 (&acc)[2][2][4][2], const Unit& u, int wr, int wc, int fr, int fq) const {
        const int row0 = u.pm * BM + wr * 64 + fr, col0 = (u.pn % npn) * BM + wc * 32 + 8 * fq;
        bf16_t* Os = O + (size_t)(u.pn / npn) * split_stride;
#pragma unroll
        for (int ai = 0; ai < 2; ++ai)
#pragma unroll
            for (int m = 0; m < 4; ++m) { bf16_t* rowp = Os + (size_t)(row0 + ai * HALF + m * 16) * ldc + col0;
#pragma unroll
                for (int bj = 0; bj < 2; ++bj) { const f32x4 v0 = acc[ai][bj][m][0], v1 = acc[ai][bj][m][1];
                    u32x4 w; w.x = cvt_pk_bf16(v0[0], v0[1]); w.y = cvt_pk_bf16(v0[2], v0[3]); w.z = cvt_pk_bf16(v1[0], v1[1]); w.w = cvt_pk_bf16(v1[2], v1[3]);
                    *(u32x4*)(rowp + bj * HALF) = w; } }
    }
};
template <class Epi, class Sched, bool STAMP = false>
__device__ __forceinline__ void gemm_phase(PG8_LAS unsigned char* lds, const Gemm g, const Sched& S, const Epi& E, unsigned long long* stamps) {
    int tid_ = threadIdx.x; asm volatile("" : "+v"(tid_)); const int tid = tid_, wid = __builtin_amdgcn_readfirstlane(tid >> 6), lane = tid & 63, wr = wid >> 2, wc = wid & 3, fr = lane & 15, fq = lane >> 4;
    const int K = g.K, nt = K / BK;
    int ts_lo = 0, ts_hi = 0, nts = 0; const unsigned long long rt_entry = STAMP ? (unsigned long long)wall_clock64() : 0ull;
#define PG8_STAMP() do { if (STAMP && wid == 0 && nts < 64) { const unsigned long long _c = (unsigned long long)clock64(); \
        ts_lo = (lane == nts) ? (int)(unsigned)_c : ts_lo; ts_hi = (lane == nts) ? (int)(unsigned)(_c >> 32) : ts_hi; ++nts; } } while (0)
    PG8_STAMP();
    unsigned voffA[2], voffB[2];
#pragma unroll
    for (int i = 0; i < 2; ++i) { int R, C; stage_rc(tid * 16 + i * 8192, R, C); const int Rb = Epi::PERM ? ((R & ~31) + perm32(R & 31)) : R;
        voffA[i] = (unsigned)(R * g.ld + C) * 2u; voffB[i] = (unsigned)(Rb * g.ld + C) * 2u; }
    const size_t kstep = (size_t)(BK * 2);
    const size_t hstep = (size_t)HALF * g.ld * 2;
    const size_t tstep = 2 * hstep;
    const unsigned ldsw = (unsigned)wid * 1024u;
    const int aoff = lds_byte(wr * 64 + fr, fq * 8), boff = lds_byte(wc * 32 + fr, fq * 8);
#define PG8_SA(b, h) (((b) * 2 + (h)) * HTB)
#define PG8_SB(b, h) ((4 + (b) * 2 + (h)) * HTB)
#define PG8_STAGE(bufoff, gbase, voff) do { _Pragma("unroll") for (int _i = 0; _i < 2; ++_i) \
        __builtin_amdgcn_global_load_lds((const unsigned*)((const char*)(gbase) + (voff)[_i]), (PG8_LAS unsigned*)(lds + (bufoff) + ldsw + _i * 8192), 16, 0, 0); } while (0)
#define PG8_LDA(dst, b, h) do { _Pragma("unroll") for (int m = 0; m < 4; ++m) _Pragma("unroll") for (int k = 0; k < 2; ++k) dst[m][k] = *(const PG8_LAS bf16x8*)(lds + PG8_SA(b, h) + aoff + m * 2048 + k * 1024); } while (0)
#define PG8_LDB(dst, b, h) do { _Pragma("unroll") for (int n = 0; n < 2; ++n) _Pragma("unroll") for (int k = 0; k < 2; ++k) dst[n][k] = *(const PG8_LAS bf16x8*)(lds + PG8_SB(b, h) + boff + n * 2048 + k * 1024); } while (0)
#define PG8_MMA(ai, bj, At, Bt) do { __builtin_amdgcn_s_setprio(1); _Pragma("unroll") for (int m = 0; m < 4; ++m) _Pragma("unroll") for (int n = 0; n < 2; ++n) _Pragma("unroll") for (int k = 0; k < 2; ++k) \
        acc[ai][bj][m][n] = __builtin_amdgcn_mfma_f32_16x16x32_bf16(Bt[n][k], At[m][k], acc[ai][bj][m][n], 0, 0, 0); __builtin_amdgcn_s_setprio(0); } while (0)
#define PG8_WAIT_V(n) asm volatile("s_waitcnt vmcnt(" #n ")" ::: "memory")
#define PG8_WAIT_L(n) asm volatile("s_waitcnt lgkmcnt(" #n ")" ::: "memory")
#define PG8_BAR __builtin_amdgcn_s_barrier()
#define PG8_SCHED __builtin_amdgcn_sched_barrier(0)
    Unit cur, nxt; int ui = 0;
    if (!S.next(0, cur)) return;
    f32x4 acc[2][2][4][2];
#pragma unroll
    for (int a = 0; a < 2; ++a)
#pragma unroll
        for (int b = 0; b < 2; ++b)
#pragma unroll
            for (int m = 0; m < 4; ++m)
#pragma unroll
                for (int n = 0; n < 2; ++n) acc[a][b][m][n] = (f32x4){0.f, 0.f, 0.f, 0.f};
    bf16x8 At[4][2], B0[2][2], B1[2][2];
    const size_t ksb = (size_t)K * 2;
    const char* cA = (const char*)g.A + (size_t)cur.pm * tstep + (size_t)(cur.pn / g.npn) * ksb; const char* cB = (const char*)g.Bt + (size_t)(cur.pn % g.npn) * tstep + (size_t)(cur.pn / g.npn) * ksb;
    S.a_ready(cur);
    PG8_STAGE(PG8_SB(0, 0), cB, voffB); PG8_STAGE(PG8_SA(0, 0), cA, voffA); PG8_STAGE(PG8_SB(0, 1), cB + hstep, voffB); PG8_STAGE(PG8_SA(0, 1), cA + hstep, voffA);
    if (wr == 1) PG8_BAR;
    PG8_WAIT_V(4); PG8_BAR;
    PG8_STAGE(PG8_SB(1, 0), cB + kstep, voffB); PG8_STAGE(PG8_SA(1, 0), cA + kstep, voffA); PG8_STAGE(PG8_SB(1, 1), cB + hstep + kstep, voffB);
    PG8_WAIT_V(6); PG8_BAR;
    PG8_STAMP();
    for (;;) {
        const bool has_next = S.next(ui + 1, nxt);
        const char* nA = has_next ? (const char*)g.A + (size_t)nxt.pm * tstep + (size_t)(nxt.pn / g.npn) * ksb : cA; const char* nB = has_next ? (const char*)g.Bt + (size_t)(nxt.pn % g.npn) * tstep + (size_t)(nxt.pn / g.npn) * ksb : cB;
        for (int t = 0; t < nt; t += 2) {
            const bool last = (t == nt - 2);
            const char* a1 = cA + (size_t)(t + 1) * kstep;
            const char* a2 = last ? nA : cA + (size_t)(t + 2) * kstep; const char* b2 = last ? nB : cB + (size_t)(t + 2) * kstep;
            const char* a3 = a2 + kstep; const char* b3 = b2 + kstep;
            if (last && has_next) S.a_ready(nxt);
            PG8_LDB(B0, 0, 0); PG8_SCHED; PG8_LDA(At, 0, 0); PG8_STAGE(PG8_SA(1, 1), a1 + hstep, voffA);
            PG8_WAIT_L(8); PG8_BAR; PG8_WAIT_L(0); PG8_MMA(0, 0, At, B0); PG8_BAR; PG8_SCHED;
            PG8_LDB(B1, 0, 1); PG8_STAGE(PG8_SB(0, 0), b2, voffB);
            PG8_BAR; PG8_WAIT_L(0); PG8_MMA(0, 1, At, B1); PG8_BAR;
            PG8_LDA(At, 0, 1); PG8_STAGE(PG8_SA(0, 0), a2, voffA);
            PG8_BAR; PG8_WAIT_L(0); PG8_MMA(1, 0, At, B0); PG8_BAR; PG8_SCHED;
            PG8_STAGE(PG8_SB(0, 1), b2 + hstep, voffB);
            PG8_WAIT_V(6); PG8_BAR; PG8_MMA(1, 1, At, B1); PG8_BAR;
            PG8_LDB(B0, 1, 0); PG8_SCHED; PG8_LDA(At, 1, 0); PG8_STAGE(PG8_SA(0, 1), a2 + hstep, voffA);
            PG8_WAIT_L(8); PG8_BAR; PG8_WAIT_L(0); PG8_MMA(0, 0, At, B0); PG8_BAR; PG8_SCHED;
            PG8_LDB(B1, 1, 1); PG8_STAGE(PG8_SB(1, 0), b3, voffB);
            PG8_BAR; PG8_WAIT_L(0); PG8_MMA(0, 1, At, B1); PG8_BAR;
            PG8_LDA(At, 1, 1); PG8_STAGE(PG8_SA(1, 0), a3, voffA);
            PG8_BAR; PG8_WAIT_L(0); PG8_MMA(1, 0, At, B0); PG8_BAR; PG8_SCHED;
            PG8_STAGE(PG8_SB(1, 1), b3 + hstep, voffB);
            PG8_WAIT_V(6); PG8_BAR; PG8_MMA(1, 1, At, B1); PG8_BAR;
        }
        PG8_STAMP();
        if constexpr (!Epi::AFTER_DRAIN) { E(acc, cur, wr, wc, fr, fq); S.done(cur); }
        PG8_STAMP();
        if (!has_next) break;
#pragma unroll
        for (int a = 0; a < 2; ++a)
#pragma unroll
            for (int b = 0; b < 2; ++b)
#pragma unroll
                for (int m = 0; m < 4; ++m)
#pragma unroll
                    for (int n = 0; n < 2; ++n) acc[a][b][m][n] = (f32x4){0.f, 0.f, 0.f, 0.f};
        cur = nxt; cA = nA; cB = nB; ++ui;
    }
    PG8_WAIT_V(0);
    if (wr == 0) PG8_BAR;
    PG8_BAR;
    if constexpr (Epi::AFTER_DRAIN) { E.fused(acc, cur, wr, wc, fr, fq, lds, wid, lane); S.done(cur); }
    PG8_STAMP();
    if (STAMP && wid == 0) { stamps[lane] = lane < nts ? (((unsigned long long)(unsigned)ts_hi << 32) | (unsigned)ts_lo) : 0ull;
        if (lane == 62) stamps[62] = rt_entry; if (lane == 63) stamps[63] = (unsigned long long)wall_clock64(); }
#undef PG8_STAMP
#undef PG8_SA
#undef PG8_SB
#undef PG8_STAGE
#undef PG8_LDA
#undef PG8_LDB
#undef PG8_MMA
#undef PG8_WAIT_V
#undef PG8_WAIT_L
#undef PG8_BAR
#undef PG8_SCHED
}
}

typedef unsigned short u16;
constexpr int D = 1024, T_ALL = 24576, TG = 8192, NGRP = 3;
constexpr int NINP = 6400, DI = 2048, FF = 2816, FF2 = 5632;
constexpr int NTHREADS = 512, LDS_BYTES = 143360;
constexpr float ALPHA = 1.4142135623730951f;
constexpr size_t WS_ADA = 0;
constexpr size_t WS_BAR = 499712;
constexpr size_t WS_W = 524288;
constexpr size_t W_IN = 0, W_OUT = W_IN + (size_t)NINP * D * 2, W_UP = W_OUT + (size_t)D * DI * 2, W_DN = W_UP + (size_t)FF2 * D * 2, W_LAYER = W_DN + (size_t)D * FF * 2;
constexpr size_t WS_H = WS_W + 2 * W_LAYER;
constexpr size_t WS_P = WS_H + (size_t)T_ALL * D * 2;
constexpr size_t WS_G = WS_P + (size_t)TG * NINP * 2;
constexpr size_t WS_YB = WS_G + (size_t)TG * FF * 2;
constexpr size_t WS_END = WS_YB + (size_t)TG * DI * 2;
constexpr size_t OUT_SSD_F = (size_t)T_ALL * D, OUT_SSD_B = OUT_SSD_F + 8388608, OUT_GDN_F = OUT_SSD_B + 8388608, OUT_GDN_B = OUT_GDN_F + 8388608;
#ifndef REP_SCAN
#define REP_SCAN 1
#endif
#ifndef REP_EW
#define REP_EW 1
#endif
#ifndef REP_SYNC
#define REP_SYNC 1
#endif
#ifndef REP_GEMM
#define REP_GEMM 1
#endif
constexpr int NPHASES = 2 + 2 * NGRP * 8 + 1;

struct Params {
    const float *x_prompt, *x_sample, *st_ssd_f, *st_ssd_b, *st_gdn_f, *st_gdn_b, *c, *c_ctx, *w_ada, *b_ada, *ln_g, *ln_b,
        *ssd_w_in, *ssd_conv_w, *ssd_conv_b, *ssd_dt_bias, *ssd_a_log, *ssd_d, *ssd_norm_w, *ssd_w_out,
        *gdn_w_in, *gdn_conv_w, *gdn_dt_bias, *gdn_a_log, *gdn_norm_w, *gdn_w_out,
        *ffn_w_up, *ffn_conv_w, *ffn_conv_b, *ffn_w_down;
    float* out; unsigned char* ws; int ph_lo, ph_hi;
};

__device__ __forceinline__ int otid() { int t = threadIdx.x; asm volatile("" : "+v"(t)); return t; }
__device__ __forceinline__ float bf2f(u16 b) { return __uint_as_float(((unsigned)b) << 16); }
__device__ __forceinline__ unsigned pk2(float lo, float hi) { return pg8::cvt_pk_bf16(lo, hi); }
__device__ __forceinline__ float siluf(float x) { return x * __builtin_amdgcn_rcpf(1.f + __expf(-x)); }
__device__ __forceinline__ float softplusf(float x) { return x > 15.f ? x : __logf(1.f + __expf(x)); }
__device__ __forceinline__ void unpack8(const uint4 v, float* f) {
    f[0] = __uint_as_float(v.x << 16); f[1] = __uint_as_float(v.x & 0xffff0000u); f[2] = __uint_as_float(v.y << 16); f[3] = __uint_as_float(v.y & 0xffff0000u);
    f[4] = __uint_as_float(v.z << 16); f[5] = __uint_as_float(v.z & 0xffff0000u); f[6] = __uint_as_float(v.w << 16); f[7] = __uint_as_float(v.w & 0xffff0000u);
}
__device__ __forceinline__ void unpack4(const uint2 v, float* f) {
    f[0] = __uint_as_float(v.x << 16); f[1] = __uint_as_float(v.x & 0xffff0000u); f[2] = __uint_as_float(v.y << 16); f[3] = __uint_as_float(v.y & 0xffff0000u);
}
__device__ __forceinline__ uint4 pack8(const float* f) { uint4 r; r.x = pk2(f[0], f[1]); r.y = pk2(f[2], f[3]); r.z = pk2(f[4], f[5]); r.w = pk2(f[6], f[7]); return r; }
typedef unsigned ntl_u32x4 __attribute__((ext_vector_type(4)));
typedef unsigned ntl_u32x2 __attribute__((ext_vector_type(2)));
typedef float ntl_f32x4 __attribute__((ext_vector_type(4)));
__device__ __forceinline__ uint4 ldnt16(const void* p) { const ntl_u32x4 v = __builtin_nontemporal_load((const ntl_u32x4*)p); return make_uint4(v.x, v.y, v.z, v.w); }
__device__ __forceinline__ uint2 ldnt8(const void* p) { const ntl_u32x2 v = __builtin_nontemporal_load((const ntl_u32x2*)p); return make_uint2(v.x, v.y); }
__device__ __forceinline__ float4 ldnt16f(const float* p) { const ntl_f32x4 v = __builtin_nontemporal_load((const ntl_f32x4*)p); return make_float4(v.x, v.y, v.z, v.w); }
__device__ __forceinline__ int cond_of(int t) { return t < 8192 ? 0 : 1 + ((t - 8192) >> 11); }
__device__ __forceinline__ const float* xin_row(const Params& p, int t) { return t < 8192 ? p.x_prompt + (size_t)t * D : p.x_sample + (size_t)(t - 8192) * D; }
__device__ __forceinline__ float wave_sum(float v) {
    v += __shfl_xor(v, 1); v += __shfl_xor(v, 2); v += __shfl_xor(v, 4); v += __shfl_xor(v, 8); v += __shfl_xor(v, 16); v += __shfl_xor(v, 32); return v;
}


#define DPP_STEP(v, ctrl, rmask, bctl) (v) += __int_as_float(__builtin_amdgcn_update_dpp(0, __float_as_int(v), (ctrl), (rmask), 0xF, (bctl)))
__device__ __forceinline__ float wave_prefix_sum(float v) {
    DPP_STEP(v, 0x111, 0xF, true); DPP_STEP(v, 0x112, 0xF, true); DPP_STEP(v, 0x114, 0xF, true); DPP_STEP(v, 0x118, 0xF, true);
    DPP_STEP(v, 0x142, 0xA, false);
    DPP_STEP(v, 0x143, 0xC, false);
    return v;
}
__device__ __forceinline__ float wave_last(float v) { return __int_as_float(__builtin_amdgcn_readlane(__float_as_int(v), 63)); }
__device__ __forceinline__ void wprep(const float* __restrict__ src, u16* __restrict__ dst, int K, int N, int Npad, float* tile) {
    const int tid = otid(); const int nkt = K >> 6, nnt = Npad >> 6;
    for (int t = blockIdx.x; t < nkt * nnt; t += gridDim.x) {
        const int kt = t % nkt, nt = t / nkt; const int k0 = kt * 64, n0 = nt * 64;
#pragma unroll
        for (int e = 0; e < 8; ++e) { const int idx = e * 512 + tid; const int kk = idx >> 6, nn = idx & 63; float v = 0.f;
            if (n0 + nn < N) v = src[(size_t)(k0 + kk) * N + n0 + nn];
            tile[kk * 65 + nn] = v; }
        __syncthreads();
#pragma unroll
        for (int e = 0; e < 4; ++e) { const int idx = e * 512 + tid; const int nn = idx >> 5, kp = idx & 31;
            const unsigned w = pk2(tile[(2 * kp) * 65 + nn], tile[(2 * kp + 1) * 65 + nn]);
            *(unsigned*)(dst + (size_t)(n0 + nn) * K + k0 + 2 * kp) = w; }
        __syncthreads();
    }
}
__device__ __forceinline__ void adaln_phase(const Params& p, float* lds) {
    float* s = lds; float* red = lds + 9 * 1024;
    const int tid = otid(), wave = tid >> 6, lane = tid & 63;
    if ((int)blockIdx.x >= 192) return;
    for (int i = tid; i < 9 * 1024; i += NTHREADS) { const int c = i >> 10, k = i & 1023; const float v = c == 0 ? p.c_ctx[k] : p.c[(c - 1) * 1024 + k]; s[i] = siluf(v); }
    __syncthreads();
    float* ada = (float*)(p.ws + WS_ADA);
    for (int ch = blockIdx.x; ch < 192; ch += gridDim.x) {
        const int l = ch / 96, col0 = (ch % 96) * 64;
        const float* w = p.w_ada + (size_t)l * 1024 * 6144 + col0 + lane;
        float acc[9];
#pragma unroll
        for (int c = 0; c < 9; ++c) acc[c] = 0.f;
#pragma unroll 8
        for (int k = wave * 128; k < wave * 128 + 128; ++k) { const float wv = w[(size_t)k * 6144];
#pragma unroll
            for (int c = 0; c < 9; ++c) acc[c] += s[c * 1024 + k] * wv; }
#pragma unroll
        for (int c = 0; c < 9; ++c) red[(wave * 9 + c) * 64 + lane] = acc[c];
        __syncthreads();
        for (int i = tid; i < 576; i += NTHREADS) { const int c = i >> 6, col = i & 63; float v = p.b_ada[l * 6144 + col0 + col];
#pragma unroll
            for (int w8 = 0; w8 < 8; ++w8) v += red[(w8 * 9 + c) * 64 + col];
            ada[(size_t)(l * 9 + c) * 6144 + col0 + col] = v; }
        __syncthreads();
    }
}
__device__ __forceinline__ void prep_phase(const Params& p, float* lds) {
    adaln_phase(p, lds);
    __syncthreads();
    for (int l = 0; l < 2; ++l) {
        u16* wb = (u16*)(p.ws + WS_W + (size_t)l * W_LAYER);
        wprep(l == 0 ? p.ssd_w_in : p.gdn_w_in, wb + W_IN / 2, 1024, 6208, NINP, lds);
        wprep(l == 0 ? p.ssd_w_out : p.gdn_w_out, wb + W_OUT / 2, 2048, 1024, 1024, lds);
        wprep(p.ffn_w_up + (size_t)l * 1024 * FF2, wb + W_UP / 2, 1024, FF2, FF2, lds);
        wprep(p.ffn_w_down + (size_t)l * FF * 1024, wb + W_DN / 2, FF, 1024, 1024, lds);
    }
}
__device__ __forceinline__ void mod0_phase(const Params& p) {
    const float* ada = (const float*)(p.ws + WS_ADA); u16* H = (u16*)(p.ws + WS_H);
    for (size_t i = (size_t)blockIdx.x * NTHREADS + otid(); i < (size_t)T_ALL * 256; i += (size_t)gridDim.x * NTHREADS) {
        const int t = (int)(i >> 8), c = (int)(i & 255) * 4;
        const float4 x = *(const float4*)(xin_row(p, t) + c);
        const float* a = ada + (size_t)cond_of(t) * 6144;
        const float4 sh = *(const float4*)(a + c), sc = *(const float4*)(a + 1024 + c);
        uint2 w; w.x = pk2(x.x * (1.f + sc.x) + sh.x, x.y * (1.f + sc.y) + sh.y); w.y = pk2(x.z * (1.f + sc.z) + sh.z, x.w * (1.f + sc.w) + sh.w);
        *(uint2*)(H + (size_t)t * D + c) = w;
    }
}
__device__ __forceinline__ void conv8(const u16* r1, int rs, bool hm, bool hp, const float* w, int wstride, float* o) {
    const uint4 z = {0u, 0u, 0u, 0u};
    const uint4 v0 = hm ? *(const uint4*)(r1 - rs) : z, v1 = *(const uint4*)r1, v2 = hp ? *(const uint4*)(r1 + rs) : z;
    float a0[8], a1[8], a2[8]; unpack8(v0, a0); unpack8(v1, a1); unpack8(v2, a2);
    float w0[8], w1[8], w2[8];
    *(float4*)w0 = *(const float4*)w; *(float4*)(w0 + 4) = *(const float4*)(w + 4);
    *(float4*)w1 = *(const float4*)(w + wstride); *(float4*)(w1 + 4) = *(const float4*)(w + wstride + 4);
    *(float4*)w2 = *(const float4*)(w + 2 * wstride); *(float4*)(w2 + 4) = *(const float4*)(w + 2 * wstride + 4);
#pragma unroll
    for (int j = 0; j < 8; ++j) o[j] = w0[j] * a0[j] + w1[j] * a1[j] + w2[j] * a2[j];
}
__device__ __forceinline__ void conv4(const u16* r1, int rs, bool hm, bool hp, const float* w, int wstride, float* o) {
    const uint2 z = {0u, 0u};
    const uint2 v0 = hm ? *(const uint2*)(r1 - rs) : z, v1 = *(const uint2*)r1, v2 = hp ? *(const uint2*)(r1 + rs) : z;
    float a0[4], a1[4], a2[4]; unpack4(v0, a0); unpack4(v1, a1); unpack4(v2, a2);
    const float4 w0 = *(const float4*)w, w1 = *(const float4*)(w + wstride), w2 = *(const float4*)(w + 2 * wstride);
    o[0] = w0.x * a0[0] + w1.x * a1[0] + w2.x * a2[0]; o[1] = w0.y * a0[1] + w1.y * a1[1] + w2.y * a2[1];
    o[2] = w0.z * a0[2] + w1.z * a1[2] + w2.z * a2[2]; o[3] = w0.w * a0[3] + w1.w * a1[3] + w2.w * a2[3];
}
__device__ __forceinline__ void ssd_scan_phase(const Params& p, int g, float* lds) {
    const int tid = otid(), wave = tid >> 6, lane = tid & 63;
    const int L = g == 0 ? 256 : 2048, nseq = g == 0 ? 32 : 4, nitems = nseq * 64;
    float* Bs = lds; float* Cs = lds + 4096; float* xs = lds + 8192; float* ybuf = lds + 10240; float* dts = lds + 12288; float* dAs = lds + 12320;
    const u16* P = (const u16*)(p.ws + WS_P);
    const int tok = tid >> 4, cgi = tid & 15;
    const int pl = lane >> 3, ng = lane & 7, pp = wave * 8 + pl;
    for (int item = blockIdx.x; item < nitems; item += gridDim.x) {
        const int d = item & 1, h = (item >> 1) & 31, seq = item >> 6, grp = h >> 2;
        const int row0 = seq * L;
        const float a_neg = -__expf(p.ssd_a_log[d * 32 + h]), dtb = p.ssd_dt_bias[d * 32 + h], dskip = d == 0 ? p.ssd_d[h] : 0.f;
        float S[16];
        if (g == 0) {
#pragma unroll
            for (int i = 0; i < 16; ++i) S[i] = 0.f;
        } else {
            const float* s0 = (d ? p.st_ssd_b : p.st_ssd_f) + ((size_t)(((g - 1) * 4 + seq) * 32 + h) * 64 + pp) * 128;
#pragma unroll
            for (int i = 0; i < 4; ++i) { const float4 v = *(const float4*)(s0 + 32 * i + 4 * ng); S[4 * i] = v.x; S[4 * i + 1] = v.y; S[4 * i + 2] = v.z; S[4 * i + 3] = v.w; }
        }
        const int chx = h * 64 + cgi * 4, chb = 2048 + grp * 128 + cgi * 8, chc = 3072 + grp * 128 + cgi * 8;
        u16* ydst = (u16*)(p.ws + (d ? WS_YB : WS_G));
        for (int tile = 0; tile < L / 32; ++tile) {
            const int sidx = tile * 32 + tok; const int tp = d ? L - 1 - sidx : sidx;
            {
                const u16* r1 = P + (size_t)(row0 + tp) * NINP + 2048;
                const bool hm = tp > 0, hp = tp < L - 1;
                float o4[4]; conv4(r1 + chx, NINP, hm, hp, p.ssd_conv_w + chx, 4096, o4);
                const float4 bx = *(const float4*)(p.ssd_conv_b + chx);
                float4 xo; xo.x = siluf(o4[0] + bx.x); xo.y = siluf(o4[1] + bx.y); xo.z = siluf(o4[2] + bx.z); xo.w = siluf(o4[3] + bx.w);
                *(float4*)(xs + tok * 64 + cgi * 4) = xo;
                float o8[8], bb[8];
                conv8(r1 + chb, NINP, hm, hp, p.ssd_conv_w + chb, 4096, o8);
                *(float4*)bb = *(const float4*)(p.ssd_conv_b + chb); *(float4*)(bb + 4) = *(const float4*)(p.ssd_conv_b + chb + 4);
#pragma unroll
                for (int j = 0; j < 8; ++j) o8[j] = siluf(o8[j] + bb[j]);
                *(float4*)(Bs + tok * 128 + cgi * 8) = *(float4*)o8; *(float4*)(Bs + tok * 128 + cgi * 8 + 4) = *(float4*)(o8 + 4);
                conv8(r1 + chc, NINP, hm, hp, p.ssd_conv_w + chc, 4096, o8);
                *(float4*)bb = *(const float4*)(p.ssd_conv_b + chc); *(float4*)(bb + 4) = *(const float4*)(p.ssd_conv_b + chc + 4);
#pragma unroll
                for (int j = 0; j < 8; ++j) o8[j] = siluf(o8[j] + bb[j]);
                *(float4*)(Cs + tok * 128 + cgi * 8) = *(float4*)o8; *(float4*)(Cs + tok * 128 + cgi * 8 + 4) = *(float4*)(o8 + 4);
                if (cgi == 0) { const float raw = bf2f(P[(size_t)(row0 + tp) * NINP + 6144 + d * 32 + h]); const float dt = softplusf(raw + dtb); dts[tok] = dt; dAs[tok] = __expf(dt * a_neg); }
            }
            __syncthreads();
            for (int tt = 0; tt < 32; ++tt) {
                const float dA = dAs[tt], x = xs[tt * 64 + pp]; const float xdt = x * dts[tt];
                float acc = 0.f;
#pragma unroll
                for (int i = 0; i < 4; ++i) {
                    const float4 b = *(const float4*)(Bs + tt * 128 + 32 * i + 4 * ng), c = *(const float4*)(Cs + tt * 128 + 32 * i + 4 * ng);
                    S[4 * i] = S[4 * i] * dA + xdt * b.x; S[4 * i + 1] = S[4 * i + 1] * dA + xdt * b.y; S[4 * i + 2] = S[4 * i + 2] * dA + xdt * b.z; S[4 * i + 3] = S[4 * i + 3] * dA + xdt * b.w;
                    acc += S[4 * i] * c.x + S[4 * i + 1] * c.y + S[4 * i + 2] * c.z + S[4 * i + 3] * c.w;
                }
                acc += __shfl_xor(acc, 1); acc += __shfl_xor(acc, 2); acc += __shfl_xor(acc, 4);
                if (ng == 0) ybuf[tt * 64 + pp] = acc + dskip * x;
            }
            __syncthreads();
            {   const float4 y = *(const float4*)(ybuf + tok * 64 + cgi * 4); uint2 w; w.x = pk2(y.x, y.y); w.y = pk2(y.z, y.w);
                *(uint2*)(ydst + (size_t)(row0 + tp) * DI + h * 64 + cgi * 4) = w; }
        }
        if (g == 0) {
            float* so = p.out + (d ? OUT_SSD_B : OUT_SSD_F) + ((size_t)(seq * 32 + h) * 64 + pp) * 128;
#pragma unroll
            for (int i = 0; i < 4; ++i) { float4 v; v.x = S[4 * i]; v.y = S[4 * i + 1]; v.z = S[4 * i + 2]; v.w = S[4 * i + 3]; *(float4*)(so + 32 * i + 4 * ng) = v; }
        }
        __syncthreads();
    }
}

typedef pg8::bf16x8 bfx8; typedef pg8::f32x4 fx4;
__device__ __forceinline__ fx4 mma16(bfx8 a, bfx8 b, fx4 c) { return __builtin_amdgcn_mfma_f32_16x16x32_bf16(a, b, c, 0, 0, 0); }
__device__ __forceinline__ uint2 pack4v(fx4 v) { uint2 r; r.x = pk2(v[0], v[1]); r.y = pk2(v[2], v[3]); return r; }
__device__ __forceinline__ void ssd_scan_mfma(const Params& p, int g, unsigned char* lds) {
    const int tid = otid(), wave = tid >> 6, lane = tid & 63, fr = lane & 15, fq = lane >> 4;
    const int L = g == 0 ? 256 : 2048, nseq = g == 0 ? 32 : 4, nitems = nseq * 64, nchunk = L / 64;
    u16* Cs = (u16*)lds; u16* Bs = Cs + 64 * 144; u16* BT = Bs + 64 * 144; u16* XT = BT + 128 * 80; u16* XwT = XT + 64 * 80; u16* Ms = XwT + 64 * 80; u16* Sb = Ms + 64 * 80;
    float* cum = (float*)(Sb + 64 * 144); float* dtv = cum + 64; float* wgt = cum + 128; float* ecum = cum + 192; float* misc = cum + 256;
    const u16* P = (const u16*)(p.ws + WS_P);
    for (int item0 = ((gridDim.x & 7) == 0 ? (int)((blockIdx.x & 7) * (gridDim.x >> 3) + (blockIdx.x >> 3)) : (int)blockIdx.x); item0 < nitems; item0 += gridDim.x) {
        const int item = item0;
        const int d = item & 1, h = (item >> 1) & 31, seq = item >> 6, grp = h >> 2;
        const int row0 = seq * L;
        const float a_neg = -__expf(p.ssd_a_log[d * 32 + h]), dtb = p.ssd_dt_bias[d * 32 + h], dskip = p.ssd_d[h];
        fx4 st[4];
        const int n0 = wave * 16 + 4 * fq;
#pragma unroll
        for (int pt = 0; pt < 4; ++pt) {
            if (g == 0) st[pt] = (fx4){0.f, 0.f, 0.f, 0.f};
            else st[pt] = *(const fx4*)((d ? p.st_ssd_b : p.st_ssd_f) + ((size_t)(((g - 1) * 4 + seq) * 32 + h) * 64 + pt * 16 + fr) * 128 + n0);
            *(uint2*)(Sb + (pt * 16 + fr) * 144 + n0) = pack4v(st[pt]);
        }
        const int oc = tid & 31, tq = tid >> 5; const int cha = (oc < 16 ? 2048 + grp * 128 + oc * 8 : 3072 + grp * 128 + (oc - 16) * 8);
        float wa0[8], wa1[8], wa2[8], ba[8];
        *(float4*)wa0 = *(const float4*)(p.ssd_conv_w + cha); *(float4*)(wa0 + 4) = *(const float4*)(p.ssd_conv_w + cha + 4);
        *(float4*)wa1 = *(const float4*)(p.ssd_conv_w + 4096 + cha); *(float4*)(wa1 + 4) = *(const float4*)(p.ssd_conv_w + 4096 + cha + 4);
        *(float4*)wa2 = *(const float4*)(p.ssd_conv_w + 8192 + cha); *(float4*)(wa2 + 4) = *(const float4*)(p.ssd_conv_w + 8192 + cha + 4);
        *(float4*)ba = *(const float4*)(p.ssd_conv_b + cha); *(float4*)(ba + 4) = *(const float4*)(p.ssd_conv_b + cha + 4);
        const int cx = h * 64 + (tid & 63);
        const float wx0 = p.ssd_conv_w[cx], wx1 = p.ssd_conv_w[4096 + cx], wx2 = p.ssd_conv_w[8192 + cx], bx = p.ssd_conv_b[cx];
        u16* ydst = (u16*)(p.ws + (d ? WS_YB : WS_G));
        uint4 pa[6]; unsigned px[10]; unsigned pdt = 0;
#define SSD_PREFETCH(T0) do { const int _t0 = (T0); \
            _Pragma("unroll") for (int k = 0; k < 6; ++k) { const int tp = _t0 + tq * 4 - 1 + k; \
                pa[k] = (tp >= 0 && tp < L) ? *(const uint4*)(P + (size_t)(row0 + tp) * NINP + 2048 + cha) : make_uint4(0u, 0u, 0u, 0u); } \
            _Pragma("unroll") for (int k = 0; k < 10; ++k) { const int tp = _t0 + (tid >> 6) * 8 - 1 + k; \
                px[k] = (tp >= 0 && tp < L) ? (unsigned)P[(size_t)(row0 + tp) * NINP + 2048 + cx] : 0u; } \
            if (wave == 0) pdt = (unsigned)P[(size_t)(row0 + _t0 + lane) * NINP + 6144 + d * 32 + h]; } while (0)
        SSD_PREFETCH((d ? nchunk - 1 : 0) * 64);
        for (int ci = 0; ci < nchunk; ++ci) {
            const int t0 = (d ? nchunk - 1 - ci : ci) * 64;
            if (wave == 0) {
                const float raw = bf2f((u16)pdt);
                const float dt = softplusf(raw + dtb), la = dt * a_neg;
                const float c = wave_prefix_sum(la);
                const float tot = wave_last(c);
                const float cm = d ? (tot - c + la) : c;
                cum[lane] = cm; dtv[lane] = dt; ecum[lane] = __expf(cm); wgt[lane] = dt * __expf(tot - cm);
                if (lane == 0) misc[0] = __expf(tot);
            }
            __syncthreads();
            {
                float rw[6][8];
#pragma unroll
                for (int k = 0; k < 6; ++k) unpack8(pa[k], rw[k]);
#pragma unroll
                for (int m = 0; m < 4; ++m) { float o[8];
#pragma unroll
                    for (int k = 0; k < 8; ++k) o[k] = siluf(wa0[k] * rw[m][k] + wa1[k] * rw[m + 1][k] + wa2[k] * rw[m + 2][k] + ba[k]);
                    *(uint4*)((oc < 16 ? Bs : Cs) + (tq * 4 + m) * 144 + (oc & 15) * 8) = pack8(o); }
            }
            {
                const int c = tid & 63, j0 = (tid >> 6) * 8;
                float o[8], ow[8];
                const fx4 wg0 = *(const fx4*)(wgt + j0), wg1 = *(const fx4*)(wgt + j0 + 4);
#pragma unroll
                for (int k = 0; k < 8; ++k) { o[k] = siluf(wx0 * bf2f((u16)px[k]) + wx1 * bf2f((u16)px[k + 1]) + wx2 * bf2f((u16)px[k + 2]) + bx); ow[k] = o[k] * (k < 4 ? wg0[k & 3] : wg1[k & 3]); }
                *(uint4*)(XT + c * 80 + j0) = pack8(o); *(uint4*)(XwT + c * 80 + j0) = pack8(ow);
            }
            __syncthreads();
            if (ci + 1 < nchunk) SSD_PREFETCH((d ? nchunk - 2 - ci : ci + 1) * 64);
#pragma unroll
            for (int it = 0; it < 2; ++it) {
                const int n = tid & 127, j0 = ((tid >> 7) + 4 * it) * 8;
                uint4 w; unsigned e[8];
#pragma unroll
                for (int k = 0; k < 8; ++k) e[k] = Bs[(j0 + k) * 144 + n];
                w.x = e[0] | (e[1] << 16); w.y = e[2] | (e[3] << 16); w.z = e[4] | (e[5] << 16); w.w = e[6] | (e[7] << 16);
                *(uint4*)(BT + n * 80 + j0) = w;
            }
#pragma unroll
            for (int tt = 0; tt < 2; ++tt) {
                const int id = wave * 2 + tt, jt = id >> 2, it = id & 3;
                fx4 acc = {0.f, 0.f, 0.f, 0.f};
#pragma unroll
                for (int ks = 0; ks < 4; ++ks) acc = mma16(*(const bfx8*)(Bs + (jt * 16 + fr) * 144 + ks * 32 + fq * 8), *(const bfx8*)(Cs + (it * 16 + fr) * 144 + ks * 32 + fq * 8), acc);
                asm volatile("s_nop 15" : "+v"(acc));
                const int i = it * 16 + fr; const float cmi = cum[i];
                const fx4 cj = *(const fx4*)(cum + jt * 16 + 4 * fq), dj = *(const fx4*)(dtv + jt * 16 + 4 * fq);
                fx4 m;
#pragma unroll
                for (int r = 0; r < 4; ++r) { const int j = jt * 16 + 4 * fq + r; const bool valid = d ? (j >= i) : (j <= i);
                    const float e = __expf(valid ? cmi - cj[r] : 0.f) * dj[r]; m[r] = valid ? acc[r] * e : 0.f; }
                *(uint2*)(Ms + i * 80 + jt * 16 + 4 * fq) = pack4v(m);
            }
            __syncthreads();
#pragma unroll
            for (int tt = 0; tt < 2; ++tt) {
                const int id = wave * 2 + tt, pt = id >> 2, it = id & 3;
                fx4 acc = {0.f, 0.f, 0.f, 0.f};
#pragma unroll
                for (int ks = 0; ks < 4; ++ks) acc = mma16(*(const bfx8*)(Sb + (pt * 16 + fr) * 144 + ks * 32 + fq * 8), *(const bfx8*)(Cs + (it * 16 + fr) * 144 + ks * 32 + fq * 8), acc);
                asm volatile("s_nop 15" : "+v"(acc));
                const int i = it * 16 + fr; const float e = ecum[i];
                acc *= e;
#pragma unroll
                for (int ks = 0; ks < 2; ++ks) acc = mma16(*(const bfx8*)(XT + (pt * 16 + fr) * 80 + ks * 32 + fq * 8), *(const bfx8*)(Ms + (it * 16 + fr) * 80 + ks * 32 + fq * 8), acc);
                asm volatile("s_nop 15" : "+v"(acc));
                if (d == 0) {
#pragma unroll
                    for (int r = 0; r < 4; ++r) acc[r] += dskip * bf2f(XT[(pt * 16 + 4 * fq + r) * 80 + i]);
                }
                *(uint2*)(ydst + (size_t)(row0 + t0 + i) * DI + h * 64 + pt * 16 + 4 * fq) = pack4v(acc);
            }
            {
                const float cd = misc[0];
#pragma unroll
                for (int pt = 0; pt < 4; ++pt) {
                    st[pt] *= cd;
#pragma unroll
                    for (int ks = 0; ks < 2; ++ks) st[pt] = mma16(*(const bfx8*)(BT + (wave * 16 + fr) * 80 + ks * 32 + fq * 8), *(const bfx8*)(XwT + (pt * 16 + fr) * 80 + ks * 32 + fq * 8), st[pt]);
                    asm volatile("s_nop 15" : "+v"(st[pt]));
                }
            }
            __syncthreads();
#pragma unroll
            for (int pt = 0; pt < 4; ++pt) *(uint2*)(Sb + (pt * 16 + fr) * 144 + n0) = pack4v(st[pt]);
        }
        if (g == 0) {
#pragma unroll
            for (int pt = 0; pt < 4; ++pt) *(fx4*)(p.out + (d ? OUT_SSD_B : OUT_SSD_F) + ((size_t)(seq * 32 + h) * 64 + pt * 16 + fr) * 128 + n0) = st[pt];
        }
        __syncthreads();
    }
}
__device__ __forceinline__ void ssd_combine_phase(const Params& p) {
    const int tid = otid(), wave = tid >> 6, lane = tid & 63;
    u16* YF = (u16*)(p.ws + WS_G); const u16* YB = (const u16*)(p.ws + WS_YB); const u16* P = (const u16*)(p.ws + WS_P);
    for (int row = blockIdx.x * 8 + wave; row < TG; row += gridDim.x * 8) {
        float gv[32]; float ss = 0.f;
#pragma unroll
        for (int i = 0; i < 4; ++i) { const int c = i * 512 + lane * 8;
            float a[8], b[8], z[8]; unpack8(ldnt16(YF + (size_t)row * DI + c), a); unpack8(ldnt16(YB + (size_t)row * DI + c), b); unpack8(ldnt16(P + (size_t)row * NINP + c), z);
#pragma unroll
            for (int j = 0; j < 8; ++j) { const float v = (a[j] + b[j]) * siluf(z[j]); gv[i * 8 + j] = v; ss += v * v; } }
        ss = wave_sum(ss);
        const float r = rsqrtf(ss * (1.f / 2048.f) + 1e-6f);
#pragma unroll
        for (int i = 0; i < 4; ++i) { const int c = i * 512 + lane * 8; float nw[8], o[8];
            *(float4*)nw = *(const float4*)(p.ssd_norm_w + c); *(float4*)(nw + 4) = *(const float4*)(p.ssd_norm_w + c + 4);
#pragma unroll
            for (int j = 0; j < 8; ++j) o[j] = gv[i * 8 + j] * r * nw[j];
            *(uint4*)(YF + (size_t)row * DI + c) = pack8(o); }
    }
}
__device__ __forceinline__ void gdn_scan_phase(const Params& p, int g, float* lds) {
    const int tid = otid(), wave = tid >> 6, lane = tid & 63;
    const int L = g == 0 ? 256 : 2048, nseq = g == 0 ? 32 : 4, nitems = nseq * 64;
    float* qs = lds; float* ks = lds + 4096; float* vs = lds + 8192; float* obuf = lds + 10240; float* egs = lds + 12288; float* betas = lds + 12320; float* kqs = lds + 12352;
    const u16* P = (const u16*)(p.ws + WS_P);
    const int tok = tid >> 4, cgi = tid & 15;
    const int dvl = lane >> 3, dkg = lane & 7, dv = wave * 8 + dvl;
    for (int item = blockIdx.x; item < nitems; item += gridDim.x) {
        const int e = item & 1, d = (item >> 1) & 1, hv = (item >> 2) & 15, seq = item >> 6, kh = hv >> 1;
        const int row0 = seq * L;
        const float a_neg = -__expf(p.gdn_a_log[d * 16 + hv]), dtb = p.gdn_dt_bias[d * 16 + hv];
        float S[16];
        if (g == 0) {
#pragma unroll
            for (int i = 0; i < 16; ++i) S[i] = 0.f;
        } else {
            const float* s0 = (d ? p.st_gdn_b : p.st_gdn_f) + (size_t)(((g - 1) * 4 + seq) * 16 + hv) * 16384 + e * 64 + dv;
#pragma unroll
            for (int i = 0; i < 4; ++i)
#pragma unroll
                for (int j = 0; j < 4; ++j) S[4 * i + j] = s0[(size_t)(32 * i + 4 * dkg + j) * 128];
        }
        const int chq = kh * 128 + cgi * 8, chk = 1024 + kh * 128 + cgi * 8, chv = 2048 + hv * 128 + e * 64 + cgi * 4;
        u16* odst = (u16*)(p.ws + (d ? WS_YB : WS_G));
        for (int tile = 0; tile < L / 32; ++tile) {
            const int sidx = tile * 32 + tok; const int tp = d ? L - 1 - sidx : sidx;
            {
                const u16* r1 = P + (size_t)(row0 + tp) * NINP;
                const bool hm = tp > 0, hp = tp < L - 1;
                float q8[8], k8[8], v4[4];
                conv8(r1 + chq, NINP, hm, hp, p.gdn_conv_w + chq, 4096, q8);
                conv8(r1 + chk, NINP, hm, hp, p.gdn_conv_w + chk, 4096, k8);
                conv4(r1 + chv, NINP, hm, hp, p.gdn_conv_w + chv, 4096, v4);
                float sq = 0.f, sk = 0.f;
#pragma unroll
                for (int j = 0; j < 8; ++j) { q8[j] = siluf(q8[j]); k8[j] = siluf(k8[j]); sq += q8[j] * q8[j]; sk += k8[j] * k8[j]; }
                sq += __shfl_xor(sq, 1); sq += __shfl_xor(sq, 2); sq += __shfl_xor(sq, 4); sq += __shfl_xor(sq, 8);
                sk += __shfl_xor(sk, 1); sk += __shfl_xor(sk, 2); sk += __shfl_xor(sk, 4); sk += __shfl_xor(sk, 8);
                const float rq = rsqrtf(sq + 1e-6f) * 0.08838834764831845f, rk = rsqrtf(sk + 1e-6f);
                float kq = 0.f;
#pragma unroll
                for (int j = 0; j < 8; ++j) { q8[j] *= rq; k8[j] *= rk; kq += q8[j] * k8[j]; }
                kq += __shfl_xor(kq, 1); kq += __shfl_xor(kq, 2); kq += __shfl_xor(kq, 4); kq += __shfl_xor(kq, 8);
                *(float4*)(qs + tok * 128 + cgi * 8) = *(float4*)q8; *(float4*)(qs + tok * 128 + cgi * 8 + 4) = *(float4*)(q8 + 4);
                *(float4*)(ks + tok * 128 + cgi * 8) = *(float4*)k8; *(float4*)(ks + tok * 128 + cgi * 8 + 4) = *(float4*)(k8 + 4);
                float4 vo; vo.x = siluf(v4[0]); vo.y = siluf(v4[1]); vo.z = siluf(v4[2]); vo.w = siluf(v4[3]);
                *(float4*)(vs + tok * 64 + cgi * 4) = vo;
                if (cgi == 0) {
                    const float a_raw = bf2f(r1[6144 + d * 16 + hv]), b_raw = bf2f(r1[6176 + d * 16 + hv]);
                    egs[tok] = __expf(a_neg * softplusf(a_raw + dtb)); betas[tok] = 1.f / (1.f + __expf(-b_raw)); kqs[tok] = kq;
                }
            }
            __syncthreads();
            for (int tt = 0; tt < 32; ++tt) {
                const float eg = egs[tt], be = betas[tt], kq = kqs[tt], v = vs[tt * 64 + dv];
                float kk[16]; float u = 0.f, w = 0.f;
#pragma unroll
                for (int i = 0; i < 4; ++i) {
                    const float4 k4 = *(const float4*)(ks + tt * 128 + 32 * i + 4 * dkg), q4 = *(const float4*)(qs + tt * 128 + 32 * i + 4 * dkg);
                    kk[4 * i] = k4.x; kk[4 * i + 1] = k4.y; kk[4 * i + 2] = k4.z; kk[4 * i + 3] = k4.w;
                    u += S[4 * i] * k4.x + S[4 * i + 1] * k4.y + S[4 * i + 2] * k4.z + S[4 * i + 3] * k4.w;
                    w += S[4 * i] * q4.x + S[4 * i + 1] * q4.y + S[4 * i + 2] * q4.z + S[4 * i + 3] * q4.w;
                }
                u += __shfl_xor(u, 1); w += __shfl_xor(w, 1); u += __shfl_xor(u, 2); w += __shfl_xor(w, 2); u += __shfl_xor(u, 4); w += __shfl_xor(w, 4);
                const float delta = be * (v - eg * u);
#pragma unroll
                for (int i = 0; i < 16; ++i) S[i] = S[i] * eg + kk[i] * delta;
                if (dkg == 0) obuf[tt * 64 + dv] = eg * w + delta * kq;
            }
            __syncthreads();
            {   const float4 y = *(const float4*)(obuf + tok * 64 + cgi * 4); uint2 w; w.x = pk2(y.x, y.y); w.y = pk2(y.z, y.w);
                *(uint2*)(odst + (size_t)(row0 + tp) * DI + hv * 128 + e * 64 + cgi * 4) = w; }
        }
        if (g == 0) {
            float* so = p.out + (d ? OUT_GDN_B : OUT_GDN_F) + (size_t)(seq * 16 + hv) * 16384 + e * 64 + dv;
#pragma unroll
            for (int i = 0; i < 4; ++i)
#pragma unroll
                for (int j = 0; j < 4; ++j) so[(size_t)(32 * i + 4 * dkg + j) * 128] = S[4 * i + j];
        }
        __syncthreads();
    }
}

__device__ __forceinline__ void gdn_scan_mfma(const Params& p, int g, unsigned char* lds) {
    const int tid = otid(), wave = tid >> 6, lane = tid & 63, fr = lane & 15, fq = lane >> 4;
    const int L = g == 0 ? 256 : 2048, nseq = g == 0 ? 32 : 4, nitems = nseq * 64, nchunk = L / 64;
    float* R32 = (float*)lds; float* Adg = R32 + 64 * 64; u16* VnT = (u16*)(Adg + 64 * 20); u16* QKm = VnT + 64 * 80; u16* Abf = QKm + 64 * 80; u16* TB = Abf + 64 * 80; u16* RT = TB + 64 * 40;
    float* cum = (float*)(RT + 64 * 40); float* ecum = cum + 64; float* beta = cum + 128; float* edec = cum + 192; float* misc = cum + 256;
    u16* Kn = (u16*)(cum + 320); u16* Qn = Kn + 64 * 144; u16* KdT = Qn + 64 * 144; u16* ST = KdT + 128 * 80;
    const u16* P = (const u16*)(p.ws + WS_P);
    const int tok = tid >> 4, cgi = tid & 15;
    for (int item0 = ((gridDim.x & 7) == 0 ? (int)((blockIdx.x & 7) * (gridDim.x >> 3) + (blockIdx.x >> 3)) : (int)blockIdx.x); item0 < nitems; item0 += gridDim.x) {
        const int item = item0;
        const int e = item & 1, d = (item >> 1) & 1, hv = (item >> 2) & 15, seq = item >> 6, kh = hv >> 1;
        const int row0 = seq * L;
        const float a_neg = -__expf(p.gdn_a_log[d * 16 + hv]), dtb = p.gdn_dt_bias[d * 16 + hv];
        fx4 st[4];
        const int dk0 = wave * 16 + 4 * fq;
#pragma unroll
        for (int pt = 0; pt < 4; ++pt) {
            if (g == 0) st[pt] = (fx4){0.f, 0.f, 0.f, 0.f};
            else { const float* s0 = (d ? p.st_gdn_b : p.st_gdn_f) + (size_t)(((g - 1) * 4 + seq) * 16 + hv) * 16384 + e * 64 + pt * 16 + fr;
#pragma unroll
                for (int r = 0; r < 4; ++r) st[pt][r] = s0[(size_t)(dk0 + r) * 128]; }
            *(uint2*)(ST + (pt * 16 + fr) * 144 + dk0) = pack4v(st[pt]);
        }
        for (int z = tid; z < 640; z += NTHREADS) ((uint4*)TB)[z] = make_uint4(0u, 0u, 0u, 0u);
        u16* odst = (u16*)(p.ws + (d ? WS_YB : WS_G));
        uint4 pq[4], pk[4]; uint2 pv[4]; unsigned pa_raw = 0, pb_raw = 0;
#define GDN_PREFETCH(T0) do { const int _t0 = (T0); const int _tok = tid >> 4, _cg = tid & 15; \
            const int _tpl = d ? _t0 + 62 - 2 * _tok : _t0 + 2 * _tok; \
            _Pragma("unroll") for (int k = 0; k < 4; ++k) { const int tp = _tpl - 1 + k; const bool ok = tp >= 0 && tp < L; const u16* r1 = P + (size_t)(row0 + tp) * NINP; \
                pq[k] = ok ? *(const uint4*)(r1 + kh * 128 + _cg * 8) : make_uint4(0u, 0u, 0u, 0u); \
                pk[k] = ok ? *(const uint4*)(r1 + 1024 + kh * 128 + _cg * 8) : make_uint4(0u, 0u, 0u, 0u); \
                pv[k] = ok ? *(const uint2*)(r1 + 2048 + hv * 128 + e * 64 + _cg * 4) : make_uint2(0u, 0u); } \
            if ((tid >> 6) == 0) { const int tp = d ? _t0 + 63 - (tid & 63) : _t0 + (tid & 63); const u16* r1 = P + (size_t)(row0 + tp) * NINP; \
                pa_raw = (unsigned)r1[6144 + d * 16 + hv]; pb_raw = (unsigned)r1[6176 + d * 16 + hv]; } } while (0)
        GDN_PREFETCH((d ? nchunk - 1 : 0) * 64);
        float wq[3][8], wk[3][8], wv[3][4];
        { const int _cg = tid & 15; const int chq = kh * 128 + _cg * 8, chk = 1024 + kh * 128 + _cg * 8, chv = 2048 + hv * 128 + e * 64 + _cg * 4;
#pragma unroll
          for (int t = 0; t < 3; ++t) {
            *(float4*)wq[t] = *(const float4*)(p.gdn_conv_w + t * 4096 + chq); *(float4*)(wq[t] + 4) = *(const float4*)(p.gdn_conv_w + t * 4096 + chq + 4);
            *(float4*)wk[t] = *(const float4*)(p.gdn_conv_w + t * 4096 + chk); *(float4*)(wk[t] + 4) = *(const float4*)(p.gdn_conv_w + t * 4096 + chk + 4);
            *(float4*)wv[t] = *(const float4*)(p.gdn_conv_w + t * 4096 + chv); } }
        for (int ci = 0; ci < nchunk; ++ci) {
            const int t0 = (d ? nchunk - 1 - ci : ci) * 64;
            const int tid = otid(), wave = tid >> 6, lane = tid & 63, fr = lane & 15, fq = lane >> 4, tok = tid >> 4, cgi = tid & 15, dk0 = wave * 16 + 4 * fq;
            int lz = 0; asm volatile("" : "+v"(lz));
            unsigned char* lb = lds + lz;
            float* R32 = (float*)lb; float* Adg = R32 + 64 * 64; u16* VnT = (u16*)(Adg + 64 * 20); u16* QKm = VnT + 64 * 80; u16* Abf = QKm + 64 * 80; u16* TB = Abf + 64 * 80; u16* RT = TB + 64 * 40;
            float* cum = (float*)(RT + 64 * 40); float* ecum = cum + 64; float* beta = cum + 128; float* edec = cum + 192; float* misc = cum + 256;
            u16* Kn = (u16*)(cum + 320); u16* Qn = Kn + 64 * 144; u16* KdT = Qn + 64 * 144; u16* ST = KdT + 128 * 80;
            const int chq = kh * 128 + cgi * 8, chk = 1024 + kh * 128 + cgi * 8, chv = 2048 + hv * 128 + e * 64 + cgi * 4;
            if (wave == 0) {
                const float a_raw = bf2f((u16)pa_raw), b_raw = bf2f((u16)pb_raw);
                const float c = wave_prefix_sum(a_neg * softplusf(a_raw + dtb));
                const float tot = wave_last(c);
                cum[lane] = c; ecum[lane] = __expf(c); beta[lane] = __builtin_amdgcn_rcpf(1.f + __expf(-b_raw)); edec[lane] = __expf(tot - c);
                if (lane == 0) misc[0] = __expf(tot);
            }
            __syncthreads();
            for (int z = tid; z < 640; z += NTHREADS) ((uint4*)VnT)[z] = make_uint4(0u, 0u, 0u, 0u);
            {
                float rq[4][8], rk[4][8], rv[4][4];
#pragma unroll
                for (int k = 0; k < 4; ++k) { unpack8(pq[k], rq[k]); unpack8(pk[k], rk[k]); unpack4(pv[k], rv[k]); }
#pragma unroll
                for (int m = 0; m < 2; ++m) {
                    const int i = (m == 0) ? (d ? 2 * tok + 1 : 2 * tok) : (d ? 2 * tok : 2 * tok + 1);
                    float q8[8], k8[8], v4[4]; float sq = 0.f, sk = 0.f;
#pragma unroll
                    for (int k = 0; k < 8; ++k) { q8[k] = siluf(wq[0][k] * rq[m][k] + wq[1][k] * rq[m + 1][k] + wq[2][k] * rq[m + 2][k]); sq += q8[k] * q8[k];
                        k8[k] = siluf(wk[0][k] * rk[m][k] + wk[1][k] * rk[m + 1][k] + wk[2][k] * rk[m + 2][k]); sk += k8[k] * k8[k]; }
#pragma unroll
                    for (int k = 0; k < 4; ++k) v4[k] = siluf(wv[0][k] * rv[m][k] + wv[1][k] * rv[m + 1][k] + wv[2][k] * rv[m + 2][k]);
                    sq += __shfl_xor(sq, 1); sq += __shfl_xor(sq, 2); sq += __shfl_xor(sq, 4); sq += __shfl_xor(sq, 8);
                    sk += __shfl_xor(sk, 1); sk += __shfl_xor(sk, 2); sk += __shfl_xor(sk, 4); sk += __shfl_xor(sk, 8);
                    const float rqn = rsqrtf(sq + 1e-6f) * 0.08838834764831845f, rkn = rsqrtf(sk + 1e-6f);
#pragma unroll
                    for (int k = 0; k < 8; ++k) { q8[k] *= rqn; k8[k] *= rkn; }
                    *(uint4*)(Qn + i * 144 + cgi * 8) = pack8(q8); *(uint4*)(Kn + i * 144 + cgi * 8) = pack8(k8);
                    const float bi = beta[i];
                    float4 rvv; rvv.x = bi * v4[0]; rvv.y = bi * v4[1]; rvv.z = bi * v4[2]; rvv.w = bi * v4[3];
                    *(float4*)(R32 + i * 64 + cgi * 4) = rvv;
                }
            }
            __syncthreads();
            if (ci + 1 < nchunk) GDN_PREFETCH((d ? nchunk - 2 - ci : ci + 1) * 64);
#pragma unroll
            for (int tt = 0; tt < 2; ++tt) {
                const int id = wave * 2 + tt, jt = id >> 2, it = id & 3;
                fx4 accA = {0.f, 0.f, 0.f, 0.f}, accQ = {0.f, 0.f, 0.f, 0.f};
#pragma unroll
                for (int ks = 0; ks < 4; ++ks) { const bfx8 a = *(const bfx8*)(Kn + (jt * 16 + fr) * 144 + ks * 32 + fq * 8);
                    accA = mma16(a, *(const bfx8*)(Kn + (it * 16 + fr) * 144 + ks * 32 + fq * 8), accA);
                    accQ = mma16(a, *(const bfx8*)(Qn + (it * 16 + fr) * 144 + ks * 32 + fq * 8), accQ); }
                asm volatile("s_nop 15" : "+v"(accA), "+v"(accQ));
                const int i = it * 16 + fr; const float cmi = cum[i], bi = beta[i];
                const fx4 cj = *(const fx4*)(cum + jt * 16 + 4 * fq);
                fx4 mA, mQ;
#pragma unroll
                for (int r = 0; r < 4; ++r) { const int j = jt * 16 + 4 * fq + r;
                    const float dec = __expf(j <= i ? cmi - cj[r] : 0.f);
                    mA[r] = j < i ? bi * accA[r] * dec : 0.f; mQ[r] = j <= i ? accQ[r] * dec : 0.f; }
                *(uint2*)(Abf + i * 80 + jt * 16 + 4 * fq) = pack4v(mA);
                if (jt == it) *(fx4*)(Adg + i * 20 + 4 * fq) = mA;
                *(uint2*)(QKm + i * 80 + jt * 16 + 4 * fq) = pack4v(mQ);
            }
            __syncthreads();
            if (wave == 4) {
                const int tb = lane >> 4, tc = lane & 15;
                float t[16]; float4 nx[4];
#pragma unroll
                for (int j4 = 0; j4 < 1; ++j4) nx[j4] = *(const float4*)(Adg + (tb * 16 + 1) * 20 + j4 * 4);
#pragma unroll
                for (int i = 0; i < 16; ++i) {
                    float4 cu[4];
#pragma unroll
                    for (int j4 = 0; j4 < 4; ++j4) cu[j4] = nx[j4];
                    if (i >= 1 && i < 15) {
#pragma unroll
                        for (int j4 = 0; j4 < (i + 4) / 4; ++j4) nx[j4] = *(const float4*)(Adg + (tb * 16 + i + 1) * 20 + j4 * 4);
                    }
                    float acc = (i == tc) ? 1.f : 0.f;
#pragma unroll
                    for (int j4 = 0; j4 < (i + 3) / 4; ++j4) {
                        const float4 a = cu[j4];
                        if (j4 * 4 + 0 < i) acc -= a.x * t[j4 * 4 + 0];
                        if (j4 * 4 + 1 < i) acc -= a.y * t[j4 * 4 + 1];
                        if (j4 * 4 + 2 < i) acc -= a.z * t[j4 * 4 + 2];
                        if (j4 * 4 + 3 < i) acc -= a.w * t[j4 * 4 + 3];
                    }
                    t[i] = acc;
                    __builtin_amdgcn_sched_barrier(0);
                }
#pragma unroll
                for (int i = 0; i < 16; ++i) TB[(tb * 16 + i) * 40 + tc] = (u16)(pk2(t[i], 0.f) & 0xffffu);
            }
            fx4 oacc[2];
#pragma unroll
            for (int tt = 0; tt < 2; ++tt) {
                const int id = wave * 2 + tt, pt = id >> 2, it = id & 3;
                fx4 accK = {0.f, 0.f, 0.f, 0.f}, accQ = {0.f, 0.f, 0.f, 0.f};
#pragma unroll
                for (int ks = 0; ks < 4; ++ks) { const bfx8 a = *(const bfx8*)(ST + (pt * 16 + fr) * 144 + ks * 32 + fq * 8);
                    accK = mma16(a, *(const bfx8*)(Kn + (it * 16 + fr) * 144 + ks * 32 + fq * 8), accK);
                    accQ = mma16(a, *(const bfx8*)(Qn + (it * 16 + fr) * 144 + ks * 32 + fq * 8), accQ); }
                asm volatile("s_nop 15" : "+v"(accK), "+v"(accQ));
                const int i = it * 16 + fr; const float ei = ecum[i], bei = beta[i] * ei;
                fx4 rr = *(const fx4*)(R32 + i * 64 + pt * 16 + 4 * fq);
                rr -= accK * bei;
                *(fx4*)(R32 + i * 64 + pt * 16 + 4 * fq) = rr;
                oacc[tt] = accQ * ei;
            }
            __syncthreads();
            if (wave >= 4) {
                const int t4 = tid - 256;
#pragma unroll
                for (int it2 = 0; it2 < 4; ++it2) {
                    const int dk = t4 & 127, j0 = ((t4 >> 7) + 2 * it2) * 8;
                    const fx4 ed0 = *(const fx4*)(edec + j0), ed1 = *(const fx4*)(edec + j0 + 4);
                    float o[8];
#pragma unroll
                    for (int k = 0; k < 8; ++k) o[k] = bf2f(Kn[(j0 + k) * 144 + dk]) * (k < 4 ? ed0[k & 3] : ed1[k & 3]);
                    *(uint4*)(KdT + dk * 80 + j0) = pack8(o);
                }
            }
            if (wave < 4) {
#pragma unroll
                for (int b = 0; b < 4; ++b) {
                    fx4 u = {0.f, 0.f, 0.f, 0.f};
                    if (b > 0) {
#pragma unroll
                        for (int ks = 0; ks < 2; ++ks) u = mma16(*(const bfx8*)(VnT + (wave * 16 + fr) * 80 + ks * 32 + fq * 8), *(const bfx8*)(Abf + (b * 16 + fr) * 80 + ks * 32 + fq * 8), u);
                        asm volatile("s_nop 15" : "+v"(u));
                    }
                    fx4 rr = *(const fx4*)(R32 + (b * 16 + fr) * 64 + wave * 16 + 4 * fq);
                    rr -= u;
#pragma unroll
                    for (int r = 0; r < 4; ++r) RT[(wave * 16 + 4 * fq + r) * 40 + fr] = (u16)(pk2(rr[r], 0.f) & 0xffffu);
                    asm volatile("s_waitcnt lgkmcnt(0)" ::: "memory");
                    fx4 xb = {0.f, 0.f, 0.f, 0.f};
                    xb = mma16(*(const bfx8*)(RT + (wave * 16 + fr) * 40 + fq * 8), *(const bfx8*)(TB + (b * 16 + fr) * 40 + fq * 8), xb);
                    asm volatile("s_nop 15" : "+v"(xb));
#pragma unroll
                    for (int r = 0; r < 4; ++r) VnT[(wave * 16 + 4 * fq + r) * 80 + b * 16 + fr] = (u16)(pk2(xb[r], 0.f) & 0xffffu);
                    asm volatile("s_waitcnt lgkmcnt(0)" ::: "memory");
                }
            }
            __syncthreads();
#pragma unroll
            for (int tt = 0; tt < 2; ++tt) {
                const int id = wave * 2 + tt, pt = id >> 2, it = id & 3;
#pragma unroll
                for (int ks = 0; ks < 2; ++ks) oacc[tt] = mma16(*(const bfx8*)(VnT + (pt * 16 + fr) * 80 + ks * 32 + fq * 8), *(const bfx8*)(QKm + (it * 16 + fr) * 80 + ks * 32 + fq * 8), oacc[tt]);
                asm volatile("s_nop 15" : "+v"(oacc[tt]));
                const int i = it * 16 + fr, tp = d ? t0 + 63 - i : t0 + i;
                *(uint2*)(odst + (size_t)(row0 + tp) * DI + hv * 128 + e * 64 + pt * 16 + 4 * fq) = pack4v(oacc[tt]);
            }
            __syncthreads();
            {
                const float cd = misc[0];
#pragma unroll
                for (int pt = 0; pt < 4; ++pt) {
                    st[pt] *= cd;
#pragma unroll
                    for (int ks = 0; ks < 2; ++ks) st[pt] = mma16(*(const bfx8*)(KdT + (wave * 16 + fr) * 80 + ks * 32 + fq * 8), *(const bfx8*)(VnT + (pt * 16 + fr) * 80 + ks * 32 + fq * 8), st[pt]);
                    asm volatile("s_nop 15" : "+v"(st[pt]));
                }
            }
            __syncthreads();
#pragma unroll
            for (int pt = 0; pt < 4; ++pt) *(uint2*)(ST + (pt * 16 + fr) * 144 + dk0) = pack4v(st[pt]);
        }
        if (g == 0) {
            float* so = p.out + (d ? OUT_GDN_B : OUT_GDN_F) + (size_t)(seq * 16 + hv) * 16384 + e * 64;
#pragma unroll
            for (int pt = 0; pt < 4; ++pt)
#pragma unroll
                for (int r = 0; r < 4; ++r) so[(size_t)(dk0 + r) * 128 + pt * 16 + fr] = st[pt][r];
        }
        __syncthreads();
    }
}
__device__ __forceinline__ void gdn_combine_phase(const Params& p) {
    const int tid = otid(), wave = tid >> 6, lane = tid & 63;
    u16* YF = (u16*)(p.ws + WS_G); const u16* YB = (const u16*)(p.ws + WS_YB); const u16* P = (const u16*)(p.ws + WS_P);
    float nw[8];
    *(float4*)nw = *(const float4*)(p.gdn_norm_w + (lane & 15) * 8); *(float4*)(nw + 4) = *(const float4*)(p.gdn_norm_w + (lane & 15) * 8 + 4);
    for (int row = blockIdx.x * 8 + wave; row < TG; row += gridDim.x * 8) {
#pragma unroll
        for (int i = 0; i < 4; ++i) { const int c = i * 512 + lane * 8;
            float a[8], b[8], z[8], o[8]; unpack8(ldnt16(YF + (size_t)row * DI + c), a); unpack8(ldnt16(YB + (size_t)row * DI + c), b); unpack8(ldnt16(P + (size_t)row * NINP + 4096 + c), z);
            float ss = 0.f;
#pragma unroll
            for (int j = 0; j < 8; ++j) { a[j] += b[j]; ss += a[j] * a[j]; }
            ss += __shfl_xor(ss, 1); ss += __shfl_xor(ss, 2); ss += __shfl_xor(ss, 4); ss += __shfl_xor(ss, 8);
            const float r = rsqrtf(ss * (1.f / 128.f) + 1e-6f);
#pragma unroll
            for (int j = 0; j < 8; ++j) o[j] = a[j] * r * nw[j] * siluf(z[j]);
            *(uint4*)(YF + (size_t)row * DI + c) = pack8(o); }
    }
}
__device__ __forceinline__ void ln_phase(const Params& p, int l, int which, int g, int wg0, int nwg) {
    const int tid = otid(), wave = tid >> 6, lane = tid & 63;
    if ((int)blockIdx.x < wg0) return;
    const u16* O = (const u16*)(p.ws + (which ? WS_YB : WS_P));
    const float* adab = (const float*)(p.ws + WS_ADA); u16* H = (u16*)(p.ws + WS_H);
    const float* lg = p.ln_g + (l * 2 + which) * 1024; const float* lb = p.ln_b + (l * 2 + which) * 1024;
    const bool has_next = !(l == 1 && which == 1);
    for (int row = ((int)blockIdx.x - wg0) * 8 + wave; row < TG; row += nwg * 8) {
        const int t = g * TG + row, cond = cond_of(t);
        const float* xr = (l == 0 && which == 0) ? xin_row(p, t) : p.out + (size_t)t * D;
        const float* ada = adab + (size_t)(l * 9 + cond) * 6144;
        const float* gate = ada + (which ? 5120 : 2048);
        float v[16]; float s = 0.f;
#pragma unroll
        for (int i = 0; i < 4; ++i) { const int c = i * 256 + lane * 4;
            const float4 x = ldnt16f(xr + c), gt = *(const float4*)(gate + c);
            float o0[4], o1[4]; unpack4(ldnt8(O + (size_t)row * D + c), o0); unpack4(ldnt8(O + (size_t)TG * D + (size_t)row * D + c), o1);
            float4 o; o.x = o0[0] + o1[0]; o.y = o0[1] + o1[1]; o.z = o0[2] + o1[2]; o.w = o0[3] + o1[3];
            v[4 * i] = ALPHA * x.x + gt.x * o.x; v[4 * i + 1] = ALPHA * x.y + gt.y * o.y; v[4 * i + 2] = ALPHA * x.z + gt.z * o.z; v[4 * i + 3] = ALPHA * x.w + gt.w * o.w;
            s += v[4 * i] + v[4 * i + 1] + v[4 * i + 2] + v[4 * i + 3]; }
        const float mean = wave_sum(s) * (1.f / 1024.f);
        float q = 0.f;
#pragma unroll
        for (int i = 0; i < 16; ++i) { v[i] -= mean; q += v[i] * v[i]; }
        const float rstd = rsqrtf(wave_sum(q) * (1.f / 1024.f) + 1e-5f);
        const float* nsh = which == 0 ? ada + 3072 : adab + (size_t)((l + 1) * 9 + cond) * 6144;
        const float* nsc = nsh + 1024;
#pragma unroll
        for (int i = 0; i < 4; ++i) { const int c = i * 256 + lane * 4;
            const float4 gg = *(const float4*)(lg + c), bb = *(const float4*)(lb + c);
            float4 y; y.x = v[4 * i] * rstd * gg.x + bb.x; y.y = v[4 * i + 1] * rstd * gg.y + bb.y; y.z = v[4 * i + 2] * rstd * gg.z + bb.z; y.w = v[4 * i + 3] * rstd * gg.w + bb.w;
            *(float4*)(p.out + (size_t)t * D + c) = y;
            if (has_next) { const float4 sh = *(const float4*)(nsh + c), sc = *(const float4*)(nsc + c);
                uint2 w; w.x = pk2(y.x * (1.f + sc.x) + sh.x, y.y * (1.f + sc.y) + sh.y); w.y = pk2(y.z * (1.f + sc.z) + sh.z, y.w * (1.f + sc.w) + sh.w);
                *(uint2*)(H + (size_t)t * D + c) = w; } }
    }
}
__device__ __forceinline__ void convgate_phase(const Params& p, int l, int g) {
    const int tid = otid();
    const u16* U = (const u16*)(p.ws + WS_P); u16* G = (u16*)(p.ws + WS_G);
    const int rpb = (TG + gridDim.x - 1) / gridDim.x;
    const int r_lo = blockIdx.x * rpb, r_hi = min(TG, r_lo + rpb);
    if (tid >= 352) return;
    const int c = tid * 8;
    const float* cw = p.ffn_conv_w + (size_t)l * 9 * FF + c;
    float bias[8]; *(float4*)bias = *(const float4*)(p.ffn_conv_b + l * FF + c); *(float4*)(bias + 4) = *(const float4*)(p.ffn_conv_b + l * FF + c + 4);
    if (g == 0) {
        float w[3][8];
#pragma unroll
        for (int j = 0; j < 3; ++j) { *(float4*)w[j] = *(const float4*)(cw + (3 + j) * FF); *(float4*)(w[j] + 4) = *(const float4*)(cw + (3 + j) * FF + 4); }
        for (int row = r_lo; row < r_hi; ++row) {
            const int tp = row & 255;
            uint4 dv[3];
#pragma unroll
            for (int j = 0; j < 3; ++j) { const bool ok = (unsigned)(tp + j - 1) < 256u; dv[j] = *(const uint4*)(U + (size_t)(row + (ok ? j - 1 : 0)) * FF2 + c); }
            const uint4 vraw = *(const uint4*)(U + (size_t)row * FF2 + FF + c);
            float acc[8];
#pragma unroll
            for (int k = 0; k < 8; ++k) acc[k] = bias[k];
#pragma unroll
            for (int j = 0; j < 3; ++j) { const float m = (unsigned)(tp + j - 1) < 256u ? 1.f : 0.f; float a[8]; unpack8(dv[j], a);
#pragma unroll
                for (int k = 0; k < 8; ++k) acc[k] += (m * w[j][k]) * a[k]; }
            float vv[8], o[8]; unpack8(vraw, vv);
#pragma unroll
            for (int k = 0; k < 8; ++k) o[k] = siluf(acc[k]) * vv[k];
            *(uint4*)(G + (size_t)row * FF + c) = pack8(o);
        }
    } else {
        float w[9][8];
#pragma unroll
        for (int t = 0; t < 9; ++t) { *(float4*)w[t] = *(const float4*)(cw + t * FF); *(float4*)(w[t] + 4) = *(const float4*)(cw + t * FF + 4); }
        for (int row = r_lo; row < r_hi; ++row) {
            const int tp = row & 2047, gr = tp >> 6, gc = tp & 63;
            uint4 dv[9];
#pragma unroll
            for (int i = 0; i < 3; ++i)
#pragma unroll
                for (int j = 0; j < 3; ++j) { const bool ok = (unsigned)(gr + i - 1) < 32u && (unsigned)(gc + j - 1) < 64u;
                    dv[i * 3 + j] = *(const uint4*)(U + (size_t)(row + (ok ? (i - 1) * 64 + (j - 1) : 0)) * FF2 + c); }
            const uint4 vraw = *(const uint4*)(U + (size_t)row * FF2 + FF + c);
            float acc[8];
#pragma unroll
            for (int k = 0; k < 8; ++k) acc[k] = bias[k];
#pragma unroll
            for (int i = 0; i < 3; ++i)
#pragma unroll
                for (int j = 0; j < 3; ++j) { const float m = ((unsigned)(gr + i - 1) < 32u && (unsigned)(gc + j - 1) < 64u) ? 1.f : 0.f; float a[8]; unpack8(dv[i * 3 + j], a);
#pragma unroll
                    for (int k = 0; k < 8; ++k) acc[k] += (m * w[i * 3 + j][k]) * a[k]; }
            float vv[8], o[8]; unpack8(vraw, vv);
#pragma unroll
            for (int k = 0; k < 8; ++k) o[k] = siluf(acc[k]) * vv[k];
            *(uint4*)(G + (size_t)row * FF + c) = pack8(o);
        }
    }
}
__device__ __forceinline__ void gemm_bf16out(PG8_LAS unsigned char* lds, const u16* A, const u16* Bt, u16* O, int M, int N, int K) {
    pg8::Gemm gg{A, Bt, M, N, K, K, N / 256}; pg8::StaticOrder S; S.init(M, N, (int)gridDim.x, (int)blockIdx.x);
    pg8::EpiBf16 E{O, N, N / 256, 0};
    pg8::gemm_phase<pg8::EpiBf16, pg8::StaticOrder>(lds, gg, S, E, nullptr);
}
__device__ __forceinline__ void gemm_f32out(PG8_LAS unsigned char* lds, const u16* A, const u16* Bt, float* C, int M, int N, int K) {
    pg8::Gemm gg{A, Bt, M, 2 * N, K / 2, K, N / 256}; pg8::StaticOrder S; S.init(M, 2 * N, (int)gridDim.x, (int)blockIdx.x);
    pg8::EpiBf16 E{(u16*)C, N, N / 256, (size_t)M * N};
    pg8::gemm_phase<pg8::EpiBf16, pg8::StaticOrder>(lds, gg, S, E, nullptr);
}


__device__ __forceinline__ void grid_bar(unsigned* ctr, unsigned target) {
    asm volatile("s_waitcnt vmcnt(0)" ::: "memory");
    __syncthreads();
    if (threadIdx.x < 64) {
        if (threadIdx.x == 0) {
            __builtin_amdgcn_fence(__ATOMIC_RELEASE, "agent");
            asm volatile("s_waitcnt vmcnt(0)" ::: "memory");
            __hip_atomic_fetch_add(ctr, 1u, __ATOMIC_RELAXED, __HIP_MEMORY_SCOPE_AGENT);
            while (__hip_atomic_load(ctr, __ATOMIC_RELAXED, __HIP_MEMORY_SCOPE_AGENT) < target) __builtin_amdgcn_s_sleep(1);
        }
        __builtin_amdgcn_fence(__ATOMIC_ACQUIRE, "agent");
        asm volatile("s_waitcnt vmcnt(0)" ::: "memory");
    }
    __syncthreads();
}

#define XB_TMO      128
#define XB_XCNT(j)  (256  + 64 * (j))
#define XB_XSUB(j)  (1280 + 64 * (j))
#define XB_XGEN(j)  (2304 + 64 * (j))
#define XB_TOP      3328
#define XB_TOPGEN   3392
#define XCD_BAR_WORDS 3456
#define XB_SPIN_CAP (1u << 18)
#define LAS __attribute__((address_space(3)))

__device__ __forceinline__ unsigned xb_ld(unsigned* p)              { return __hip_atomic_load(p, __ATOMIC_RELAXED, __HIP_MEMORY_SCOPE_AGENT); }
__device__ __forceinline__ unsigned xb_add(unsigned* p, unsigned v) { return __hip_atomic_fetch_add(p, v, __ATOMIC_RELAXED, __HIP_MEMORY_SCOPE_AGENT); }
__device__ __forceinline__ unsigned xb_xcc_id() { return (unsigned)__builtin_amdgcn_s_getreg((3 << 11) | 20) & 0xFu; }
#define XB_SPIN(cond, bar) do { unsigned _sp = 0; while (cond) { __builtin_amdgcn_s_sleep(1); \
    if ((++_sp & 255u) == 0u) { if (xb_ld(&(bar)[XB_TMO])) break; if (_sp > XB_SPIN_CAP) { atomicAdd(&(bar)[XB_TMO], 1u); break; } } } } while (0)
struct XcdBarrier {
    unsigned* bar; unsigned x;
    volatile LAS unsigned* st;
};

__device__ __forceinline__ XcdBarrier xcd_barrier_post(unsigned* bar, volatile LAS unsigned* st) {
    XcdBarrier b; b.bar = bar; b.x = xb_xcc_id(); b.st = st;
    if (threadIdx.x == 0) (void)xb_add(&bar[XB_XCNT(b.x)], 1u);
    return b;
}
__device__ __forceinline__ void xcd_barrier_complete(unsigned* bar, unsigned x, unsigned& nloc, unsigned& nx) {
    const unsigned G = gridDim.x * gridDim.y * gridDim.z;
    unsigned sum, cnt, mine, sp = 0u;
    for (;;) {
        sum = 0u; cnt = 0u; mine = 0u;
#pragma unroll
        for (unsigned j = 0; j < 16; ++j) { const unsigned c = xb_ld(&bar[XB_XCNT(j)]); sum += c; cnt += (c > 0u) ? 1u : 0u; mine = (j == x) ? c : mine; }
        if (sum == G) break;
        __builtin_amdgcn_s_sleep(1);
        if ((++sp & 255u) == 0u) { if (xb_ld(&bar[XB_TMO])) break; if (sp > XB_SPIN_CAP) { atomicAdd(&bar[XB_TMO], 1u); break; } }
    }
    nloc = mine > 0u ? mine : 1u; nx = cnt > 0u ? cnt : 1u;
}

__device__ __forceinline__ void xcd_barrier(const XcdBarrier& b) {
    asm volatile("s_waitcnt vmcnt(0)" ::: "memory");
    __syncthreads();
    if (threadIdx.x == 0) {
        unsigned* bar = b.bar;
        __builtin_amdgcn_s_waitcnt(0);
        unsigned nloc = b.st[0], nx = b.st[1];
        if (nloc == 0u) { xcd_barrier_complete(bar, b.x, nloc, nx); b.st[0] = nloc; b.st[1] = nx; }
        const unsigned old = xb_add(&bar[XB_XSUB(b.x)], 1u);
        const unsigned gen = old / nloc;
        if (old + 1u == (gen + 1u) * nloc) {
            __builtin_amdgcn_fence(__ATOMIC_RELEASE, "agent");
            asm volatile("s_waitcnt vmcnt(0)" ::: "memory");
            const unsigned og = xb_add(&bar[XB_TOP], 1u);
            const unsigned tg = og / nx;
            if (og + 1u == (tg + 1u) * nx) xb_add(&bar[XB_TOPGEN], 1u);
            else XB_SPIN(xb_ld(&bar[XB_TOPGEN]) == tg, bar);
            __builtin_amdgcn_fence(__ATOMIC_ACQUIRE, "agent");
            xb_add(&bar[XB_XGEN(b.x)], 1u);
            asm volatile("s_waitcnt vmcnt(0)" ::: "memory");
        } else {
            XB_SPIN(xb_ld(&bar[XB_XGEN(b.x)]) == gen, bar);
            __builtin_amdgcn_fence(__ATOMIC_ACQUIRE, "agent");
            asm volatile("s_waitcnt vmcnt(0)" ::: "memory");
        }
    }
    __syncthreads();
}


__global__ void __launch_bounds__(NTHREADS, 2) mega_fwd(Params p) {
    extern __shared__ __attribute__((aligned(16))) unsigned char lds_raw[];
    cg::grid_group grid = cg::this_grid();
    PG8_LAS unsigned char* ldsp = (PG8_LAS unsigned char*)lds_raw;
    float* ldsf = (float*)lds_raw;
    unsigned char* ws = p.ws;
    volatile LAS unsigned* xst = (volatile LAS unsigned*)((PG8_LAS unsigned char*)lds_raw + (LDS_BYTES - 16));
    if (threadIdx.x == 0) { xst[0] = 0u; xst[1] = 0u; }
    __syncthreads();
    const XcdBarrier xbar = xcd_barrier_post((unsigned*)(ws + WS_BAR), xst);
    for (int ph = p.ph_lo; ph < p.ph_hi; ++ph) {
        if (ph == 0) { for (int rep = 0; rep < REP_EW; ++rep) { prep_phase(p, ldsf); __syncthreads(); } }
        else if (ph == 1) { for (int rep = 0; rep < REP_EW; ++rep) mod0_phase(p); }
        else {
            const int q = ph - 2, gl = q >> 3, s = q & 7;
            const int l = gl / 3, g = gl % 3;
            const u16* wb = (const u16*)(ws + WS_W + (size_t)l * W_LAYER);
            const u16* Hg = (const u16*)(ws + WS_H) + (size_t)g * TG * D;
            const int G = (int)gridDim.x;
            if (gl == 6) ln_phase(p, 1, 1, 2, 0, G);
            else if (s == 0) {
                { for (int rep = 0; rep < REP_GEMM; ++rep) { gemm_bf16out(ldsp, Hg, wb + W_IN / 2, (u16*)(ws + WS_P), TG, NINP, D); __syncthreads(); } }
                if (gl > 0) {
                    const int lead = 800 - 3 * G, wg0 = (lead > 0 && lead < G) ? lead : 0;
                    ln_phase(p, (gl - 1) / 3, 1, (gl - 1) % 3, wg0, G - wg0);
                }
            }
            else if (s == 1) { for (int rep = 0; rep < REP_SCAN; ++rep) { if (l == 0) ssd_scan_mfma(p, g, lds_raw); else gdn_scan_mfma(p, g, lds_raw); __syncthreads(); } }
            else if (s == 2) { if (l == 0) ssd_combine_phase(p); else gdn_combine_phase(p); }
            else if (s == 3) { for (int rep = 0; rep < REP_GEMM; ++rep) { gemm_f32out(ldsp, (const u16*)(ws + WS_G), wb + W_OUT / 2, (float*)(ws + WS_P), TG, D, DI); __syncthreads(); } }
            else if (s == 4) ln_phase(p, l, 0, g, 0, G);
            else if (s == 5) { for (int rep = 0; rep < REP_GEMM; ++rep) { gemm_bf16out(ldsp, Hg, wb + W_UP / 2, (u16*)(ws + WS_P), TG, FF2, D); __syncthreads(); } }
            else if (s == 6) { for (int rep = 0; rep < REP_EW; ++rep) convgate_phase(p, l, g); }
            else { for (int rep = 0; rep < REP_GEMM; ++rep) { gemm_f32out(ldsp, (const u16*)(ws + WS_G), wb + W_DN / 2, (float*)(ws + WS_YB), TG, D, FF); __syncthreads(); } }
        }
        if (ph + 1 < p.ph_hi) {
            if (p.ph_lo < 0) grid.sync();
            for (int rep = 0; rep < REP_SYNC; ++rep) xcd_barrier(xbar);
        }
    }
}

extern "C" void kernel_launch(void* const* d_in, const int* in_sizes, int n_in, void* d_out, int out_size, void* d_ws, size_t ws_size, hipStream_t stream) {
    static int grid = 0;
    if (grid == 0) {
        if (n_in != 30 || ws_size < WS_END) { fprintf(stderr, "kernel_launch: unexpected n_in %d or ws_size %zu (need %zu)\n", n_in, ws_size, (size_t)WS_END); grid = -1; return; }
        int dev = 0, cus = 0, per_cu = 0;
        hipGetDevice(&dev); hipDeviceGetAttribute(&cus, hipDeviceAttributeMultiprocessorCount, dev);
        if (hipFuncSetAttribute((const void*)mega_fwd, hipFuncAttributeMaxDynamicSharedMemorySize, LDS_BYTES) != hipSuccess) { fprintf(stderr, "kernel_launch: hipFuncSetAttribute failed\n"); grid = -1; return; }
        if (hipOccupancyMaxActiveBlocksPerMultiprocessor(&per_cu, (const void*)mega_fwd, NTHREADS, LDS_BYTES) != hipSuccess || per_cu < 1) per_cu = 1;
        (void)hipGetLastError();
        grid = cus * 1;
        if (grid <= 0) grid = 256;
    }
    if (grid < 0) return;
    Params p; memset(&p, 0, sizeof(p));
    const float** pp = (const float**)&p;
    for (int i = 0; i < 30; ++i) pp[i] = (const float*)d_in[i];
    p.out = (float*)d_out; p.ws = (unsigned char*)d_ws; p.ph_lo = 0; p.ph_hi = NPHASES;
    (void)hipMemsetAsync((char*)d_ws + WS_BAR, 0, XCD_BAR_WORDS * 4, stream);
    void* args[] = {&p};
    hipError_t e = hipLaunchCooperativeKernel((const void*)mega_fwd, dim3(grid), dim3(NTHREADS), args, LDS_BYTES, stream);
    if (e != hipSuccess) fprintf(stderr, "cooperative launch failed: %s (grid %d)\n", hipGetErrorString(e), grid);
}
```
